# Optimizing an MI355X kernel written in HIP

```python
import math
import jax, jax.numpy as jnp
from jax import lax
import numpy as np

D_MODEL = 2048
BATCH = 2
SEQ = 8192
DEPTH = 2

D_MIX = D_MODEL
HEAD_DIM = 64
BLOCK = 128
ROPE_THETA = 10000.0
A_HEADS = (3 * D_MIX) // (8 * HEAD_DIM)
A_KV_HEADS = A_HEADS // 3
A_GROUP = A_HEADS // A_KV_HEADS
A_WIDTH = A_HEADS * HEAD_DIM
WINDOW = 128
POOL_WINDOWS = (2, 4, 8, 16)
B_GROUPS = len(POOL_WINDOWS)
B_WIDTH = D_MIX // 4
B_GROUP_DIM = B_WIDTH // B_GROUPS
C_VDIM = 2 * HEAD_DIM
C_WIDTH = D_MIX - A_WIDTH - B_WIDTH
C_HEADS = C_WIDTH // C_VDIM
DIFF_EPS = 1e-5
IN_WIDTHS = (A_WIDTH, A_KV_HEADS * HEAD_DIM, A_KV_HEADS * HEAD_DIM, B_WIDTH, C_WIDTH, C_WIDTH, C_WIDTH)
IN_COLS = sum(IN_WIDTHS)
N_GROUPS = 4
EXPERTS_PER_GROUP = 8
N_EXPERTS = N_GROUPS * EXPERTS_PER_GROUP
TOP_K = 2
D_FF_EXPERT = D_MODEL // 4
ROW_BLOCK = 128
NORM_EPS = 1e-6

kernel_name = "hymba_style_swa_pool_diffattn_hiermoe"


def rms_norm(x, g, eps=NORM_EPS):
    xf = x.astype(jnp.float32)
    y = xf * lax.rsqrt(jnp.mean(xf * xf, axis=-1, keepdims=True) + eps)
    return (y * g.astype(jnp.float32)).astype(x.dtype)


def rope(x, positions):
    half = x.shape[-1] // 2
    inv = ROPE_THETA ** (-jnp.arange(half, dtype=jnp.float32) / half)
    ang = positions.astype(jnp.float32)[:, :, None] * inv
    cos = jnp.cos(ang)[:, :, None, :]
    sin = jnp.sin(ang)[:, :, None, :]
    xf = x.astype(jnp.float32)
    x1, x2 = xf[..., :half], xf[..., half:]
    return jnp.concatenate([x1 * cos - x2 * sin, x2 * cos + x1 * sin], axis=-1).astype(x.dtype)


def split_projection(proj):
    idx, out = 0, []
    for w in IN_WIDTHS:
        out.append(proj[..., idx:idx + w])
        idx += w
    return out


def sliding_window_attention(q, k, v, sinks):
    B, S = q.shape[:2]
    nb = S // BLOCK
    qb = q.reshape(B, nb, BLOCK, A_KV_HEADS, A_GROUP, HEAD_DIM)

    def band(t):
        tb = t.reshape(B, nb, BLOCK, A_KV_HEADS, HEAD_DIM)
        prev = jnp.concatenate([jnp.zeros_like(tb[:, :1]), tb[:, :-1]], axis=1)
        return jnp.concatenate([prev, tb], axis=2)

    kb, vb = band(k), band(v)
    s = jnp.einsum('bnqkgd,bnjkd->bnkgqj', qb, kb).astype(jnp.float32) * (HEAD_DIM ** -0.5)
    qi = jnp.arange(BLOCK)[:, None]
    j = jnp.arange(2 * BLOCK)[None, :]
    dist = qi + BLOCK - j
    kpos = jnp.arange(nb)[:, None, None] * BLOCK - BLOCK + j[None]
    mask = (dist >= 0)[None] & (dist < WINDOW)[None] & (kpos >= 0)
    s = jnp.where(mask[None, :, None, None], s, -jnp.inf)
    sink = sinks.astype(jnp.float32).reshape(1, 1, A_KV_HEADS, A_GROUP, 1, 1)
    sink = jnp.broadcast_to(sink, s.shape[:-1] + (1,))
    p = jax.nn.softmax(jnp.concatenate([s, sink], axis=-1), axis=-1)[..., :-1]
    o = jnp.einsum('bnkgqj,bnjkd->bnqkgd', p.astype(v.dtype), vb)
    return o.reshape(B, S, A_WIDTH)


def multiscale_pool(u, w_pool, scale):
    S = u.shape[1]
    uf = u.astype(jnp.float32)
    cs = jnp.cumsum(uf, axis=1)
    t = jnp.arange(S)
    outs = []
    for gi, w in enumerate(POOL_WINDOWS):
        sl = slice(gi * B_GROUP_DIM, (gi + 1) * B_GROUP_DIM)
        c = cs[:, :, sl]
        prev = jnp.pad(c, ((0, 0), (w, 0), (0, 0)))[:, :S]
        cnt = jnp.minimum(t + 1, w).astype(jnp.float32)[None, :, None]
        y = ((c - prev) / cnt - uf[:, :, sl]).astype(u.dtype)
        outs.append(y @ w_pool[gi])
    return jnp.concatenate(outs, axis=-1) * scale


def differential_attention(q, k, v, lam, lam_init, subln):
    B, S = q.shape[:2]
    nb = S // BLOCK
    qb = q.reshape(B, nb, BLOCK, C_HEADS, 2, HEAD_DIM).transpose(1, 0, 2, 3, 4, 5)
    kpos = jnp.arange(S)

    def one_block(args):
        n, qblk = args
        s = jnp.einsum('bqhcd,bkhcd->bhcqk', qblk, k).astype(jnp.float32) * (HEAD_DIM ** -0.5)
        qpos = n * BLOCK + jnp.arange(BLOCK)
        s = jnp.where(kpos[None, :] <= qpos[:, None], s, -jnp.inf)
        p = jax.nn.softmax(s, axis=-1)
        a = p[:, :, 0] - lam * p[:, :, 1]
        return jnp.einsum('bhqk,bkhe->bqhe', a.astype(v.dtype), v)

    o = lax.map(one_block, (jnp.arange(nb), qb))
    o = o.transpose(1, 0, 2, 3, 4).reshape(B, S, C_HEADS, C_VDIM)
    o = rms_norm(o, subln, eps=DIFF_EPS) * (1.0 - lam_init)
    return o.reshape(B, S, C_WIDTH)


def hierarchical_moe(h, w_rg, b_rg, w_re, b_re, w_g, w_u, w_d):
    B, S, D = h.shape
    T = B * S
    xs = h.reshape(T, D)
    pg = jax.nn.softmax((xs @ w_rg + b_rg).astype(jnp.float32), axis=-1)
    gsel = jnp.argmax(pg, axis=-1)
    pgsel = jnp.take_along_axis(pg, gsel[:, None], axis=1)
    le = (xs @ w_re + b_re).astype(jnp.float32).reshape(T, N_GROUPS, EXPERTS_PER_GROUP)
    le = jnp.take_along_axis(le, gsel[:, None, None], axis=1)[:, 0]
    pe = jax.nn.softmax(le, axis=-1)
    top_p, top_i = lax.top_k(pe, TOP_K)
    gates = pgsel * top_p / jnp.sum(top_p, axis=-1, keepdims=True)
    eidx = (gsel[:, None] * EXPERTS_PER_GROUP + top_i).astype(jnp.int32)

    N = T * TOP_K
    flat_e = eidx.reshape(N)
    order = jnp.argsort(flat_e)
    sorted_e = flat_e[order]
    tok = order // TOP_K
    g_sorted = gates.reshape(N)[order]
    xs_sorted = xs[tok]
    counts = jnp.bincount(flat_e, length=N_EXPERTS)
    starts = (jnp.cumsum(counts) - counts).astype(jnp.int32)
    nb = N // ROW_BLOCK
    bounds = jnp.sort(jnp.concatenate([jnp.arange(nb, dtype=jnp.int32) * ROW_BLOCK, starts]))
    ends = jnp.concatenate([bounds[1:], jnp.full((1,), N, bounds.dtype)])
    seg_blk = jnp.minimum(bounds // ROW_BLOCK, nb - 1)
    seg_exp = sorted_e[jnp.minimum(bounds, N - 1)]

    def segment(args):
        s0, s1, blk, ex = args
        row0 = blk * ROW_BLOCK
        xb = lax.dynamic_slice_in_dim(xs_sorted, row0, ROW_BLOCK, 0)
        a = jax.nn.silu(xb @ w_g[ex]) * (xb @ w_u[ex])
        yb = a @ w_d[ex]
        rows = row0 + jnp.arange(ROW_BLOCK)
        wgt = jnp.where((rows >= s0) & (rows < s1), g_sorted[rows], 0.0)
        return yb * wgt[:, None].astype(yb.dtype), tok[rows]

    ys, tok_rows = lax.map(segment, (bounds, ends, seg_blk, seg_exp))
    y = jnp.zeros((T, D), h.dtype).at[tok_rows.reshape(-1)].add(ys.reshape(-1, D))
    return y.reshape(B, S, D)


def setup_inputs(seed: int = 0) -> dict:
    key = jax.random.key(seed)
    ks = jax.random.split(key, 24)
    f32 = jnp.float32
    nrm = lambda k, shape, scale: jax.random.normal(k, shape, f32) * scale
    L = DEPTH
    return {
        "x": nrm(ks[0], (BATCH, SEQ, D_MODEL), 1.0),
        "positions": jnp.broadcast_to(jnp.arange(SEQ, dtype=jnp.int32)[None], (BATCH, SEQ)),
        "attn_norm": 1.0 + nrm(ks[1], (L, D_MODEL), 0.02),
        "w_in": nrm(ks[2], (L, D_MODEL, IN_COLS), D_MODEL ** -0.5),
        "sinks": nrm(ks[3], (L, A_HEADS), 1.0),
        "branch_norm_a": 1.0 + nrm(ks[4], (L, A_WIDTH), 0.02),
        "w_pool": nrm(ks[5], (L, B_GROUPS, B_GROUP_DIM, B_GROUP_DIM), B_GROUP_DIM ** -0.5),
        "pool_scale": 1.0 + nrm(ks[6], (L, B_WIDTH), 0.02),
        "lambda_q1": nrm(ks[7], (L, HEAD_DIM), 0.1),
        "lambda_k1": nrm(ks[8], (L, HEAD_DIM), 0.1),
        "lambda_q2": nrm(ks[9], (L, HEAD_DIM), 0.1),
        "lambda_k2": nrm(ks[10], (L, HEAD_DIM), 0.1),
        "subln": 1.0 + nrm(ks[11], (L, C_VDIM), 0.02),
        "w_out": nrm(ks[12], (L, D_MIX, D_MODEL), D_MIX ** -0.5),
        "ffn_norm": 1.0 + nrm(ks[13], (L, D_MODEL), 0.02),
        "w_router_group": nrm(ks[14], (L, D_MODEL, N_GROUPS), D_MODEL ** -0.5),
        "b_router_group": nrm(ks[15], (L, N_GROUPS), 0.01),
        "w_router_expert": nrm(ks[16], (L, D_MODEL, N_EXPERTS), D_MODEL ** -0.5),
        "b_router_expert": nrm(ks[17], (L, N_EXPERTS), 0.01),
        "w_expert_gate": nrm(ks[18], (L, N_EXPERTS, D_MODEL, D_FF_EXPERT), D_MODEL ** -0.5),
        "w_expert_up": nrm(ks[19], (L, N_EXPERTS, D_MODEL, D_FF_EXPERT), D_MODEL ** -0.5),
        "w_expert_down": nrm(ks[20], (L, N_EXPERTS, D_FF_EXPERT, D_MODEL), D_FF_EXPERT ** -0.5),
        "final_norm": 1.0 + nrm(ks[21], (D_MODEL,), 0.02),
    }


def reference(x, positions, attn_norm, w_in, sinks, branch_norm_a, w_pool, pool_scale,
              lambda_q1, lambda_k1, lambda_q2, lambda_k2, subln, w_out, ffn_norm,
              w_router_group, b_router_group, w_router_expert, b_router_expert,
              w_expert_gate, w_expert_up, w_expert_down, final_norm):
    B, S, _ = x.shape
    h = x
    for l in range(DEPTH):
        hn = rms_norm(h, attn_norm[l])
        qa, ka, va, ub, qc, kc, vc = split_projection(hn @ w_in[l])
        qa = rope(qa.reshape(B, S, A_HEADS, HEAD_DIM), positions)
        ka = rope(ka.reshape(B, S, A_KV_HEADS, HEAD_DIM), positions)
        va = va.reshape(B, S, A_KV_HEADS, HEAD_DIM)
        oa = rms_norm(sliding_window_attention(qa, ka, va, sinks[l]), branch_norm_a[l])
        ob = multiscale_pool(ub, w_pool[l], pool_scale[l])
        qc = rope(qc.reshape(B, S, 2 * C_HEADS, HEAD_DIM), positions).reshape(B, S, C_HEADS, 2, HEAD_DIM)
        kc = rope(kc.reshape(B, S, 2 * C_HEADS, HEAD_DIM), positions).reshape(B, S, C_HEADS, 2, HEAD_DIM)
        vc = vc.reshape(B, S, C_HEADS, C_VDIM)
        lam_init = 0.8 - 0.6 * math.exp(-0.3 * l)
        lam = (jnp.exp(jnp.sum(lambda_q1[l].astype(jnp.float32) * lambda_k1[l].astype(jnp.float32)))
               - jnp.exp(jnp.sum(lambda_q2[l].astype(jnp.float32) * lambda_k2[l].astype(jnp.float32)))
               + lam_init)
        oc = differential_attention(qc, kc, vc, lam, lam_init, subln[l])
        h = h + jnp.concatenate([oa, ob, oc], axis=-1) @ w_out[l]
        h = h + hierarchical_moe(rms_norm(h, ffn_norm[l]), w_router_group[l], b_router_group[l],
                                 w_router_expert[l], b_router_expert[l], w_expert_gate[l],
                                 w_expert_up[l], w_expert_down[l])
    return rms_norm(h, final_norm)
```

```cpp
#include <hip/hip_runtime.h>
#include <hip/hip_cooperative_groups.h>
#include <cstdio>
#include <cstdint>
namespace cg = cooperative_groups;

namespace pg8 {
#define PG8_LAS __attribute__((address_space(3)))
typedef unsigned short bf16_t;
typedef short bf16x8 __attribute__((ext_vector_type(8)));
typedef float f32x4 __attribute__((ext_vector_type(4)));
typedef unsigned u32x4 __attribute__((ext_vector_type(4)));
constexpr int BM = 256, BK = 64, HALF = 128, HTB = HALF * BK * 2  , STAGE_BYTES = 8 * HTB, NXCD = 8, WGM = 8;

__host__ __device__ __forceinline__ int lds_byte(int r, int c) { const int st = (r >> 4) * 2 + (c >> 5), rr = r & 15, cc = c & 31, ob = rr * 64 + cc * 2; return st * 1024 + (ob ^ (((ob >> 9) & 1) << 5)); }
__host__ __device__ __forceinline__ void stage_rc(int b, int& R, int& C) { const int st = b / 1024, sb = b % 1024, swz = sb ^ (((sb >> 9) & 1) << 5); R = (st >> 1) * 16 + swz / 64; C = (st & 1) * 32 + (swz % 64) / 2; }
__host__ __device__ __forceinline__ int perm32(int rho) { const int n = rho >> 4, i = rho & 15; return 8 * (i >> 2) + 4 * n + (i & 3); }

struct Unit { int am, bn, pm, pn, e, valid; };
struct Gemm { const bf16_t* A; const bf16_t* Bt; int M, N, K; };

struct StaticOrder {
    int nM, nN, nwg, G, c;
    __device__ void init(int M, int N, int G_, int c_) { nM = M / BM; nN = N / BM; nwg = nM * nN; G = G_; c = c_; }
    __device__ bool next(int i, Unit& u) const {
        const long L = (long)i * G + c; if (L >= nwg) return false;
        int wgid = (int)L; { const int q = nwg / NXCD, r = nwg % NXCD, xcd = wgid % NXCD, off = wgid / NXCD; wgid = (xcd < r ? xcd * (q + 1) : r * (q + 1) + (xcd - r) * q) + off; }
        const int nig = WGM * nN, gid = wgid / nig, fm = gid * WGM, gsz = (nM - fm) < WGM ? (nM - fm) : WGM;
        u.pm = fm + ((wgid % nig) % gsz); u.pn = (wgid % nig) / gsz; u.am = u.pm * BM; u.bn = u.pn * BM; u.e = 0; u.valid = BM; return true;
    }
    __device__ __forceinline__ void a_ready(const Unit&) const {}
    __device__ __forceinline__ void done(const Unit&) const {}
};
struct MoeOrder {
    const PG8_LAS int* ST;
    const PG8_LAS int* TP;
    int NP, NB, G, c;
    __device__ bool next(int i, Unit& u) const {
        const int U = TP[32] * NP, CH = (U + NXCD - 1) / NXCD;
        const int x = c % NXCD, j = c / NXCD + (G / NXCD) * i;
        if (j >= CH) return false;
        const int ui = x * CH + j; if (ui >= U) return false;
        const int t = ui / NP, pn = ui % NP;
        int e = 0;
        while (e < 31 && TP[e + 1] <= t) ++e;
        const int mt = t - TP[e], cnt = ST[e + 1] - ST[e];
        u.e = e; u.pm = mt; u.pn = pn; u.am = ST[e] + mt * BM; u.bn = e * NB + pn * BM; u.valid = (cnt - mt * BM) < BM ? (cnt - mt * BM) : BM; return true;
    }
    __device__ __forceinline__ void a_ready(const Unit&) const {}
    __device__ __forceinline__ void done(const Unit&) const {}
};

__device__ __forceinline__ unsigned cvt_pk_bf16(float lo, float hi) { unsigned r; asm volatile("v_cvt_pk_bf16_f32 %0, %1, %2" : "=v"(r) : "v"(lo), "v"(hi)); return r; }

template <class Epi, class Sched, bool ALIGN_EPI = false, bool SP2 = false>
__device__ __forceinline__ void gemm_phase(PG8_LAS unsigned char* lds, const Gemm g, const Sched& S, const Epi& E, const int tid) {
    const int wid = __builtin_amdgcn_readfirstlane(tid >> 6), lane = tid & 63, wr = wid >> 2, wc = wid & 3, fr = lane & 15, fq = lane >> 4;
    const int K = g.K, nt = K / BK;
    unsigned voffA[2], voffB[2];
#pragma unroll
    for (int i = 0; i < 2; ++i) { int R, C; stage_rc(tid * 16 + i * 8192, R, C); const int Rb = Epi::PERM ? ((R & ~31) + perm32(R & 31)) : R;
        voffA[i] = (unsigned)(R * K + C) * 2u; voffB[i] = (unsigned)(Rb * K + C) * 2u; }
    const size_t kstep = (size_t)(BK * 2);
    const size_t hstep = (size_t)HALF * K * 2;
    const size_t rowb = (size_t)K * 2;
    const unsigned ldsw = (unsigned)wid * 1024u;
    const int aoff = lds_byte(wr * 64 + fr, fq * 8), boff = lds_byte(wc * 32 + fr, fq * 8);
#define PG8_SA(b, h) (((b) * 2 + (h)) * HTB)
#define PG8_SB(b, h) ((4 + (b) * 2 + (h)) * HTB)
#define PG8_STAGE(bufoff, gbase, voff) do { _Pragma("unroll") for (int _i = 0; _i < 2; ++_i) \
        __builtin_amdgcn_global_load_lds((const unsigned*)((const char*)(gbase) + (voff)[_i]), (PG8_LAS unsigned*)(lds + (bufoff) + ldsw + _i * 8192), 16, 0, 0); } while (0)
#define PG8_LDA(dst, b, h) do { _Pragma("unroll") for (int m = 0; m < 4; ++m) _Pragma("unroll") for (int k = 0; k < 2; ++k) dst[m][k] = *(const PG8_LAS bf16x8*)(lds + PG8_SA(b, h) + aoff + m * 2048 + k * 1024); } while (0)
#define PG8_LDB(dst, b, h) do { _Pragma("unroll") for (int n = 0; n < 2; ++n) _Pragma("unroll") for (int k = 0; k < 2; ++k) dst[n][k] = *(const PG8_LAS bf16x8*)(lds + PG8_SB(b, h) + boff + n * 2048 + k * 1024); } while (0)
#define PG8_MMA(ai, bj, At, Bt) do { __builtin_amdgcn_s_setprio(1); _Pragma("unroll") for (int m = 0; m < 4; ++m) _Pragma("unroll") for (int n = 0; n < 2; ++n) _Pragma("unroll") for (int k = 0; k < 2; ++k) \
        acc[ai][bj][m][n] = __builtin_amdgcn_mfma_f32_16x16x32_bf16(Bt[n][k], At[m][k], acc[ai][bj][m][n], 0, 0, 0); __builtin_amdgcn_s_setprio(0); } while (0)
#define PG8_WAIT_V(n) asm volatile("s_waitcnt vmcnt(" #n ")" ::: "memory")
#define PG8_WAIT_L(n) asm volatile("s_waitcnt lgkmcnt(" #n ")" ::: "memory")
#define PG8_BAR __builtin_amdgcn_s_barrier()
#define PG8_SCHED __builtin_amdgcn_sched_barrier(0)
    Unit cur, nxt; int ui = 0;
    if (!S.next(0, cur)) return;
    f32x4 acc[2][2][4][2];
#pragma unroll
    for (int a = 0; a < 2; ++a)
#pragma unroll
        for (int b = 0; b < 2; ++b)
#pragma unroll
            for (int m = 0; m < 4; ++m)
#pragma unroll
                for (int n = 0; n < 2; ++n) acc[a][b][m][n] = (f32x4){0.f, 0.f, 0.f, 0.f};
    bf16x8 At[4][2], B0[2][2], B1[2][2];
    const char* cA = (const char*)g.A + (size_t)cur.am * rowb; const char* cB = (const char*)g.Bt + (size_t)cur.bn * rowb;
    S.a_ready(cur);
    if constexpr (SP2) {
        PG8_STAGE(PG8_SB(0, 0), cB, voffB); PG8_STAGE(PG8_SB(0, 1), cB + hstep, voffB); PG8_STAGE(PG8_SA(0, 0), cA, voffA); PG8_STAGE(PG8_SA(0, 1), cA + hstep, voffA);
        if (wr == 1) PG8_BAR;
        PG8_WAIT_V(2); PG8_BAR;
        PG8_STAGE(PG8_SB(1, 0), cB + kstep, voffB); PG8_STAGE(PG8_SA(1, 0), cA + kstep, voffA); PG8_STAGE(PG8_SB(1, 1), cB + hstep + kstep, voffB);
        PG8_WAIT_V(6); PG8_BAR;
    } else {
        PG8_STAGE(PG8_SB(0, 0), cB, voffB); PG8_STAGE(PG8_SA(0, 0), cA, voffA); PG8_STAGE(PG8_SB(0, 1), cB + hstep, voffB); PG8_STAGE(PG8_SA(0, 1), cA + hstep, voffA);
        if (wr == 1) PG8_BAR;
        PG8_WAIT_V(4); PG8_BAR;
        PG8_STAGE(PG8_SB(1, 0), cB + kstep, voffB); PG8_STAGE(PG8_SA(1, 0), cA + kstep, voffA); PG8_STAGE(PG8_SB(1, 1), cB + hstep + kstep, voffB);
        PG8_WAIT_V(6); PG8_BAR;
    }
    for (;;) {
        const bool has_next = S.next(ui + 1, nxt);
        const char* nA = has_next ? (const char*)g.A + (size_t)nxt.am * rowb : cA; const char* nB = has_next ? (const char*)g.Bt + (size_t)nxt.bn * rowb : cB;
        for (int t = 0; t < nt; t += 2) {
            const bool last = (t == nt - 2);
            const char* a1 = cA + (size_t)(t + 1) * kstep;
            const char* a2 = last ? nA : cA + (size_t)(t + 2) * kstep; const char* b2 = last ? nB : cB + (size_t)(t + 2) * kstep;
            const char* a3 = a2 + kstep; const char* b3 = b2 + kstep;
            if (last && has_next) S.a_ready(nxt);
            if constexpr (SP2) {
            PG8_LDB(B0, 0, 0); PG8_LDB(B1, 0, 1); PG8_SCHED; PG8_LDA(At, 0, 0); PG8_STAGE(PG8_SA(1, 1), a1 + hstep, voffA);
            PG8_WAIT_V(8); PG8_WAIT_L(0); PG8_BAR; PG8_MMA(0, 0, At, B0); PG8_MMA(0, 1, At, B1); PG8_BAR; PG8_SCHED;
            PG8_LDA(At, 0, 1); PG8_STAGE(PG8_SB(0, 0), b2, voffB); PG8_STAGE(PG8_SB(0, 1), b2 + hstep, voffB); PG8_STAGE(PG8_SA(0, 0), a2, voffA);
            PG8_WAIT_V(8); PG8_WAIT_L(0); PG8_BAR; PG8_MMA(1, 0, At, B0); PG8_MMA(1, 1, At, B1); PG8_BAR; PG8_SCHED;
            PG8_LDB(B0, 1, 0); PG8_LDB(B1, 1, 1); PG8_SCHED; PG8_LDA(At, 1, 0); PG8_STAGE(PG8_SA(0, 1), a2 + hstep, voffA);
            PG8_WAIT_V(8); PG8_WAIT_L(0); PG8_BAR; PG8_MMA(0, 0, At, B0); PG8_MMA(0, 1, At, B1); PG8_BAR; PG8_SCHED;
            PG8_LDA(At, 1, 1); PG8_STAGE(PG8_SB(1, 0), b3, voffB); PG8_STAGE(PG8_SB(1, 1), b3 + hstep, voffB); PG8_STAGE(PG8_SA(1, 0), a3, voffA);
            PG8_WAIT_V(8); PG8_WAIT_L(0); PG8_BAR; PG8_MMA(1, 0, At, B0); PG8_MMA(1, 1, At, B1); PG8_BAR; PG8_SCHED;
            } else {
            PG8_LDB(B0, 0, 0); PG8_SCHED; PG8_LDA(At, 0, 0); PG8_STAGE(PG8_SA(1, 1), a1 + hstep, voffA);
            PG8_WAIT_L(8); PG8_BAR; PG8_WAIT_L(0); PG8_MMA(0, 0, At, B0); PG8_BAR; PG8_SCHED;
            PG8_LDB(B1, 0, 1); PG8_STAGE(PG8_SB(0, 0), b2, voffB);
            PG8_BAR; PG8_WAIT_L(0); PG8_MMA(0, 1, At, B1); PG8_BAR;
            PG8_LDA(At, 0, 1); PG8_STAGE(PG8_SA(0, 0), a2, voffA);
            PG8_BAR; PG8_WAIT_L(0); PG8_MMA(1, 0, At, B0); PG8_BAR; PG8_SCHED;
            PG8_STAGE(PG8_SB(0, 1), b2 + hstep, voffB);
            PG8_WAIT_V(6); PG8_BAR; PG8_MMA(1, 1, At, B1); PG8_BAR;
            PG8_LDB(B0, 1, 0); PG8_SCHED; PG8_LDA(At, 1, 0); PG8_STAGE(PG8_SA(0, 1), a2 + hstep, voffA);
            PG8_WAIT_L(8); PG8_BAR; PG8_WAIT_L(0); PG8_MMA(0, 0, At, B0); PG8_BAR; PG8_SCHED;
            PG8_LDB(B1, 1, 1); PG8_STAGE(PG8_SB(1, 0), b3, voffB);
            PG8_BAR; PG8_WAIT_L(0); PG8_MMA(0, 1, At, B1); PG8_BAR;
            PG8_LDA(At, 1, 1); PG8_STAGE(PG8_SA(1, 0), a3, voffA);
            PG8_BAR; PG8_WAIT_L(0); PG8_MMA(1, 0, At, B0); PG8_BAR; PG8_SCHED;
            PG8_STAGE(PG8_SB(1, 1), b3 + hstep, voffB);
            PG8_WAIT_V(6); PG8_BAR; PG8_MMA(1, 1, At, B1); PG8_BAR;
            }
        }
        if constexpr (ALIGN_EPI) { if (wr == 0) PG8_BAR; }
        if constexpr (!Epi::AFTER_DRAIN) { E(acc, cur, wr, wc, fr, fq); S.done(cur); }
        if (!has_next) break;
#pragma unroll
        for (int a = 0; a < 2; ++a)
#pragma unroll
            for (int b = 0; b < 2; ++b)
#pragma unroll
                for (int m = 0; m < 4; ++m)
#pragma unroll
                    for (int n = 0; n < 2; ++n) acc[a][b][m][n] = (f32x4){0.f, 0.f, 0.f, 0.f};
        cur = nxt; cA = nA; cB = nB; ++ui;
        if constexpr (ALIGN_EPI) { if (wr == 1) PG8_BAR; }
    }
    PG8_WAIT_V(0);
    if constexpr (!ALIGN_EPI) { if (wr == 0) PG8_BAR; }
    PG8_BAR;
    if constexpr (Epi::AFTER_DRAIN) { E.fused(acc, cur, wr, wc, fr, fq, lds, wid, lane); S.done(cur); }
#undef PG8_SA
#undef PG8_SB
#undef PG8_STAGE
#undef PG8_LDA
#undef PG8_LDB
#undef PG8_MMA
#undef PG8_WAIT_V
#undef PG8_WAIT_L
#undef PG8_BAR
#undef PG8_SCHED
}
}

#define LAS __attribute__((address_space(3)))
typedef unsigned short bf16_t;
typedef short bf16x8 __attribute__((ext_vector_type(8)));
typedef float f32x4 __attribute__((ext_vector_type(4)));
typedef float f32x16 __attribute__((ext_vector_type(16)));
typedef unsigned u32x4 __attribute__((ext_vector_type(4)));
typedef unsigned u32x2 __attribute__((ext_vector_type(2)));
typedef short s16x4 __attribute__((ext_vector_type(4)));
typedef LAS const char* lds_cptr;
using pg8::Unit;

constexpr int T = 16384, SEQ = 8192, DM = 2048, INC = 4096, NEXP = 32, DFF = 512, NASSIGN = 2 * T, NLAYER = 2;
constexpr float LOG2E = 1.4426950408889634f;
constexpr float C2 = 0.125f * LOG2E;
constexpr int C_QA = 0, C_KA = 768, C_VA = 1024, C_UB = 1280, C_QC = 1792, C_KC = 2560, C_VC = 3328;

constexpr size_t MiB = 1u << 20;
constexpr size_t WS_CTL = 0, CTL_ZERO_BYTES = 1 * MiB;
constexpr size_t WS_COS = 2 * MiB, WS_SIN = 4 * MiB;
constexpr size_t WS_TOKE = 6 * MiB, WS_TOKG = 6 * MiB + 256 * 1024, WS_TOKP = 6 * MiB + 512 * 1024, WS_SGATE = 6 * MiB + 768 * 1024;
constexpr size_t WS_ROWTOK = 8 * MiB, WS_ROWGATE = 10 * MiB;
constexpr size_t WS_WR = 12 * MiB;
constexpr size_t WS_WIN = 16 * MiB, WS_WOUT = 48 * MiB, WS_WGU = 64 * MiB, WS_WDN = 320 * MiB;
constexpr size_t WS_HN = 448 * MiB, WS_PROJ = 512 * MiB, WS_CAT = 642 * MiB, WS_XSS = 706 * MiB, WS_ACT = 835 * MiB, WS_END = 868 * MiB;
constexpr int CW_QCTR = 0;
constexpr int CW_CUR = 1024;

constexpr int LDS_WSF = 135168, LDS_MISC = 137216, LDS_BYTES = 147456;
constexpr int MI_ST = 16, MI_TP = 64, MI_LCNT = 128, MI_LBASE = 160, MI_SSQ = 256;

#define LDS_WAIT() asm volatile("s_waitcnt lgkmcnt(0)" ::: "memory")
__device__ __forceinline__ unsigned f2bf(float f) { unsigned u = __builtin_bit_cast(unsigned, f); return (u + 0x7fffu + ((u >> 16) & 1u)) >> 16; }
__device__ __forceinline__ unsigned pk2(float lo, float hi) { return f2bf(lo) | (f2bf(hi) << 16); }
__device__ __forceinline__ float bf2f(unsigned b) { return __builtin_bit_cast(float, b << 16); }
typedef float f32x2_t __attribute__((ext_vector_type(2))); typedef __bf16 bf16x2_t __attribute__((ext_vector_type(2)));
__device__ __forceinline__ unsigned cvtpk(float lo, float hi) { f32x2_t v = {lo, hi}; bf16x2_t b = __builtin_convertvector(v, bf16x2_t); return __builtin_bit_cast(unsigned, b); }
__device__ __forceinline__ float wave_sum(float v) {
#pragma unroll
    for (int o = 1; o < 64; o <<= 1) v += __shfl_xor(v, o);
    return v;
}

struct Ctx {
    const float* in[23]; float* out; unsigned char* ws;
    LAS unsigned char* lds; volatile LAS int* misc;
    int tid, lane, wave, G, bid;
};
#define IN_X 0
#define IN_POS 1
#define IN_ANORM 2
#define IN_WIN 3
#define IN_SINKS 4
#define IN_BNA 5
#define IN_WPOOL 6
#define IN_PSCALE 7
#define IN_LQ1 8
#define IN_LK1 9
#define IN_LQ2 10
#define IN_LK2 11
#define IN_SUBLN 12
#define IN_WOUT 13
#define IN_FNORM 14
#define IN_WRG 15
#define IN_BRG 16
#define IN_WRE 17
#define IN_BRE 18
#define IN_WG 19
#define IN_WU 20
#define IN_WD 21
#define IN_FINAL 22

struct EpiProj {
    static constexpr bool PERM = true, AFTER_DRAIN = false;
    bf16_t* O; const float* cosT; const float* sinT;
    __device__ __forceinline__ void operator()(const f32x4 (&acc)[2][2][4][2], const Unit& u, int wr, int wc, int fr, int fq) const {
        const int pn = u.pn;
        const bool rope = (pn <= 3) || (pn >= 7 && pn <= 12);
        const float sc = ((pn <= 2) || (pn >= 7 && pn <= 9)) ? C2 : 1.f;
        const int row0 = u.pm * 256 + wr * 64 + fr, col0 = pn * 256 + wc * 32 + 8 * fq, fi = 16 * (wc & 1) + 4 * fq;
#pragma unroll
        for (int ai = 0; ai < 2; ++ai)
#pragma unroll
            for (int m = 0; m < 4; ++m) {
                const int row = row0 + ai * 128 + m * 16;
                f32x4 cs = {1.f, 1.f, 1.f, 1.f}, sn = {0.f, 0.f, 0.f, 0.f};
                if (rope) { cs = *(const f32x4*)(cosT + (size_t)row * 32 + fi); sn = *(const f32x4*)(sinT + (size_t)row * 32 + fi); }
                bf16_t* rowp = O + (size_t)row * INC + col0;
#pragma unroll
                for (int bj = 0; bj < 2; ++bj) {
                    const f32x4 v0 = acc[ai][bj][m][0], v1 = acc[ai][bj][m][1];
                    const f32x4 o0 = (v0 * cs - v1 * sn) * sc, o1 = (v1 * cs + v0 * sn) * sc;
                    u32x4 w; w.x = cvtpk(o0[0], o0[1]); w.y = cvtpk(o0[2], o0[3]); w.z = cvtpk(o1[0], o1[1]); w.w = cvtpk(o1[2], o1[3]);
                    *(u32x4*)(rowp + bj * 128) = w;
                }
            }
    }
};
struct EpiResid {
    static constexpr bool PERM = false, AFTER_DRAIN = false;
    const float* src; float* dst;
    __device__ __forceinline__ void operator()(const f32x4 (&acc)[2][2][4][2], const Unit& u, int wr, int wc, int fr, int fq) const {
        const int row0 = u.pm * 256 + wr * 64 + fr, col0 = u.pn * 256 + wc * 32 + 4 * fq;
#pragma unroll
        for (int ai = 0; ai < 2; ++ai)
#pragma unroll
            for (int m = 0; m < 4; ++m) {
                const size_t off = (size_t)(row0 + ai * 128 + m * 16) * DM + col0;
#pragma unroll
                for (int bj = 0; bj < 2; ++bj)
#pragma unroll
                    for (int n = 0; n < 2; ++n) { const f32x4 s = *(const f32x4*)(src + off + bj * 128 + n * 16); *(f32x4*)(dst + off + bj * 128 + n * 16) = s + acc[ai][bj][m][n]; }
            }
    }
};
struct EpiGU {
    static constexpr bool PERM = true, AFTER_DRAIN = false;
    bf16_t* ACT;
    __device__ __forceinline__ void operator()(const f32x4 (&acc)[2][2][4][2], const Unit& u, int wr, int wc, int fr, int fq) const {
        const int col0 = u.pn * 128 + wc * 32 + 8 * fq;
#pragma unroll
        for (int ai = 0; ai < 2; ++ai)
#pragma unroll
            for (int m = 0; m < 4; ++m) {
                const int r = ai * 128 + wr * 64 + m * 16 + fr;
                if (r < u.valid) {
                    float a[8];
#pragma unroll
                    for (int n = 0; n < 2; ++n)
#pragma unroll
                        for (int j = 0; j < 4; ++j) { const float g = acc[ai][0][m][n][j], up = acc[ai][1][m][n][j]; a[n * 4 + j] = g * __builtin_amdgcn_rcpf(1.f + __builtin_amdgcn_exp2f(-g * LOG2E)) * up; }
                    u32x4 w; w.x = cvtpk(a[0], a[1]); w.y = cvtpk(a[2], a[3]); w.z = cvtpk(a[4], a[5]); w.w = cvtpk(a[6], a[7]);
                    *(u32x4*)(ACT + (size_t)(u.am + r) * DFF + col0) = w;
                }
            }
    }
};
struct EpiDown {
    static constexpr bool PERM = true, AFTER_DRAIN = false;
    bf16_t* YB; const float* sgate;
    __device__ __forceinline__ void operator()(const f32x4 (&acc)[2][2][4][2], const Unit& u, int wr, int wc, int fr, int fq) const {
        const int col0 = u.pn * 256 + wc * 32 + 8 * fq;
#pragma unroll
        for (int ai = 0; ai < 2; ++ai)
#pragma unroll
            for (int m = 0; m < 4; ++m) {
                const int r = ai * 128 + wr * 64 + m * 16 + fr;
                if (r < u.valid) {
                    const float gt = sgate[u.am + r];
                    bf16_t* rowp = YB + (size_t)(u.am + r) * DM + col0;
#pragma unroll
                    for (int bj = 0; bj < 2; ++bj) {
                        const f32x4 v0 = acc[ai][bj][m][0] * gt, v1 = acc[ai][bj][m][1] * gt;
                        u32x4 w; w.x = cvtpk(v0[0], v0[1]); w.y = cvtpk(v0[2], v0[3]); w.z = cvtpk(v1[0], v1[1]); w.w = cvtpk(v1[2], v1[3]);
                        *(u32x4*)(rowp + bj * 128) = w;
                    }
                }
            }
    }
};

template <class F> __device__ __forceinline__ void tr_item(const F& f, int K, bf16_t* WT, LAS float* scr, int kb, int nb, int lane) {
    const int k0 = 64 * kb, n0 = 32 * nb;
#pragma unroll 8
    for (int i = 0; i < 32; ++i) { const int kk = 2 * i + (lane >> 5); scr[kk * 33 + (lane & 31)] = f(k0 + kk, n0 + (lane & 31)); }
    LDS_WAIT(); asm volatile("" ::: "memory");
    const int c = lane & 7;
#pragma unroll
    for (int j = 0; j < 4; ++j) { const int n = (lane >> 3) + 8 * j; const LAS float* s = scr + (8 * c) * 33 + n;
        u32x4 o; o.x = pk2(s[0 * 33], s[1 * 33]); o.y = pk2(s[2 * 33], s[3 * 33]); o.z = pk2(s[4 * 33], s[5 * 33]); o.w = pk2(s[6 * 33], s[7 * 33]);
        *(u32x4*)(WT + (size_t)(n0 + n) * K + k0 + 8 * c) = o; }
    LDS_WAIT(); asm volatile("" ::: "memory");
}
__device__ __forceinline__ float lam_init_of(int l) { return l == 0 ? 0.2f : (0.8f - 0.6f * 0.74081822068171788f); }

struct FWin { const float* w;
    __device__ __forceinline__ float operator()(int k, int n) const {
        const int pn = n >> 8; int col = n;
        if ((pn <= 3) || (pn >= 7 && pn <= 12)) { const int cw = n & 63; col = (n & ~63) + 32 * ((cw >> 2) & 1) + 4 * (cw >> 3) + (cw & 3); }
        return w[(size_t)k * INC + col]; } };
struct FWout { const float* w; const float* bna; const float* subln; const float* wpool; const float* pscale; float omli;
    __device__ __forceinline__ float operator()(int k, int n) const {
        if (k < 768) return bna[k] * w[(size_t)k * DM + n];
        if (k >= 1280) return subln[(k - 1280) & 127] * omli * w[(size_t)k * DM + n];
        const int g = (k - 768) >> 7, kk = (k - 768) & 127; const float* wp = wpool + ((size_t)g * 128 + kk) * 128; const float* ps = pscale + g * 128; const float* wo = w + (size_t)(768 + g * 128) * DM + n;
        float s = 0.f;
        for (int j = 0; j < 128; ++j) s += wp[j] * ps[j] * wo[(size_t)j * DM];
        return s; } };
struct FWgu { const float* w;
    __device__ __forceinline__ float operator()(int k, int n) const {
        const int col = 128 * (n >> 8) + (n & 127);
        return w[(size_t)k * DFF + col]; } };
struct FWdn { const float* w;
    __device__ __forceinline__ float operator()(int k, int n) const { return w[(size_t)k * DM + n]; } };
struct FWr { const float* wrg; const float* wre;
    __device__ __forceinline__ float operator()(int k, int n) const {
        const int hl = n >= 48, j = hl ? n - 48 : n;
        float v = 0.f; if (j < 4) v = wrg[k * 4 + j]; else if (j < 36) v = wre[k * 32 + (j - 4)];
        const float hi = bf2f(f2bf(v)); return hl ? v - hi : v; } };

constexpr int I_WIN = 32 * 128, I_WOUT = 32 * 64, I_WR = 32 * 3, I_WGU1 = 32 * 32, I_WDN1 = 8 * 64;
constexpr int I_LAYER = I_WIN + I_WOUT + I_WR + NEXP * I_WGU1 + NEXP * I_WDN1;
__device__ __forceinline__ void phase_prologue(Ctx& C) {
    LAS float* scr = (LAS float*)(C.lds + C.wave * 16384);
    const int gw = C.bid * 8 + C.wave, NGW = C.G * 8;
    for (int it = gw; it < NLAYER * I_LAYER; it += NGW) {
        const int l = it / I_LAYER; int r = it % I_LAYER;
        if (r < I_WIN) { FWin f{C.in[IN_WIN] + (size_t)l * DM * INC}; tr_item(f, DM, (bf16_t*)(C.ws + WS_WIN) + (size_t)l * INC * DM, scr, r / 128, r % 128, C.lane); continue; } r -= I_WIN;
        if (r < I_WOUT) { FWout f{C.in[IN_WOUT] + (size_t)l * DM * DM, C.in[IN_BNA] + l * 768, C.in[IN_SUBLN] + l * 128, C.in[IN_WPOOL] + (size_t)l * 4 * 128 * 128, C.in[IN_PSCALE] + l * 512, 1.f - lam_init_of(l)};
            tr_item(f, DM, (bf16_t*)(C.ws + WS_WOUT) + (size_t)l * DM * DM, scr, r / 64, r % 64, C.lane); continue; } r -= I_WOUT;
        if (r < I_WR) { FWr f{C.in[IN_WRG] + (size_t)l * DM * 4, C.in[IN_WRE] + (size_t)l * DM * 32}; tr_item(f, DM, (bf16_t*)(C.ws + WS_WR) + (size_t)l * 96 * DM, scr, r / 3, r % 3, C.lane); continue; } r -= I_WR;
        if (r < NEXP * I_WGU1) { const int e = r / I_WGU1, q = r % I_WGU1; const size_t eo = ((size_t)l * NEXP + e) * DM * DFF;
            FWgu f{(((q % 32) & 4) ? C.in[IN_WU] : C.in[IN_WG]) + eo}; tr_item(f, DM, (bf16_t*)(C.ws + WS_WGU) + ((size_t)l * NEXP + e) * 1024 * DM, scr, q / 32, q % 32, C.lane); continue; } r -= NEXP * I_WGU1;
        { const int e = r / I_WDN1, q = r % I_WDN1; FWdn f{C.in[IN_WD] + ((size_t)l * NEXP + e) * DFF * DM}; tr_item(f, DFF, (bf16_t*)(C.ws + WS_WDN) + ((size_t)l * NEXP + e) * DM * DFF, scr, q / 64, q % 64, C.lane); }
    }
    float* cosT = (float*)(C.ws + WS_COS); float* sinT = (float*)(C.ws + WS_SIN); const int* pos = (const int*)C.in[IN_POS];
    for (int i = C.bid * 512 + C.tid; i < T * 32; i += C.G * 512) {
        const int tok = i >> 5, fi = i & 31;
        double inv = 1.0; for (int q = 0; q < fi; ++q) inv *= 0.74989420933245582;
        const double rev = (double)pos[tok] * inv * 0.15915494309189535;
        const float fr = (float)(rev - __builtin_floor(rev));
        cosT[i] = __builtin_amdgcn_cosf(fr); sinT[i] = __builtin_amdgcn_sinf(fr);
    }
}

__device__ __forceinline__ void load_starts(Ctx& C, int l) {
    if (C.tid == 0) { const unsigned* cur = (const unsigned*)(C.ws + WS_CTL) + CW_CUR + l * 32 * 64; int s = 0, tp = 0;
        for (int e = 0; e < NEXP; ++e) { C.misc[MI_ST + e] = s; C.misc[MI_TP + e] = tp; const int c = (int)__hip_atomic_load(cur + e * 64, __ATOMIC_RELAXED, __HIP_MEMORY_SCOPE_AGENT); s += c; tp += (c + 255) >> 8; }
        C.misc[MI_ST + NEXP] = s; C.misc[MI_TP + NEXP] = tp; }
    __syncthreads();
}
template <int MODE> __device__ __forceinline__ void phase_norm(Ctx& C, const float* src, float* dsth, const float* g, bf16_t* hn, float* outf) {
    const int gw = C.bid * 8 + C.wave, NGW = C.G * 8, lane = C.lane;
    const bf16_t* YB = (const bf16_t*)(C.ws + WS_PROJ);
    const int* toke = (const int*)(C.ws + WS_TOKE); const int* tokp = (const int*)(C.ws + WS_TOKP);
    for (int m = gw; m < T; m += NGW) {
        const f32x4* xr = (const f32x4*)(src + (size_t)m * DM) + lane;
        f32x4 v[8];
#pragma unroll
        for (int j = 0; j < 8; ++j) v[j] = xr[64 * j];
        if (MODE >= 1) {
            const int r0 = C.misc[MI_ST + toke[2 * m]] + tokp[2 * m], r1 = C.misc[MI_ST + toke[2 * m + 1]] + tokp[2 * m + 1];
            const u32x2* y0 = (const u32x2*)(YB + (size_t)r0 * DM) + lane; const u32x2* y1 = (const u32x2*)(YB + (size_t)r1 * DM) + lane;
#pragma unroll
            for (int j = 0; j < 8; ++j) { const u32x2 a = y0[64 * j], b = y1[64 * j];
                v[j][0] += bf2f(a.x & 0xffffu) + bf2f(b.x & 0xffffu); v[j][1] += bf2f(a.x >> 16) + bf2f(b.x >> 16);
                v[j][2] += bf2f(a.y & 0xffffu) + bf2f(b.y & 0xffffu); v[j][3] += bf2f(a.y >> 16) + bf2f(b.y >> 16); }
        }
        if (MODE == 1) { f32x4* hr = (f32x4*)(dsth + (size_t)m * DM) + lane;
#pragma unroll
            for (int j = 0; j < 8; ++j) hr[64 * j] = v[j]; }
        float s = 0.f;
#pragma unroll
        for (int j = 0; j < 8; ++j) s += (v[j][0] * v[j][0] + v[j][1] * v[j][1]) + (v[j][2] * v[j][2] + v[j][3] * v[j][3]);
        const float rs = 1.0f / sqrtf(wave_sum(s) * (1.f / DM) + 1e-6f);
        const f32x4* gr = (const f32x4*)g + lane;
        if (MODE == 2) { f32x4* o = (f32x4*)(outf + (size_t)m * DM) + lane;
#pragma unroll
            for (int j = 0; j < 8; ++j) o[64 * j] = v[j] * rs * gr[64 * j]; }
        else { u32x2* o = (u32x2*)(hn + (size_t)m * DM) + lane;
#pragma unroll
            for (int j = 0; j < 8; ++j) { const f32x4 w = v[j] * rs * gr[64 * j]; u32x2 p; p.x = cvtpk(w[0], w[1]); p.y = cvtpk(w[2], w[3]); o[64 * j] = p; } }
    }
}

__device__ __forceinline__ int crow(int r, int hi) { return (r & 3) + 8 * (r >> 2) + 4 * hi; }
typedef short v4i16_t __attribute__((ext_vector_type(4)));
__device__ __forceinline__ s16x4 vtr(lds_cptr p) { return __builtin_bit_cast(s16x4, __builtin_amdgcn_ds_read_tr16_b64_v4i16((LAS v4i16_t*)p)); }
__device__ __forceinline__ float swapmax(float v) { auto rr = __builtin_amdgcn_permlane32_swap(__float_as_uint(v), __float_as_uint(v), false, false); return fmaxf(__uint_as_float(rr[0]), __uint_as_float(rr[1])); }
__device__ __forceinline__ float swapsum(float v) { auto rr = __builtin_amdgcn_permlane32_swap(__float_as_uint(v), __float_as_uint(v), false, false); return __uint_as_float(rr[0]) + __uint_as_float(rr[1]); }

template <int NDH, int MASK>
__device__ __forceinline__ void attn_tile(f32x16 (&o)[NDH], float& m, float& l, const bf16x8 (&qr)[4], lds_cptr Kslot, lds_cptr Vslot, LAS float* wsf, int kbase, int qrow, int lane) {
    const int r32 = lane & 31, hi = lane >> 5;
    const lds_cptr kp = Kslot + hi * 1024 + r32 * 16;
    f32x16 p0 = {}, p1 = {};
#pragma unroll
    for (int d0 = 0; d0 < 4; ++d0) {
        const bf16x8 b0 = *(const LAS bf16x8*)(kp + d0 * 2048), b1 = *(const LAS bf16x8*)(kp + d0 * 2048 + 512);
        p0 = __builtin_amdgcn_mfma_f32_32x32x16_bf16(b0, qr[d0], p0, 0, 0, 0);
        p1 = __builtin_amdgcn_mfma_f32_32x32x16_bf16(b1, qr[d0], p1, 0, 0, 0);
    }
    __builtin_amdgcn_sched_barrier(0);
    if (MASK) {
#pragma unroll
        for (int r = 0; r < 16; ++r) {
            const int k0 = kbase + crow(r, hi), k1 = k0 + 32;
            bool v0 = k0 <= qrow, v1 = k1 <= qrow;
            if (MASK == 2) { v0 = v0 && (qrow - k0 < 128); v1 = v1 && (qrow - k1 < 128); }
            p0[r] = v0 ? p0[r] : -__builtin_inff(); p1[r] = v1 ? p1[r] : -__builtin_inff();
        }
    }
    float mx = fmaxf(p0[0], p1[0]);
#pragma unroll
    for (int r = 1; r < 16; ++r) mx = fmaxf(mx, fmaxf(p0[r], p1[r]));
    mx = swapmax(mx);
    const float mn = fmaxf(m, mx);
    const float alpha = __builtin_amdgcn_exp2f(m - mn);
    m = mn;
    float s = 0.f;
#pragma unroll
    for (int r = 0; r < 16; ++r) { p0[r] = __builtin_amdgcn_exp2f(p0[r] - mn); p1[r] = __builtin_amdgcn_exp2f(p1[r] - mn); s += p0[r] + p1[r]; }
    l = l * alpha + s;
    if (__any(alpha != 1.0f)) {
        if (hi == 0) wsf[r32] = alpha;
#pragma unroll
        for (int r = 0; r < 16; ++r) { const float a = wsf[crow(r, hi)];
#pragma unroll
            for (int dh = 0; dh < NDH; ++dh) o[dh][r] *= a; }
    }
    __builtin_amdgcn_sched_barrier(0);
    u32x4 pw[4];
    pw[0] = (u32x4){cvtpk(p0[0], p0[1]), cvtpk(p0[2], p0[3]), cvtpk(p0[4], p0[5]), cvtpk(p0[6], p0[7])};
    pw[1] = (u32x4){cvtpk(p0[8], p0[9]), cvtpk(p0[10], p0[11]), cvtpk(p0[12], p0[13]), cvtpk(p0[14], p0[15])};
    pw[2] = (u32x4){cvtpk(p1[0], p1[1]), cvtpk(p1[2], p1[3]), cvtpk(p1[4], p1[5]), cvtpk(p1[6], p1[7])};
    pw[3] = (u32x4){cvtpk(p1[8], p1[9]), cvtpk(p1[10], p1[11]), cvtpk(p1[12], p1[13]), cvtpk(p1[14], p1[15])};
    __builtin_amdgcn_sched_barrier(0);
    const lds_cptr vp = Vslot + ((lane >> 4) & 1) * 32 + (lane & 3) * 8 + (4 * hi + ((lane & 15) >> 2)) * 64;
#pragma unroll
    for (int dh = 0; dh < NDH; ++dh)
#pragma unroll
        for (int ks = 0; ks < 4; ++ks) {
            const s16x4 lo = vtr(vp + dh * 4096 + ks * 1024), hh = vtr(vp + dh * 4096 + ks * 1024 + 512);
            const bf16x8 vb = (bf16x8){lo[0], lo[1], lo[2], lo[3], hh[0], hh[1], hh[2], hh[3]};
            o[dh] = __builtin_amdgcn_mfma_f32_32x32x16_bf16(__builtin_bit_cast(bf16x8, pw[ks]), vb, o[dh], 0, 0, 0);
            if (ks == 3) __builtin_amdgcn_sched_barrier(0);
        }
}

__device__ __forceinline__ void diff_unit(Ctx& C, int b, int h, int qb, float lam) {
    const int lane = C.lane, wid = C.wave, r32 = lane & 31, hi = lane >> 5, c = wid >> 2, wq = wid & 3;
    const int q0w = qb * 128 + wq * 32;
    const char* Pb = (const char*)(C.ws + WS_PROJ) + (size_t)b * SEQ * INC * 2;
    bf16x8 qr[4];
    { const unsigned qo = (unsigned)(((q0w + r32) * INC + C_QC + (2 * h + c) * 64 + hi * 8) * 2);
#pragma unroll
      for (int d0 = 0; d0 < 4; ++d0) qr[d0] = *(const bf16x8*)(Pb + (qo + d0 * 32)); }
    const int NT = 2 * (qb + 1);
    LAS unsigned char* L = C.lds; LAS float* wsf = (LAS float*)(L + LDS_WSF + wid * 256);
    const unsigned kofs = (unsigned)((lane * INC + C_KC + (2 * h) * 64 + wid * 8) * 2);
    const unsigned vofs0 = (unsigned)(((16 * (wid & 3) + (lane >> 2)) * INC + C_VC + h * 128 + (wid >> 2) * 32 + (lane & 3) * 8) * 2);
    const unsigned vofs1 = vofs0 + 64 * 2;
    const int kdst = wid * 1024 + lane * 16;
    u32x4 rk0, rk1, rv0, rv1;
#define DIFF_LOAD(t) do { const char* Pt_ = Pb + (size_t)(t) * (64 * INC * 2); rk0 = *(const u32x4*)(Pt_ + kofs); rk1 = *(const u32x4*)(Pt_ + (kofs + 128)); rv0 = *(const u32x4*)(Pt_ + vofs0); rv1 = *(const u32x4*)(Pt_ + vofs1); } while (0)
#define DIFF_WRITE(bo) do { *(LAS u32x4*)(L + (bo) + kdst) = rk0; *(LAS u32x4*)(L + (bo) + 8192 + kdst) = rk1; *(LAS u32x4*)(L + (bo) + 16384 + kdst) = rv0; *(LAS u32x4*)(L + (bo) + 24576 + kdst) = rv1; } while (0)
    DIFF_LOAD(0); DIFF_WRITE(0); __syncthreads();
    f32x16 o[4]; o[0] = f32x16{}; o[1] = f32x16{}; o[2] = f32x16{}; o[3] = f32x16{};
    float m = -1e30f, lsum = 0.f;
#pragma unroll 1
    for (int t = 0; t < NT; ++t) {
        const int tn = (t + 1 < NT) ? t + 1 : t;
        DIFF_LOAD(tn);
        const int kbase = 64 * t, bo = (t & 1) * 32768;
        if (kbase <= q0w + 31) {
            const lds_cptr Ks = (lds_cptr)(L + bo + c * 8192), Vs = (lds_cptr)(L + bo + 16384);
            attn_tile<4, 1>(o, m, lsum, qr, Ks, Vs, wsf, kbase, q0w + r32, lane);
        }
        DIFF_WRITE(((t + 1) & 1) * 32768);
        __syncthreads();
    }
#undef DIFF_LOAD
#undef DIFF_WRITE
    lsum = swapsum(lsum);
    if (hi == 0) wsf[r32] = lsum;
    LAS float* X = (LAS float*)(L + 65536) + wq * 4096 + lane;
    if (c == 1) {
#pragma unroll
        for (int r = 0; r < 16; ++r) { const float rl = 1.0f / wsf[crow(r, hi)];
#pragma unroll
            for (int dh = 0; dh < 4; ++dh) X[(dh * 16 + r) * 64] = o[dh][r] * rl; }
    }
    __syncthreads();
    if (c == 0) {
        char* Cb = (char*)(C.ws + WS_CAT) + (size_t)b * SEQ * DM * 2;
        const unsigned co = (unsigned)(((q0w + 4 * hi) * DM + 1280 + h * 128 + r32) * 2);
#pragma unroll
        for (int r = 0; r < 16; ++r) {
            const float rl = 1.0f / wsf[crow(r, hi)];
            float s = 0.f;
#pragma unroll
            for (int dh = 0; dh < 4; ++dh) { const float d = o[dh][r] * rl - lam * X[(dh * 16 + r) * 64]; o[dh][r] = d; s += d * d; }
#pragma unroll
            for (int off = 1; off < 32; off <<= 1) s += __shfl_xor(s, off);
            const float rn = 1.0f / sqrtf(s * (1.f / 128.f) + 1e-5f);
            const unsigned ro = co + (unsigned)(((r & 3) + 8 * (r >> 2)) * DM * 2);
#pragma unroll
            for (int dh = 0; dh < 4; ++dh) *(bf16_t*)(Cb + (ro + dh * 64)) = (bf16_t)f2bf(o[dh][r] * rn);
        }
    }
}

__device__ __forceinline__ void swa_task(Ctx& C, int l, int b, int q0, int head, f32x16 (&o)[2], float (&ssq)[16]) {
    const int lane = C.lane, wid = C.wave, r32 = lane & 31, hi = lane >> 5;
    const char* Pb = (const char*)(C.ws + WS_PROJ) + (size_t)b * SEQ * INC * 2;
    LAS unsigned char* Lw = C.lds + wid * 16384; LAS float* wsf = (LAS float*)(C.lds + LDS_WSF + wid * 256);
    const int kvh = head / 3;
    bf16x8 qr[4];
    { const unsigned qo = (unsigned)(((q0 + r32) * INC + C_QA + head * 64 + hi * 8) * 2);
#pragma unroll
      for (int d0 = 0; d0 < 4; ++d0) qr[d0] = *(const bf16x8*)(Pb + (qo + d0 * 32)); }
    o[0] = f32x16{}; o[1] = f32x16{};
    float m = C.in[IN_SINKS][l * 12 + head] * LOG2E, lsum = (hi == 0) ? 1.f : 0.f;
    const int tlo = (q0 >= 127 ? q0 - 127 : 0) >> 6, thi = (q0 + 31) >> 6;
    const unsigned kofs = (unsigned)((lane * INC + C_KA + kvh * 64) * 2);
    const unsigned vofs = (unsigned)(((lane >> 2) * INC + C_VA + kvh * 64 + (lane & 3) * 8) * 2);
    for (int t = tlo; t <= thi; ++t) {
        const char* Pt = Pb + (size_t)t * (64 * INC * 2);
        u32x4 kk[8], vv[8];
#pragma unroll
        for (int c8 = 0; c8 < 8; ++c8) kk[c8] = *(const u32x4*)(Pt + (kofs + c8 * 16));
#pragma unroll
        for (int i = 0; i < 8; ++i) vv[i] = *(const u32x4*)(Pt + (vofs + (16 * (i & 3) * INC + (i >> 2) * 32) * 2));
#pragma unroll
        for (int c8 = 0; c8 < 8; ++c8) *(LAS u32x4*)(Lw + c8 * 1024 + lane * 16) = kk[c8];
#pragma unroll
        for (int i = 0; i < 8; ++i) *(LAS u32x4*)(Lw + 8192 + i * 1024 + lane * 16) = vv[i];
        attn_tile<2, 2>(o, m, lsum, qr, (lds_cptr)Lw, (lds_cptr)(Lw + 8192), wsf, 64 * t, q0 + r32, lane);
    }
    lsum = swapsum(lsum);
    if (hi == 0) wsf[r32] = lsum;
#pragma unroll
    for (int r = 0; r < 16; ++r) { const float rl = 1.0f / wsf[crow(r, hi)]; o[0][r] *= rl; o[1][r] *= rl; float s = o[0][r] * o[0][r] + o[1][r] * o[1][r];
#pragma unroll
        for (int off = 1; off < 32; off <<= 1) s += __shfl_xor(s, off);
        ssq[r] = s; }
}
__device__ __forceinline__ void swa_store(Ctx& C, int b, int q0, int head, const f32x16 (&o)[2]) {
    const int lane = C.lane, r32 = lane & 31, hi = lane >> 5;
    char* Cb = (char*)(C.ws + WS_CAT) + (size_t)b * SEQ * DM * 2; const LAS float* tot = (const LAS float*)(C.misc + MI_SSQ) + 12 * 32;
    const unsigned co = (unsigned)(((q0 + 4 * hi) * DM + head * 64 + r32) * 2);
#pragma unroll
    for (int r = 0; r < 16; ++r) { const int qq = (r & 3) + 8 * (r >> 2); const float rn = tot[qq + 4 * hi];
        const unsigned ro = co + (unsigned)(qq * DM * 2);
        *(bf16_t*)(Cb + ro) = (bf16_t)f2bf(o[0][r] * rn); *(bf16_t*)(Cb + (ro + 64)) = (bf16_t)f2bf(o[1][r] * rn); }
}
__device__ __forceinline__ void swa_unit(Ctx& C, int l, int b, int jb) {
    const int lane = C.lane, wid = C.wave, r32 = lane & 31, hi = lane >> 5;
    const int q0 = jb * 32;
    LAS float* ssqL = (LAS float*)(C.misc + MI_SSQ);
    f32x16 oa[2], ob[2]; float sa[16], sb[16];
    swa_task(C, l, b, q0, wid, oa, sa);
    if (r32 == 0) {
#pragma unroll
        for (int r = 0; r < 16; ++r) ssqL[wid * 32 + crow(r, hi)] = sa[r]; }
    if (wid < 4) {
        swa_task(C, l, b, q0, 8 + wid, ob, sb);
        if (r32 == 0) {
#pragma unroll
            for (int r = 0; r < 16; ++r) ssqL[(8 + wid) * 32 + crow(r, hi)] = sb[r]; }
    }
    __syncthreads();
    if (C.tid < 32) { float s = 0.f;
#pragma unroll
        for (int hh = 0; hh < 12; ++hh) s += ssqL[hh * 32 + C.tid];
        ssqL[12 * 32 + C.tid] = 1.0f / sqrtf(s * (1.f / 768.f) + 1e-6f); }
    __syncthreads();
    swa_store(C, b, q0, wid, oa);
    if (wid < 4) swa_store(C, b, q0, 8 + wid, ob);
    __syncthreads();
}

__device__ __forceinline__ void pool_unit(Ctx& C, int b, int blk) {
    const int cg8 = C.tid & 63, ts = C.tid >> 6;
    const int w = 2 << (cg8 >> 4);
    const size_t rowbase = (size_t)b * SEQ;
    const bf16_t* P = (const bf16_t*)(C.ws + WS_PROJ) + C_UB + 8 * cg8; bf16_t* CAT = (bf16_t*)(C.ws + WS_CAT) + 768 + 8 * cg8;
    for (int i = 0; i < 4; ++i) {
        const int s = blk * 32 + ts * 4 + i;
        float acc[8];
#pragma unroll
        for (int j = 0; j < 8; ++j) acc[j] = 0.f;
        const int lo = (s - w + 1) > 0 ? (s - w + 1) : 0;
        u32x4 self = {0, 0, 0, 0};
        for (int sp = lo; sp <= s; ++sp) { const u32x4 v = *(const u32x4*)(P + (rowbase + sp) * INC); self = v;
            acc[0] += bf2f(v.x & 0xffffu); acc[1] += bf2f(v.x >> 16); acc[2] += bf2f(v.y & 0xffffu); acc[3] += bf2f(v.y >> 16);
            acc[4] += bf2f(v.z & 0xffffu); acc[5] += bf2f(v.z >> 16); acc[6] += bf2f(v.w & 0xffffu); acc[7] += bf2f(v.w >> 16); }
        const float rc = 1.0f / (float)(s - lo + 1);
        u32x4 ov;
        ov.x = pk2(acc[0] * rc - bf2f(self.x & 0xffffu), acc[1] * rc - bf2f(self.x >> 16)); ov.y = pk2(acc[2] * rc - bf2f(self.y & 0xffffu), acc[3] * rc - bf2f(self.y >> 16));
        ov.z = pk2(acc[4] * rc - bf2f(self.z & 0xffffu), acc[5] * rc - bf2f(self.z >> 16)); ov.w = pk2(acc[6] * rc - bf2f(self.w & 0xffffu), acc[7] * rc - bf2f(self.w >> 16));
        *(u32x4*)(CAT + (rowbase + s) * DM) = ov;
    }
}

#ifndef MIXSEL
#define MIXSEL 7
#endif
constexpr int NU_DIFF = 2 * 6 * 64, NU_SWA = 2 * 256, NU_POOL = 2 * 256, NU_MIX = NU_DIFF + NU_SWA + NU_POOL;
__device__ __forceinline__ void phase_mixers(Ctx& C, int l) {
    if (C.tid == 0) {
        float s1 = 0.f, s2 = 0.f;
        for (int i = 0; i < 64; ++i) { s1 += C.in[IN_LQ1][l * 64 + i] * C.in[IN_LK1][l * 64 + i]; s2 += C.in[IN_LQ2][l * 64 + i] * C.in[IN_LK2][l * 64 + i]; }
        C.misc[1] = __float_as_int(__expf(s1) - __expf(s2) + lam_init_of(l));
    }
    __syncthreads();
    const float lam = __int_as_float(C.misc[1]);
    unsigned* qctr = (unsigned*)(C.ws + WS_CTL) + CW_QCTR + 64 * l;
    for (;;) {
        if (C.tid == 0) C.misc[0] = (int)__hip_atomic_fetch_add(qctr, 1u, __ATOMIC_RELAXED, __HIP_MEMORY_SCOPE_AGENT);
        __syncthreads();
        const int u = C.misc[0];
        __syncthreads();
        if (u >= NU_MIX) break;
        if (MIXSEL & 1) if (u < NU_DIFF) { const int qb = 63 - u / 12, bh = u % 12; diff_unit(C, bh / 6, bh % 6, qb, lam); }
        if (MIXSEL & 2) if (u >= NU_DIFF && u < NU_DIFF + NU_SWA) { const int v = u - NU_DIFF; swa_unit(C, l, v >> 8, v & 255); }
        if (MIXSEL & 4) if (u >= NU_DIFF + NU_SWA) { const int v = u - NU_DIFF - NU_SWA; pool_unit(C, v >> 8, v & 255); }
    }
}

constexpr int XT_PITCH = 4112;
__device__ __forceinline__ void phase_router(Ctx& C, int l) {
    const int lane = C.lane, wid = C.wave, tid = C.tid;
    const float* h = C.out; const float* g = C.in[IN_FNORM] + l * DM;
    bf16_t* XS = (bf16_t*)(C.ws + WS_HN); const bf16_t* WR = (const bf16_t*)(C.ws + WS_WR) + (size_t)l * 96 * DM;
    unsigned* cur = (unsigned*)(C.ws + WS_CTL) + CW_CUR + l * 32 * 64;
    int* toke = (int*)(C.ws + WS_TOKE); float* tokg = (float*)(C.ws + WS_TOKG); int* tokp = (int*)(C.ws + WS_TOKP);
    int* rowtok = (int*)(C.ws + WS_ROWTOK); float* rowgate = (float*)(C.ws + WS_ROWGATE);
    LAS unsigned char* L = C.lds;
    for (int unit = C.bid; unit < T / 32; unit += C.G) {
        const int tok0 = unit * 32;
#pragma unroll 1
        for (int rr = 0; rr < 4; ++rr) {
            const int row = wid * 4 + rr; const size_t m = (size_t)tok0 + row;
            const f32x4* xr = (const f32x4*)(h + m * DM) + lane; f32x4 v[8]; float s = 0.f;
#pragma unroll
            for (int j = 0; j < 8; ++j) { v[j] = xr[64 * j]; s += (v[j][0] * v[j][0] + v[j][1] * v[j][1]) + (v[j][2] * v[j][2] + v[j][3] * v[j][3]); }
            const float rs = 1.0f / sqrtf(wave_sum(s) * (1.f / DM) + 1e-6f);
            const f32x4* gr = (const f32x4*)g + lane; u32x2* o = (u32x2*)(XS + m * DM) + lane;
#pragma unroll
            for (int j = 0; j < 8; ++j) { const f32x4 w = v[j] * rs * gr[64 * j]; u32x2 p; p.x = cvtpk(w[0], w[1]); p.y = cvtpk(w[2], w[3]); o[64 * j] = p;
                *(LAS u32x2*)(L + row * XT_PITCH + (4 * lane + 256 * j) * 2) = p; }
        }
        if (tid < 32) C.misc[MI_LCNT + tid] = 0;
        __syncthreads();
        f32x4 acc[2][3];
#pragma unroll
        for (int rt = 0; rt < 2; ++rt)
#pragma unroll
            for (int ct = 0; ct < 3; ++ct) acc[rt][ct] = (f32x4){0.f, 0.f, 0.f, 0.f};
#pragma unroll 2
        for (int ks = 0; ks < 8; ++ks) {
            const int kk = 256 * wid + 32 * ks + 8 * (lane >> 4);
            bf16x8 a[2];
#pragma unroll
            for (int rt = 0; rt < 2; ++rt) a[rt] = *(const LAS bf16x8*)(L + (16 * rt + (lane & 15)) * XT_PITCH + kk * 2);
#pragma unroll
            for (int ct = 0; ct < 3; ++ct)
#pragma unroll
                for (int hl = 0; hl < 2; ++hl) {
                    const bf16x8 bb = *(const bf16x8*)(WR + (size_t)(hl * 48 + 16 * ct + (lane & 15)) * DM + kk);
#pragma unroll
                    for (int rt = 0; rt < 2; ++rt) acc[rt][ct] = __builtin_amdgcn_mfma_f32_16x16x32_bf16(a[rt], bb, acc[rt][ct], 0, 0, 0);
                }
        }
        __syncthreads();
        LAS float* RED = (LAS float*)L;
#pragma unroll
        for (int rt = 0; rt < 2; ++rt)
#pragma unroll
            for (int ct = 0; ct < 3; ++ct)
#pragma unroll
                for (int q = 0; q < 4; ++q) RED[(wid * 32 + 16 * rt + 4 * (lane >> 4) + q) * 48 + 16 * ct + (lane & 15)] = acc[rt][ct][q];
        __syncthreads();
        LAS float* LG = RED + 8 * 32 * 48;
        for (int i = tid; i < 32 * 48; i += 512) { float sacc = 0.f;
#pragma unroll
            for (int w8 = 0; w8 < 8; ++w8) sacc += RED[w8 * 32 * 48 + i];
            LG[i] = sacc; }
        __syncthreads();
        int e0 = 0, e1 = 0, rk0 = 0, rk1 = 0; float g0 = 0.f, g1 = 0.f;
        if (tid < 32) {
            const LAS float* lg = LG + tid * 48;
            const float* brg = C.in[IN_BRG] + l * 4; const float* bre = C.in[IN_BRE] + l * 32;
            float gl[4]; int gsel = 0; float gm = -__builtin_inff();
#pragma unroll
            for (int j = 0; j < 4; ++j) { gl[j] = lg[j] + brg[j]; if (gl[j] > gm) { gm = gl[j]; gsel = j; } }
            float gs = 0.f;
#pragma unroll
            for (int j = 0; j < 4; ++j) gs += __expf(gl[j] - gm);
            const float pgsel = 1.0f / gs;
            float le[8];
#pragma unroll
            for (int j = 0; j < 8; ++j) le[j] = lg[4 + gsel * 8 + j] + bre[gsel * 8 + j];
            int i0 = 0; float m0 = le[0];
#pragma unroll
            for (int j = 1; j < 8; ++j) if (le[j] > m0) { m0 = le[j]; i0 = j; }
            int i1 = -1; float m1 = -__builtin_inff();
#pragma unroll
            for (int j = 0; j < 8; ++j) if (j != i0 && le[j] > m1) { m1 = le[j]; i1 = j; }
            const float p1 = __expf(m1 - m0), den = 1.0f / (1.0f + p1);
            g0 = pgsel * den; g1 = pgsel * p1 * den;
            e0 = gsel * 8 + i0; e1 = gsel * 8 + i1;
            rk0 = __hip_atomic_fetch_add((LAS int*)(C.misc + MI_LCNT) + e0, 1, __ATOMIC_RELAXED, __HIP_MEMORY_SCOPE_WORKGROUP);
            rk1 = __hip_atomic_fetch_add((LAS int*)(C.misc + MI_LCNT) + e1, 1, __ATOMIC_RELAXED, __HIP_MEMORY_SCOPE_WORKGROUP);
        }
        __syncthreads();
        if (tid < 32) { const int c = C.misc[MI_LCNT + tid]; C.misc[MI_LBASE + tid] = c ? (int)__hip_atomic_fetch_add(cur + tid * 64, (unsigned)c, __ATOMIC_RELAXED, __HIP_MEMORY_SCOPE_AGENT) : 0; }
        __syncthreads();
        if (tid < 32) {
            const int t = tok0 + tid; const int p0 = C.misc[MI_LBASE + e0] + rk0, p1 = C.misc[MI_LBASE + e1] + rk1;
            toke[2 * t] = e0; toke[2 * t + 1] = e1; tokg[2 * t] = g0; tokg[2 * t + 1] = g1; tokp[2 * t] = p0; tokp[2 * t + 1] = p1;
            rowtok[e0 * T + p0] = t; rowtok[e1 * T + p1] = t; rowgate[e0 * T + p0] = g0; rowgate[e1 * T + p1] = g1;
        }
        __syncthreads();
    }
}

__device__ __forceinline__ void phase_gather(Ctx& C, int l) {
    load_starts(C, l);
    const int gw = C.bid * 8 + C.wave, NGW = C.G * 8, lane = C.lane;
    const bf16_t* XS = (const bf16_t*)(C.ws + WS_HN); bf16_t* XSS = (bf16_t*)(C.ws + WS_XSS);
    const int* rowtok = (const int*)(C.ws + WS_ROWTOK); const float* rowgate = (const float*)(C.ws + WS_ROWGATE); float* sgate = (float*)(C.ws + WS_SGATE);
    for (int ci = gw; ci < NASSIGN; ci += NGW) {
        int e = 0;
        while (e < 31 && C.misc[MI_ST + e + 1] <= ci) ++e;
        const int pos = ci - C.misc[MI_ST + e]; const int tok = rowtok[e * T + pos];
        const u32x4* s = (const u32x4*)(XS + (size_t)tok * DM) + lane; u32x4* d = (u32x4*)(XSS + (size_t)ci * DM) + lane;
        const u32x4 a0 = s[0], a1 = s[64], a2 = s[128], a3 = s[192];
        d[0] = a0; d[64] = a1; d[128] = a2; d[192] = a3;
        if (lane == 0) sgate[ci] = rowgate[e * T + pos];
    }
}

#ifndef PHASE_MASK
#define PHASE_MASK 0x3ff
#endif
#define HAS(k) (((PHASE_MASK) >> (k)) & 1)
struct Args { const float* in[23]; float* out; unsigned char* ws; int ph_lo, ph_hi; };
constexpr int N_PHASES = 18;

__global__ void __launch_bounds__(512, 2) mega_fwd(Args args) {
    extern __shared__ __attribute__((aligned(16))) unsigned char lds_raw[];
    cg::grid_group grid = cg::this_grid();
    Ctx C;
    C.lds = (LAS unsigned char*)lds_raw; C.misc = (volatile LAS int*)(C.lds + LDS_MISC);
    C.tid = threadIdx.x; C.lane = C.tid & 63; C.wave = __builtin_amdgcn_readfirstlane(C.tid >> 6); C.G = gridDim.x; C.bid = blockIdx.x;
    const int lo = args.ph_lo, hi = args.ph_hi;
    typedef const Args __attribute__((address_space(4)))* KArgP;
#define CTX_REFRESH() do { KArgP ka_ = (KArgP)__builtin_amdgcn_kernarg_segment_ptr(); asm volatile("" : "+s"(ka_)); \
        _Pragma("unroll") for (int i_ = 0; i_ < 23; ++i_) C.in[i_] = ka_->in[i_]; C.out = ka_->out; C.ws = ka_->ws; \
        int t_ = threadIdx.x; asm volatile("" : "+v"(t_)); C.tid = t_; C.lane = t_ & 63; C.wave = __builtin_amdgcn_readfirstlane(t_ >> 6); } while (0)
#define IN(k) (lo <= (k) && (k) < hi)
#define SEAM(k) do { if (IN(k) && IN((k) + 1)) grid.sync(); } while (0)
#define HN ((bf16_t*)(C.ws + WS_HN))
#define PROJ ((bf16_t*)(C.ws + WS_PROJ))
#define CAT ((bf16_t*)(C.ws + WS_CAT))
#define XSS ((bf16_t*)(C.ws + WS_XSS))
#define ACT ((bf16_t*)(C.ws + WS_ACT))
#define YB ((bf16_t*)(C.ws + WS_PROJ))

    if (HAS(0) && IN(0)) { CTX_REFRESH(); phase_prologue(C); } SEAM(0);
    for (int l = 0; l < NLAYER; ++l) {
        const int p0 = 1 + 8 * l;
        if (HAS(1) && IN(p0 + 0)) { CTX_REFRESH();
            if (l == 0) phase_norm<0>(C, C.in[IN_X], nullptr, C.in[IN_ANORM], HN, nullptr);
            else { load_starts(C, l - 1); phase_norm<1>(C, C.out, C.out, C.in[IN_ANORM] + l * DM, HN, nullptr); }
        } SEAM(p0 + 0);
        if (HAS(2) && IN(p0 + 1)) { CTX_REFRESH();
            pg8::Gemm g{HN, (const bf16_t*)(C.ws + WS_WIN) + (size_t)l * INC * DM, T, INC, DM}; pg8::StaticOrder S; S.init(T, INC, C.G, C.bid);
            EpiProj E{PROJ, (const float*)(C.ws + WS_COS), (const float*)(C.ws + WS_SIN)};
            pg8::gemm_phase<EpiProj, pg8::StaticOrder, true, true>(C.lds, g, S, E, C.tid);
        } SEAM(p0 + 1);
        if (HAS(3) && IN(p0 + 2)) { CTX_REFRESH(); phase_mixers(C, l); } SEAM(p0 + 2);
        if (HAS(4) && IN(p0 + 3)) { CTX_REFRESH();
            pg8::Gemm g{CAT, (const bf16_t*)(C.ws + WS_WOUT) + (size_t)l * DM * DM, T, DM, DM}; pg8::StaticOrder S; S.init(T, DM, C.G, C.bid);
            EpiResid E{l == 0 ? C.in[IN_X] : C.out, C.out};
            pg8::gemm_phase<EpiResid, pg8::StaticOrder, true, true>(C.lds, g, S, E, C.tid);
        } SEAM(p0 + 3);
        if (HAS(5) && IN(p0 + 4)) { CTX_REFRESH(); phase_router(C, l); } SEAM(p0 + 4);
        if (HAS(6) && IN(p0 + 5)) { CTX_REFRESH(); phase_gather(C, l); } SEAM(p0 + 5);
        if (HAS(7) && IN(p0 + 6)) { CTX_REFRESH();
            load_starts(C, l);
            pg8::Gemm g{XSS, (const bf16_t*)(C.ws + WS_WGU) + (size_t)l * NEXP * 1024 * DM, NASSIGN, 1024, DM};
            pg8::MoeOrder S{(const LAS int*)(C.lds + LDS_MISC) + MI_ST, (const LAS int*)(C.lds + LDS_MISC) + MI_TP, 4, 1024, C.G, C.bid};
            EpiGU E{ACT};
            pg8::gemm_phase<EpiGU, pg8::MoeOrder, true, true>(C.lds, g, S, E, C.tid);
        } SEAM(p0 + 6);
        if (HAS(8) && IN(p0 + 7)) { CTX_REFRESH();
            load_starts(C, l);
            pg8::Gemm g{ACT, (const bf16_t*)(C.ws + WS_WDN) + (size_t)l * NEXP * DM * DFF, NASSIGN, DM, DFF};
            pg8::MoeOrder S{(const LAS int*)(C.lds + LDS_MISC) + MI_ST, (const LAS int*)(C.lds + LDS_MISC) + MI_TP, 8, DM, C.G, C.bid};
            EpiDown E{YB, (const float*)(C.ws + WS_SGATE)};
            pg8::gemm_phase<EpiDown, pg8::MoeOrder, true, true>(C.lds, g, S, E, C.tid);
        } SEAM(p0 + 7);
    }
    if (HAS(9) && IN(17)) { CTX_REFRESH(); load_starts(C, NLAYER - 1); phase_norm<2>(C, C.out, nullptr, C.in[IN_FINAL], nullptr, C.out); }
#undef IN
#undef SEAM
#undef HN
#undef PROJ
#undef CAT
#undef XSS
#undef ACT
#undef YB
}

#ifndef MK_PER_PHASE
#define MK_PER_PHASE 0
#endif
extern "C" void kernel_launch(void* const* d_in, const int* in_sizes, int n_in, void* d_out, int out_size, void* d_ws, size_t ws_size, hipStream_t stream) {
    static int grid = 0;
    if (grid == 0) {
        if (n_in != 23 || in_sizes[0] != T * DM || out_size != T * DM || ws_size < WS_END) { fprintf(stderr, "kernel_launch: unexpected shapes (n_in %d, in0 %d, out %d, ws %zu < %zu)\n", n_in, n_in > 0 ? in_sizes[0] : -1, out_size, ws_size, (size_t)WS_END); grid = -1; return; }
        int dev = 0, cus = 0, per_cu = 0;
        hipGetDevice(&dev); hipDeviceGetAttribute(&cus, hipDeviceAttributeMultiprocessorCount, dev);
        if (hipFuncSetAttribute((const void*)mega_fwd, hipFuncAttributeMaxDynamicSharedMemorySize, LDS_BYTES) != hipSuccess) { fprintf(stderr, "kernel_launch: hipFuncSetAttribute failed\n"); grid = -1; return; }
        if (hipOccupancyMaxActiveBlocksPerMultiprocessor(&per_cu, (const void*)mega_fwd, 512, LDS_BYTES) != hipSuccess || per_cu < 1) { fprintf(stderr, "kernel_launch: occupancy query says %d blocks per CU\n", per_cu); per_cu = 1; }
        (void)hipGetLastError();
        grid = cus * 1;
        fprintf(stderr, "kernel_launch: %d CUs, occupancy %d/CU, grid %d\n", cus, per_cu, grid);
    }
    if (grid < 0) return;
    hipMemsetAsync((char*)d_ws + WS_CTL, 0, CTL_ZERO_BYTES, stream);
    Args a{};
    for (int i = 0; i < 23; ++i) a.in[i] = (const float*)d_in[i];
    a.out = (float*)d_out; a.ws = (unsigned char*)d_ws;
#if MK_PER_PHASE
    for (int p = 0; p < N_PHASES; ++p) {
        a.ph_lo = p; a.ph_hi = p + 1; void* kargs[] = {&a};
        hipError_t e = hipLaunchCooperativeKernel((const void*)mega_fwd, dim3(grid), dim3(512), kargs, LDS_BYTES, stream);
        if (e != hipSuccess) { fprintf(stderr, "launch of phase %d failed: %s\n", p, hipGetErrorString(e)); break; }
    }
#else
    a.ph_lo = 0; a.ph_hi = N_PHASES; void* kargs[] = {&a};
    hipError_t e = hipLaunchCooperativeKernel((const void*)mega_fwd, dim3(grid), dim3(512), kargs, LDS_BYTES, stream);
    if (e != hipSuccess) fprintf(stderr, "cooperative launch failed: %s (grid %d)\n", hipGetErrorString(e), grid);
#endif
}
```

```cpp
#include <hip/hip_runtime.h>
#include <hip/hip_cooperative_groups.h>
#include <cstdio>
#include <cstdint>
namespace cg = cooperative_groups;
#ifndef PROBE
#define PROBE 0
#endif

namespace pg8 {
#define PG8_LAS __attribute__((address_space(3)))
typedef unsigned short bf16_t;
typedef short bf16x8 __attribute__((ext_vector_type(8)));
typedef float f32x4 __attribute__((ext_vector_type(4)));
typedef unsigned u32x4 __attribute__((ext_vector_type(4)));
constexpr int BM = 256, BK = 64, HALF = 128, HTB = HALF * BK * 2  , STAGE_BYTES = 8 * HTB, NXCD = 8, WGM = 8;

__host__ __device__ __forceinline__ int lds_byte(int r, int c) { const int st = (r >> 4) * 2 + (c >> 5), rr = r & 15, cc = c & 31, ob = rr * 64 + cc * 2; return st * 1024 + (ob ^ (((ob >> 9) & 1) << 5)); }
__host__ __device__ __forceinline__ void stage_rc(int b, int& R, int& C) { const int st = b / 1024, sb = b % 1024, swz = sb ^ (((sb >> 9) & 1) << 5); R = (st >> 1) * 16 + swz / 64; C = (st & 1) * 32 + (swz % 64) / 2; }
__host__ __device__ __forceinline__ int perm32(int rho) { const int n = rho >> 4, i = rho & 15; return 8 * (i >> 2) + 4 * n + (i & 3); }

struct Unit { int am, bn, pm, pn, e, valid; };
struct Gemm { const bf16_t* A; const bf16_t* Bt; int M, N, K; };

struct StaticOrder {
    int nM, nN, nwg, G, c;
    __device__ void init(int M, int N, int G_, int c_) { nM = M / BM; nN = N / BM; nwg = nM * nN; G = G_; c = c_; }
    __device__ bool next(int i, Unit& u) const {
        const long L = (long)i * G + c; if (L >= nwg) return false;
        int wgid = (int)L; { const int q = nwg / NXCD, r = nwg % NXCD, xcd = wgid % NXCD, off = wgid / NXCD; wgid = (xcd < r ? xcd * (q + 1) : r * (q + 1) + (xcd - r) * q) + off; }
        const int nig = WGM * nN, gid = wgid / nig, fm = gid * WGM, gsz = (nM - fm) < WGM ? (nM - fm) : WGM;
        u.pm = fm + ((wgid % nig) % gsz); u.pn = (wgid % nig) / gsz; u.am = u.pm * BM; u.bn = u.pn * BM; u.e = 0; u.valid = BM; return true;
    }
    __device__ __forceinline__ void a_ready(const Unit&) const {}
    __device__ __forceinline__ void done(const Unit&) const {}
};
struct MoeOrder {
    const PG8_LAS int* ST;
    const PG8_LAS int* TP;
    int NP, NB, G, c;
    __device__ bool next(int i, Unit& u) const {
        const int U = TP[32] * NP, CH = (U + NXCD - 1) / NXCD;
        const int x = c % NXCD, j = c / NXCD + (G / NXCD) * i;
        if (j >= CH) return false;
        const int ui = x * CH + j; if (ui >= U) return false;
        const int t = ui / NP, pn = ui % NP;
        int e = 0;
        while (e < 31 && TP[e + 1] <= t) ++e;
        const int mt = t - TP[e], cnt = ST[e + 1] - ST[e];
        u.e = e; u.pm = mt; u.pn = pn; u.am = ST[e] + mt * BM; u.bn = e * NB + pn * BM; u.valid = (cnt - mt * BM) < BM ? (cnt - mt * BM) : BM; return true;
    }
    __device__ __forceinline__ void a_ready(const Unit&) const {}
    __device__ __forceinline__ void done(const Unit&) const {}
};

__device__ __forceinline__ unsigned cvt_pk_bf16(float lo, float hi) { unsigned r; asm volatile("v_cvt_pk_bf16_f32 %0, %1, %2" : "=v"(r) : "v"(lo), "v"(hi)); return r; }

template <class Epi, class Sched, bool ALIGN_EPI = false, bool SP2 = false>
__device__ __forceinline__ void gemm_phase(PG8_LAS unsigned char* lds, const Gemm g, const Sched& S, const Epi& E, const int tid) {
    const int wid = __builtin_amdgcn_readfirstlane(tid >> 6), lane = tid & 63, wr = wid >> 2, wc = wid & 3, fr = lane & 15, fq = lane >> 4;
    const int K = g.K, nt = K / BK;
    unsigned voffA[2], voffB[2];
#pragma unroll
    for (int i = 0; i < 2; ++i) { int R, C; stage_rc(tid * 16 + i * 8192, R, C); const int Rb = Epi::PERM ? ((R & ~31) + perm32(R & 31)) : R;
        voffA[i] = (unsigned)(R * K + C) * 2u; voffB[i] = (unsigned)(Rb * K + C) * 2u; }
    const size_t kstep = (size_t)(BK * 2);
    const size_t hstep = (size_t)HALF * K * 2;
    const size_t rowb = (size_t)K * 2;
    const unsigned ldsw = (unsigned)wid * 1024u;
    const int aoff = lds_byte(wr * 64 + fr, fq * 8), boff = lds_byte(wc * 32 + fr, fq * 8);
#define PG8_SA(b, h) (((b) * 2 + (h)) * HTB)
#define PG8_SB(b, h) ((4 + (b) * 2 + (h)) * HTB)
#define PG8_STAGE(bufoff, gbase, voff) do { _Pragma("unroll") for (int _i = 0; _i < 2; ++_i) \
        __builtin_amdgcn_global_load_lds((const unsigned*)((const char*)(gbase) + (voff)[_i]), (PG8_LAS unsigned*)(lds + (bufoff) + ldsw + _i * 8192), 16, 0, 0); } while (0)
#define PG8_LDA(dst, b, h) do { _Pragma("unroll") for (int m = 0; m < 4; ++m) _Pragma("unroll") for (int k = 0; k < 2; ++k) dst[m][k] = *(const PG8_LAS bf16x8*)(lds + PG8_SA(b, h) + aoff + m * 2048 + k * 1024); } while (0)
#define PG8_LDB(dst, b, h) do { _Pragma("unroll") for (int n = 0; n < 2; ++n) _Pragma("unroll") for (int k = 0; k < 2; ++k) dst[n][k] = *(const PG8_LAS bf16x8*)(lds + PG8_SB(b, h) + boff + n * 2048 + k * 1024); } while (0)
#define PG8_MMA(ai, bj, At, Bt) do { __builtin_amdgcn_s_setprio(1); _Pragma("unroll") for (int m = 0; m < 4; ++m) _Pragma("unroll") for (int n = 0; n < 2; ++n) _Pragma("unroll") for (int k = 0; k < 2; ++k) \
        acc[ai][bj][m][n] = __builtin_amdgcn_mfma_f32_16x16x32_bf16(Bt[n][k], At[m][k], acc[ai][bj][m][n], 0, 0, 0); __builtin_amdgcn_s_setprio(0); } while (0)
#define PG8_WAIT_V(n) asm volatile("s_waitcnt vmcnt(" #n ")" ::: "memory")
#define PG8_WAIT_L(n) asm volatile("s_waitcnt lgkmcnt(" #n ")" ::: "memory")
#define PG8_BAR __builtin_amdgcn_s_barrier()
#define PG8_SCHED __builtin_amdgcn_sched_barrier(0)
    Unit cur, nxt; int ui = 0;
    if (!S.next(0, cur)) return;
    f32x4 acc[2][2][4][2];
#pragma unroll
    for (int a = 0; a < 2; ++a)
#pragma unroll
        for (int b = 0; b < 2; ++b)
#pragma unroll
            for (int m = 0; m < 4; ++m)
#pragma unroll
                for (int n = 0; n < 2; ++n) acc[a][b][m][n] = (f32x4){0.f, 0.f, 0.f, 0.f};
    bf16x8 At[4][2], B0[2][2], B1[2][2];
    const char* cA = (const char*)g.A + (size_t)cur.am * rowb; const char* cB = (const char*)g.Bt + (size_t)cur.bn * rowb;
    S.a_ready(cur);
    if constexpr (SP2) {
        PG8_STAGE(PG8_SB(0, 0), cB, voffB); PG8_STAGE(PG8_SB(0, 1), cB + hstep, voffB); PG8_STAGE(PG8_SA(0, 0), cA, voffA); PG8_STAGE(PG8_SA(0, 1), cA + hstep, voffA);
        if (wr == 1) PG8_BAR;
        PG8_WAIT_V(2); PG8_BAR;
        PG8_STAGE(PG8_SB(1, 0), cB + kstep, voffB); PG8_STAGE(PG8_SA(1, 0), cA + kstep, voffA); PG8_STAGE(PG8_SB(1, 1), cB + hstep + kstep, voffB);
        PG8_WAIT_V(6); PG8_BAR;
    } else {
        PG8_STAGE(PG8_SB(0, 0), cB, voffB); PG8_STAGE(PG8_SA(0, 0), cA, voffA); PG8_STAGE(PG8_SB(0, 1), cB + hstep, voffB); PG8_STAGE(PG8_SA(0, 1), cA + hstep, voffA);
        if (wr == 1) PG8_BAR;
        PG8_WAIT_V(4); PG8_BAR;
        PG8_STAGE(PG8_SB(1, 0), cB + kstep, voffB); PG8_STAGE(PG8_SA(1, 0), cA + kstep, voffA); PG8_STAGE(PG8_SB(1, 1), cB + hstep + kstep, voffB);
        PG8_WAIT_V(6); PG8_BAR;
    }
    for (;;) {
        const bool has_next = S.next(ui + 1, nxt);
        const char* nA = has_next ? (const char*)g.A + (size_t)nxt.am * rowb : cA; const char* nB = has_next ? (const char*)g.Bt + (size_t)nxt.bn * rowb : cB;
        for (int t = 0; t < nt; t += 2) {
            const bool last = (t == nt - 2);
            const char* a1 = cA + (size_t)(t + 1) * kstep;
            const char* a2 = last ? nA : cA + (size_t)(t + 2) * kstep; const char* b2 = last ? nB : cB + (size_t)(t + 2) * kstep;
            const char* a3 = a2 + kstep; const char* b3 = b2 + kstep;
            if (last && has_next) S.a_ready(nxt);
            if constexpr (SP2) {
            PG8_LDB(B0, 0, 0); PG8_LDB(B1, 0, 1); PG8_SCHED; PG8_LDA(At, 0, 0); PG8_STAGE(PG8_SA(1, 1), a1 + hstep, voffA);
            PG8_WAIT_V(8); PG8_WAIT_L(0); PG8_BAR; PG8_MMA(0, 0, At, B0); PG8_MMA(0, 1, At, B1); PG8_BAR; PG8_SCHED;
            PG8_LDA(At, 0, 1); PG8_STAGE(PG8_SB(0, 0), b2, voffB); PG8_STAGE(PG8_SB(0, 1), b2 + hstep, voffB); PG8_STAGE(PG8_SA(0, 0), a2, voffA);
            PG8_WAIT_V(8); PG8_WAIT_L(0); PG8_BAR; PG8_MMA(1, 0, At, B0); PG8_MMA(1, 1, At, B1); PG8_BAR; PG8_SCHED;
            PG8_LDB(B0, 1, 0); PG8_LDB(B1, 1, 1); PG8_SCHED; PG8_LDA(At, 1, 0); PG8_STAGE(PG8_SA(0, 1), a2 + hstep, voffA);
            PG8_WAIT_V(8); PG8_WAIT_L(0); PG8_BAR; PG8_MMA(0, 0, At, B0); PG8_MMA(0, 1, At, B1); PG8_BAR; PG8_SCHED;
            PG8_LDA(At, 1, 1); PG8_STAGE(PG8_SB(1, 0), b3, voffB); PG8_STAGE(PG8_SB(1, 1), b3 + hstep, voffB); PG8_STAGE(PG8_SA(1, 0), a3, voffA);
            PG8_WAIT_V(8); PG8_WAIT_L(0); PG8_BAR; PG8_MMA(1, 0, At, B0); PG8_MMA(1, 1, At, B1); PG8_BAR; PG8_SCHED;
            } else {
            PG8_LDB(B0, 0, 0); PG8_SCHED; PG8_LDA(At, 0, 0); PG8_STAGE(PG8_SA(1, 1), a1 + hstep, voffA);
            PG8_WAIT_L(8); PG8_BAR; PG8_WAIT_L(0); PG8_MMA(0, 0, At, B0); PG8_BAR; PG8_SCHED;
            PG8_LDB(B1, 0, 1); PG8_STAGE(PG8_SB(0, 0), b2, voffB);
            PG8_BAR; PG8_WAIT_L(0); PG8_MMA(0, 1, At, B1); PG8_BAR;
            PG8_LDA(At, 0, 1); PG8_STAGE(PG8_SA(0, 0), a2, voffA);
            PG8_BAR; PG8_WAIT_L(0); PG8_MMA(1, 0, At, B0); PG8_BAR; PG8_SCHED;
            PG8_STAGE(PG8_SB(0, 1), b2 + hstep, voffB);
            PG8_WAIT_V(6); PG8_BAR; PG8_MMA(1, 1, At, B1); PG8_BAR;
            PG8_LDB(B0, 1, 0); PG8_SCHED; PG8_LDA(At, 1, 0); PG8_STAGE(PG8_SA(0, 1), a2 + hstep, voffA);
            PG8_WAIT_L(8); PG8_BAR; PG8_WAIT_L(0); PG8_MMA(0, 0, At, B0); PG8_BAR; PG8_SCHED;
            PG8_LDB(B1, 1, 1); PG8_STAGE(PG8_SB(1, 0), b3, voffB);
            PG8_BAR; PG8_WAIT_L(0); PG8_MMA(0, 1, At, B1); PG8_BAR;
            PG8_LDA(At, 1, 1); PG8_STAGE(PG8_SA(1, 0), a3, voffA);
            PG8_BAR; PG8_WAIT_L(0); PG8_MMA(1, 0, At, B0); PG8_BAR; PG8_SCHED;
            PG8_STAGE(PG8_SB(1, 1), b3 + hstep, voffB);
            PG8_WAIT_V(6); PG8_BAR; PG8_MMA(1, 1, At, B1); PG8_BAR;
            }
        }
        if constexpr (ALIGN_EPI) { if (wr == 0) PG8_BAR; }
        if constexpr (!Epi::AFTER_DRAIN) { E(acc, cur, wr, wc, fr, fq); S.done(cur); }
        if (!has_next) break;
#pragma unroll
        for (int a = 0; a < 2; ++a)
#pragma unroll
            for (int b = 0; b < 2; ++b)
#pragma unroll
                for (int m = 0; m < 4; ++m)
#pragma unroll
                    for (int n = 0; n < 2; ++n) acc[a][b][m][n] = (f32x4){0.f, 0.f, 0.f, 0.f};
        cur = nxt; cA = nA; cB = nB; ++ui;
        if constexpr (ALIGN_EPI) { if (wr == 1) PG8_BAR; }
    }
    PG8_WAIT_V(0);
    if constexpr (!ALIGN_EPI) { if (wr == 0) PG8_BAR; }
    PG8_BAR;
    if constexpr (Epi::AFTER_DRAIN) { E.fused(acc, cur, wr, wc, fr, fq, lds, wid, lane); S.done(cur); }
#undef PG8_SA
#undef PG8_SB
#undef PG8_STAGE
#undef PG8_LDA
#undef PG8_LDB
#undef PG8_MMA
#undef PG8_WAIT_V
#undef PG8_WAIT_L
#undef PG8_BAR
#undef PG8_SCHED
}
}

#define LAS __attribute__((address_space(3)))
typedef unsigned short bf16_t;
typedef short bf16x8 __attribute__((ext_vector_type(8)));
typedef float f32x4 __attribute__((ext_vector_type(4)));
typedef float f32x16 __attribute__((ext_vector_type(16)));
typedef unsigned u32x4 __attribute__((ext_vector_type(4)));
typedef unsigned u32x2 __attribute__((ext_vector_type(2)));
typedef short s16x4 __attribute__((ext_vector_type(4)));
typedef LAS const char* lds_cptr;
using pg8::Unit;

constexpr int T = 16384, SEQ = 8192, DM = 2048, INC = 4096, NEXP = 32, DFF = 512, NASSIGN = 2 * T, NLAYER = 2;
constexpr float LOG2E = 1.4426950408889634f;
constexpr float C2 = 0.125f * LOG2E;
constexpr int C_QA = 0, C_KA = 768, C_VA = 1024, C_UB = 1280, C_QC = 1792, C_KC = 2560, C_VC = 3328;

constexpr size_t MiB = 1u << 20;
constexpr size_t WS_CTL = 0, CTL_ZERO_BYTES = 1 * MiB;
constexpr size_t WS_COS = 2 * MiB, WS_SIN = 4 * MiB;
constexpr size_t WS_TOKE = 6 * MiB, WS_TOKG = 6 * MiB + 256 * 1024, WS_TOKP = 6 * MiB + 512 * 1024, WS_SGATE = 6 * MiB + 768 * 1024;
constexpr size_t WS_ROWTOK = 8 * MiB, WS_ROWGATE = 10 * MiB;
constexpr size_t WS_WR = 12 * MiB;
constexpr size_t WS_WIN = 16 * MiB, WS_WOUT = 48 * MiB, WS_WGU = 64 * MiB, WS_WDN = 320 * MiB;
constexpr size_t WS_HN = 448 * MiB, WS_PROJ = 512 * MiB, WS_CAT = 642 * MiB, WS_XSS = 706 * MiB, WS_ACT = 835 * MiB, WS_END = 868 * MiB;
constexpr int CW_QCTR = 0;
constexpr int CW_CUR = 1024;
constexpr int CW_BAR = 8192;

constexpr int LDS_WSF = 135168, LDS_MISC = 137216, LDS_BYTES = 147456;
constexpr int MI_ST = 16, MI_TP = 64, MI_LCNT = 128, MI_LBASE = 160, MI_SSQ = 256;

#define LDS_WAIT() asm volatile("s_waitcnt lgkmcnt(0)" ::: "memory")
__device__ __forceinline__ unsigned f2bf(float f) { unsigned u = __builtin_bit_cast(unsigned, f); return (u + 0x7fffu + ((u >> 16) & 1u)) >> 16; }
__device__ __forceinline__ unsigned pk2(float lo, float hi) { return f2bf(lo) | (f2bf(hi) << 16); }
__device__ __forceinline__ float bf2f(unsigned b) { return __builtin_bit_cast(float, b << 16); }
typedef float f32x2_t __attribute__((ext_vector_type(2))); typedef __bf16 bf16x2_t __attribute__((ext_vector_type(2)));
__device__ __forceinline__ unsigned cvtpk(float lo, float hi) { f32x2_t v = {lo, hi}; bf16x2_t b = __builtin_convertvector(v, bf16x2_t); return __builtin_bit_cast(unsigned, b); }
__device__ __forceinline__ float wave_sum(float v) {
#pragma unroll
    for (int o = 1; o < 64; o <<= 1) v += __shfl_xor(v, o);
    return v;
}

struct Ctx {
    const float* in[23]; float* out; unsigned char* ws;
    LAS unsigned char* lds; volatile LAS int* misc;
    int tid, lane, wave, G, bid;
};
#define IN_X 0
#define IN_POS 1
#define IN_ANORM 2
#define IN_WIN 3
#define IN_SINKS 4
#define IN_BNA 5
#define IN_WPOOL 6
#define IN_PSCALE 7
#define IN_LQ1 8
#define IN_LK1 9
#define IN_LQ2 10
#define IN_LK2 11
#define IN_SUBLN 12
#define IN_WOUT 13
#define IN_FNORM 14
#define IN_WRG 15
#define IN_BRG 16
#define IN_WRE 17
#define IN_BRE 18
#define IN_WG 19
#define IN_WU 20
#define IN_WD 21
#define IN_FINAL 22

struct EpiProj {
    static constexpr bool PERM = true, AFTER_DRAIN = false;
    bf16_t* O; const float* cosT; const float* sinT;
    __device__ __forceinline__ void operator()(const f32x4 (&acc)[2][2][4][2], const Unit& u, int wr, int wc, int fr, int fq) const {
        const int pn = u.pn;
        const bool rope = (pn <= 3) || (pn >= 7 && pn <= 12);
        const float sc = ((pn <= 2) || (pn >= 7 && pn <= 9)) ? C2 : 1.f;
        const int row0 = u.pm * 256 + wr * 64 + fr, col0 = pn * 256 + wc * 32 + 8 * fq, fi = 16 * (wc & 1) + 4 * fq;
#pragma unroll
        for (int ai = 0; ai < 2; ++ai)
#pragma unroll
            for (int m = 0; m < 4; ++m) {
                const int row = row0 + ai * 128 + m * 16;
                f32x4 cs = {1.f, 1.f, 1.f, 1.f}, sn = {0.f, 0.f, 0.f, 0.f};
                if (rope) { cs = *(const f32x4*)(cosT + (size_t)row * 32 + fi); sn = *(const f32x4*)(sinT + (size_t)row * 32 + fi); }
                bf16_t* rowp = O + (size_t)row * INC + col0;
#pragma unroll
                for (int bj = 0; bj < 2; ++bj) {
                    const f32x4 v0 = acc[ai][bj][m][0], v1 = acc[ai][bj][m][1];
                    const f32x4 o0 = (v0 * cs - v1 * sn) * sc, o1 = (v1 * cs + v0 * sn) * sc;
                    u32x4 w; w.x = cvtpk(o0[0], o0[1]); w.y = cvtpk(o0[2], o0[3]); w.z = cvtpk(o1[0], o1[1]); w.w = cvtpk(o1[2], o1[3]);
                    *(u32x4*)(rowp + bj * 128) = w;
                }
            }
    }
};
struct EpiResid {
    static constexpr bool PERM = false, AFTER_DRAIN = false;
    const float* src; float* dst;
    __device__ __forceinline__ void operator()(const f32x4 (&acc)[2][2][4][2], const Unit& u, int wr, int wc, int fr, int fq) const {
        const int row0 = u.pm * 256 + wr * 64 + fr, col0 = u.pn * 256 + wc * 32 + 4 * fq;
#pragma unroll
        for (int ai = 0; ai < 2; ++ai)
#pragma unroll
            for (int m = 0; m < 4; ++m) {
                const size_t off = (size_t)(row0 + ai * 128 + m * 16) * DM + col0;
#pragma unroll
                for (int bj = 0; bj < 2; ++bj)
#pragma unroll
                    for (int n = 0; n < 2; ++n) { const f32x4 s = *(const f32x4*)(src + off + bj * 128 + n * 16); *(f32x4*)(dst + off + bj * 128 + n * 16) = s + acc[ai][bj][m][n]; }
            }
    }
};
struct EpiGU {
    static constexpr bool PERM = true, AFTER_DRAIN = false;
    bf16_t* ACT;
    __device__ __forceinline__ void operator()(const f32x4 (&acc)[2][2][4][2], const Unit& u, int wr, int wc, int fr, int fq) const {
        const int col0 = u.pn * 128 + wc * 32 + 8 * fq;
#pragma unroll
        for (int ai = 0; ai < 2; ++ai)
#pragma unroll
            for (int m = 0; m < 4; ++m) {
                const int r = ai * 128 + wr * 64 + m * 16 + fr;
                if (r < u.valid) {
                    float a[8];
#pragma unroll
                    for (int n = 0; n < 2; ++n)
#pragma unroll
                        for (int j = 0; j < 4; ++j) { const float g = acc[ai][0][m][n][j], up = acc[ai][1][m][n][j]; a[n * 4 + j] = g * __builtin_amdgcn_rcpf(1.f + __builtin_amdgcn_exp2f(-g * LOG2E)) * up; }
                    u32x4 w; w.x = cvtpk(a[0], a[1]); w.y = cvtpk(a[2], a[3]); w.z = cvtpk(a[4], a[5]); w.w = cvtpk(a[6], a[7]);
                    *(u32x4*)(ACT + (size_t)(u.am + r) * DFF + col0) = w;
                }
            }
    }
};
struct EpiDown {
    static constexpr bool PERM = true, AFTER_DRAIN = false;
    bf16_t* YB; const float* sgate;
    __device__ __forceinline__ void operator()(const f32x4 (&acc)[2][2][4][2], const Unit& u, int wr, int wc, int fr, int fq) const {
        const int col0 = u.pn * 256 + wc * 32 + 8 * fq;
#pragma unroll
        for (int ai = 0; ai < 2; ++ai)
#pragma unroll
            for (int m = 0; m < 4; ++m) {
                const int r = ai * 128 + wr * 64 + m * 16 + fr;
                if (r < u.valid) {
                    const float gt = sgate[u.am + r];
                    bf16_t* rowp = YB + (size_t)(u.am + r) * DM + col0;
#pragma unroll
                    for (int bj = 0; bj < 2; ++bj) {
                        const f32x4 v0 = acc[ai][bj][m][0] * gt, v1 = acc[ai][bj][m][1] * gt;
                        u32x4 w; w.x = cvtpk(v0[0], v0[1]); w.y = cvtpk(v0[2], v0[3]); w.z = cvtpk(v1[0], v1[1]); w.w = cvtpk(v1[2], v1[3]);
                        *(u32x4*)(rowp + bj * 128) = w;
                    }
                }
            }
    }
};

template <class F> __device__ __forceinline__ void tr_item(const F& f, int K, bf16_t* WT, LAS float* scr, int kb, int nb, int lane) {
    const int k0 = 64 * kb, n0 = 32 * nb;
#pragma unroll 8
    for (int i = 0; i < 32; ++i) { const int kk = 2 * i + (lane >> 5); scr[kk * 33 + (lane & 31)] = f(k0 + kk, n0 + (lane & 31)); }
    LDS_WAIT(); asm volatile("" ::: "memory");
    const int c = lane & 7;
#pragma unroll
    for (int j = 0; j < 4; ++j) { const int n = (lane >> 3) + 8 * j; const LAS float* s = scr + (8 * c) * 33 + n;
        u32x4 o; o.x = pk2(s[0 * 33], s[1 * 33]); o.y = pk2(s[2 * 33], s[3 * 33]); o.z = pk2(s[4 * 33], s[5 * 33]); o.w = pk2(s[6 * 33], s[7 * 33]);
        *(u32x4*)(WT + (size_t)(n0 + n) * K + k0 + 8 * c) = o; }
    LDS_WAIT(); asm volatile("" ::: "memory");
}
__device__ __forceinline__ float lam_init_of(int l) { return l == 0 ? 0.2f : (0.8f - 0.6f * 0.74081822068171788f); }

struct FWin { const float* w;
    __device__ __forceinline__ float operator()(int k, int n) const {
        const int pn = n >> 8; int col = n;
        if ((pn <= 3) || (pn >= 7 && pn <= 12)) { const int cw = n & 63; col = (n & ~63) + 32 * ((cw >> 2) & 1) + 4 * (cw >> 3) + (cw & 3); }
        return w[(size_t)k * INC + col]; } };
struct FWout { const float* w; const float* bna; const float* subln; const float* wpool; const float* pscale; float omli;
    __device__ __forceinline__ float operator()(int k, int n) const {
        if (k < 768) return bna[k] * w[(size_t)k * DM + n];
        if (k >= 1280) return subln[(k - 1280) & 127] * omli * w[(size_t)k * DM + n];
        const int g = (k - 768) >> 7, kk = (k - 768) & 127; const float* wp = wpool + ((size_t)g * 128 + kk) * 128; const float* ps = pscale + g * 128; const float* wo = w + (size_t)(768 + g * 128) * DM + n;
        float s = 0.f;
        for (int j = 0; j < 128; ++j) s += wp[j] * ps[j] * wo[(size_t)j * DM];
        return s; } };
struct FWgu { const float* w;
    __device__ __forceinline__ float operator()(int k, int n) const {
        const int col = 128 * (n >> 8) + (n & 127);
        return w[(size_t)k * DFF + col]; } };
struct FWdn { const float* w;
    __device__ __forceinline__ float operator()(int k, int n) const { return w[(size_t)k * DM + n]; } };
struct FWr { const float* wrg; const float* wre;
    __device__ __forceinline__ float operator()(int k, int n) const {
        const int hl = n >= 48, j = hl ? n - 48 : n;
        float v = 0.f; if (j < 4) v = wrg[k * 4 + j]; else if (j < 36) v = wre[k * 32 + (j - 4)];
        const float hi = bf2f(f2bf(v)); return hl ? v - hi : v; } };

template <int PM = 0, class F> __device__ __forceinline__ void tr_item64(const F& f, int K, bf16_t* WT, LAS unsigned char* scr, int kb, int nb, int lane) {
    const int k0 = 64 * kb, n = 64 * nb + lane;
    float v[64];
#pragma unroll
    for (int j = 0; j < 64; ++j) v[j] = f(k0 + j, n);
#pragma unroll
    for (int c = 0; c < 8; ++c) { u32x4 o; o.x = cvtpk(v[8 * c], v[8 * c + 1]); o.y = cvtpk(v[8 * c + 2], v[8 * c + 3]); o.z = cvtpk(v[8 * c + 4], v[8 * c + 5]); o.w = cvtpk(v[8 * c + 6], v[8 * c + 7]);
        *(LAS u32x4*)(scr + lane * 144 + c * 16) = o; }
    LDS_WAIT(); asm volatile("" ::: "memory");
    const int rr = lane >> 3, cc = lane & 7;
    bf16_t* dst = WT + (size_t)(64 * nb + rr) * K + k0 + 8 * cc;
#pragma unroll
    for (int g = 0; g < 8; ++g) { const u32x4 o = *(const LAS u32x4*)(scr + (8 * g + rr) * 144 + cc * 16); *(u32x4*)(dst + (size_t)(8 * g) * K) = o; }
    LDS_WAIT(); asm volatile("" ::: "memory");
}
constexpr int I_FOLD = 8 * 64, I_WR = 32 * 3, I_WIN = 32 * 64, I_WOUT = 24 * 32, I_WGU1 = 32 * 16, I_WDN1 = 8 * 32;
constexpr int I_LAYER = I_FOLD + I_WR + I_WIN + I_WOUT + NEXP * I_WGU1 + NEXP * I_WDN1;
__device__ __forceinline__ void phase_prologue(Ctx& C) {
    LAS float* scr = (LAS float*)(C.lds + C.wave * 16384);
    const int gw = C.bid * 8 + C.wave, NGW = C.G * 8;
    for (int it = gw; it < NLAYER * I_LAYER; it += NGW) {
        const int l = it / I_LAYER; int r = it % I_LAYER;
        if (r < I_FOLD + I_WOUT) { FWout f{C.in[IN_WOUT] + (size_t)l * DM * DM, C.in[IN_BNA] + l * 768, C.in[IN_SUBLN] + l * 128, C.in[IN_WPOOL] + (size_t)l * 4 * 128 * 128, C.in[IN_PSCALE] + l * 512, 1.f - lam_init_of(l)};
            bf16_t* WT = (bf16_t*)(C.ws + WS_WOUT) + (size_t)l * DM * DM;
            if (r < I_FOLD) tr_item(f, DM, WT, scr, 12 + r / 64, r % 64, C.lane);
            else { const int q = r - I_FOLD, kq = q / 32; tr_item64(f, DM, WT, (LAS unsigned char*)scr, kq < 12 ? kq : kq + 8, q % 32, C.lane); }
            continue; } r -= I_FOLD + I_WOUT;
        if (r < I_WR) { FWr f{C.in[IN_WRG] + (size_t)l * DM * 4, C.in[IN_WRE] + (size_t)l * DM * 32}; tr_item(f, DM, (bf16_t*)(C.ws + WS_WR) + (size_t)l * 96 * DM, scr, r / 3, r % 3, C.lane); continue; } r -= I_WR;
        if (r < I_WIN) { FWin f{C.in[IN_WIN] + (size_t)l * DM * INC}; tr_item64(f, DM, (bf16_t*)(C.ws + WS_WIN) + (size_t)l * INC * DM, (LAS unsigned char*)scr, r / 64, r % 64, C.lane); continue; } r -= I_WIN;
        if (r < NEXP * I_WGU1) { const int e = r / I_WGU1, q = r % I_WGU1; const size_t eo = ((size_t)l * NEXP + e) * DM * DFF;
            FWgu f{(((q % 16) & 2) ? C.in[IN_WU] : C.in[IN_WG]) + eo}; tr_item64(f, DM, (bf16_t*)(C.ws + WS_WGU) + ((size_t)l * NEXP + e) * 1024 * DM, (LAS unsigned char*)scr, q / 16, q % 16, C.lane); continue; } r -= NEXP * I_WGU1;
        { const int e = r / I_WDN1, q = r % I_WDN1; FWdn f{C.in[IN_WD] + ((size_t)l * NEXP + e) * DFF * DM}; tr_item64(f, DFF, (bf16_t*)(C.ws + WS_WDN) + ((size_t)l * NEXP + e) * DM * DFF, (LAS unsigned char*)scr, q / 32, q % 32, C.lane); }
    }
    float* cosT = (float*)(C.ws + WS_COS); float* sinT = (float*)(C.ws + WS_SIN); const int* pos = (const int*)C.in[IN_POS];
    for (int i = C.bid * 512 + C.tid; i < T * 32; i += C.G * 512) {
        const int tok = i >> 5, fi = i & 31;
        double inv = 1.0; for (int q = 0; q < fi; ++q) inv *= 0.74989420933245582;
        const double rev = (double)pos[tok] * inv * 0.15915494309189535;
        const float fr = (float)(rev - __builtin_floor(rev));
        cosT[i] = __builtin_amdgcn_cosf(fr); sinT[i] = __builtin_amdgcn_sinf(fr);
    }
}

__device__ __forceinline__ void load_starts(Ctx& C, int l) {
    if (C.tid == 0) { const unsigned* cur = (const unsigned*)(C.ws + WS_CTL) + CW_CUR + l * 32 * 64; int s = 0, tp = 0;
        for (int e = 0; e < NEXP; ++e) { C.misc[MI_ST + e] = s; C.misc[MI_TP + e] = tp; const int c = (int)__hip_atomic_load(cur + e * 64, __ATOMIC_RELAXED, __HIP_MEMORY_SCOPE_AGENT); s += c; tp += (c + 255) >> 8; }
        C.misc[MI_ST + NEXP] = s; C.misc[MI_TP + NEXP] = tp; }
    __syncthreads();
}
template <int MODE> __device__ __forceinline__ void phase_norm(Ctx& C, const float* src, float* dsth, const float* g, bf16_t* hn, float* outf) {
    const int gw = C.bid * 8 + C.wave, NGW = C.G * 8, lane = C.lane;
    const bf16_t* YB = (const bf16_t*)(C.ws + WS_PROJ);
    const int* toke = (const int*)(C.ws + WS_TOKE); const int* tokp = (const int*)(C.ws + WS_TOKP);
    for (int m = gw; m < T; m += NGW) {
        const f32x4* xr = (const f32x4*)(src + (size_t)m * DM) + lane;
        f32x4 v[8];
#pragma unroll
        for (int j = 0; j < 8; ++j) v[j] = xr[64 * j];
        if (MODE >= 1) {
            const int r0 = C.misc[MI_ST + toke[2 * m]] + tokp[2 * m], r1 = C.misc[MI_ST + toke[2 * m + 1]] + tokp[2 * m + 1];
            const u32x2* y0 = (const u32x2*)(YB + (size_t)r0 * DM) + lane; const u32x2* y1 = (const u32x2*)(YB + (size_t)r1 * DM) + lane;
#pragma unroll
            for (int j = 0; j < 8; ++j) { const u32x2 a = y0[64 * j], b = y1[64 * j];
                v[j][0] += bf2f(a.x & 0xffffu) + bf2f(b.x & 0xffffu); v[j][1] += bf2f(a.x >> 16) + bf2f(b.x >> 16);
                v[j][2] += bf2f(a.y & 0xffffu) + bf2f(b.y & 0xffffu); v[j][3] += bf2f(a.y >> 16) + bf2f(b.y >> 16); }
        }
        if (MODE == 1) { f32x4* hr = (f32x4*)(dsth + (size_t)m * DM) + lane;
#pragma unroll
            for (int j = 0; j < 8; ++j) hr[64 * j] = v[j]; }
        float s = 0.f;
#pragma unroll
        for (int j = 0; j < 8; ++j) s += (v[j][0] * v[j][0] + v[j][1] * v[j][1]) + (v[j][2] * v[j][2] + v[j][3] * v[j][3]);
        const float rs = 1.0f / sqrtf(wave_sum(s) * (1.f / DM) + 1e-6f);
        const f32x4* gr = (const f32x4*)g + lane;
        if (MODE == 2) { f32x4* o = (f32x4*)(outf + (size_t)m * DM) + lane;
#pragma unroll
            for (int j = 0; j < 8; ++j) o[64 * j] = v[j] * rs * gr[64 * j]; }
        else { u32x2* o = (u32x2*)(hn + (size_t)m * DM) + lane;
#pragma unroll
            for (int j = 0; j < 8; ++j) { const f32x4 w = v[j] * rs * gr[64 * j]; u32x2 p; p.x = cvtpk(w[0], w[1]); p.y = cvtpk(w[2], w[3]); o[64 * j] = p; } }
    }
}

__device__ __forceinline__ int crow(int r, int hi) { return (r & 3) + 8 * (r >> 2) + 4 * hi; }
typedef short v4i16_t __attribute__((ext_vector_type(4)));
__device__ __forceinline__ s16x4 vtr(lds_cptr p) { return __builtin_bit_cast(s16x4, __builtin_amdgcn_ds_read_tr16_b64_v4i16((LAS v4i16_t*)p)); }
__device__ __forceinline__ float swapmax(float v) { auto rr = __builtin_amdgcn_permlane32_swap(__float_as_uint(v), __float_as_uint(v), false, false); return fmaxf(__uint_as_float(rr[0]), __uint_as_float(rr[1])); }
__device__ __forceinline__ float swapsum(float v) { auto rr = __builtin_amdgcn_permlane32_swap(__float_as_uint(v), __float_as_uint(v), false, false); return __uint_as_float(rr[0]) + __uint_as_float(rr[1]); }

template <int NDH, int MASK>
__device__ __forceinline__ void attn_tile(f32x16 (&o)[NDH], float& m, float& l, const bf16x8 (&qr)[4], lds_cptr Kslot, lds_cptr Vslot, LAS float* wsf, int kbase, int qrow, int lane) {
    const int r32 = lane & 31, hi = lane >> 5;
    const lds_cptr kp = Kslot + hi * 1024 + r32 * 16;
    f32x16 p0 = {}, p1 = {};
#pragma unroll
    for (int d0 = 0; d0 < 4; ++d0) {
        const bf16x8 b0 = *(const LAS bf16x8*)(kp + d0 * 2048), b1 = *(const LAS bf16x8*)(kp + d0 * 2048 + 512);
        p0 = __builtin_amdgcn_mfma_f32_32x32x16_bf16(b0, qr[d0], p0, 0, 0, 0);
        p1 = __builtin_amdgcn_mfma_f32_32x32x16_bf16(b1, qr[d0], p1, 0, 0, 0);
    }
    __builtin_amdgcn_sched_barrier(0);
    if (MASK) {
#pragma unroll
        for (int r = 0; r < 16; ++r) {
            const int k0 = kbase + crow(r, hi), k1 = k0 + 32;
            bool v0 = k0 <= qrow, v1 = k1 <= qrow;
            if (MASK == 2) { v0 = v0 && (qrow - k0 < 128); v1 = v1 && (qrow - k1 < 128); }
            p0[r] = v0 ? p0[r] : -__builtin_inff(); p1[r] = v1 ? p1[r] : -__builtin_inff();
        }
    }
    float mx = fmaxf(p0[0], p1[0]);
#pragma unroll
    for (int r = 1; r < 16; ++r) mx = fmaxf(mx, fmaxf(p0[r], p1[r]));
    mx = swapmax(mx);
    const float mn = fmaxf(m, mx);
    const float alpha = __builtin_amdgcn_exp2f(m - mn);
    m = mn;
    float s = 0.f;
#pragma unroll
    for (int r = 0; r < 16; ++r) { p0[r] = __builtin_amdgcn_exp2f(p0[r] - mn); p1[r] = __builtin_amdgcn_exp2f(p1[r] - mn); s += p0[r] + p1[r]; }
    l = l * alpha + s;
    if (__any(alpha != 1.0f)) {
        if (hi == 0) wsf[r32] = alpha;
#pragma unroll
        for (int r = 0; r < 16; ++r) { const float a = wsf[crow(r, hi)];
#pragma unroll
            for (int dh = 0; dh < NDH; ++dh) o[dh][r] *= a; }
    }
    __builtin_amdgcn_sched_barrier(0);
    u32x4 pw[4];
    pw[0] = (u32x4){cvtpk(p0[0], p0[1]), cvtpk(p0[2], p0[3]), cvtpk(p0[4], p0[5]), cvtpk(p0[6], p0[7])};
    pw[1] = (u32x4){cvtpk(p0[8], p0[9]), cvtpk(p0[10], p0[11]), cvtpk(p0[12], p0[13]), cvtpk(p0[14], p0[15])};
    pw[2] = (u32x4){cvtpk(p1[0], p1[1]), cvtpk(p1[2], p1[3]), cvtpk(p1[4], p1[5]), cvtpk(p1[6], p1[7])};
    pw[3] = (u32x4){cvtpk(p1[8], p1[9]), cvtpk(p1[10], p1[11]), cvtpk(p1[12], p1[13]), cvtpk(p1[14], p1[15])};
    __builtin_amdgcn_sched_barrier(0);
    const lds_cptr vp = Vslot + ((lane >> 4) & 1) * 32 + (lane & 3) * 8 + (4 * hi + ((lane & 15) >> 2)) * 64;
#pragma unroll
    for (int dh = 0; dh < NDH; ++dh)
#pragma unroll
        for (int ks = 0; ks < 4; ++ks) {
            const s16x4 lo = vtr(vp + dh * 4096 + ks * 1024), hh = vtr(vp + dh * 4096 + ks * 1024 + 512);
            const bf16x8 vb = (bf16x8){lo[0], lo[1], lo[2], lo[3], hh[0], hh[1], hh[2], hh[3]};
            o[dh] = __builtin_amdgcn_mfma_f32_32x32x16_bf16(__builtin_bit_cast(bf16x8, pw[ks]), vb, o[dh], 0, 0, 0);
            if (ks == 3) __builtin_amdgcn_sched_barrier(0);
        }
}

__device__ __forceinline__ void diff_unit(Ctx& C, int b, int h, int qb, float lam) {
    const int lane = C.lane, wid = C.wave, r32 = lane & 31, hi = lane >> 5, c = wid >> 2, wq = wid & 3;
    const int q0w = qb * 128 + wq * 32;
    const char* Pb = (const char*)(C.ws + WS_PROJ) + (size_t)b * SEQ * INC * 2;
    bf16x8 qr[4];
    { const unsigned qo = (unsigned)(((q0w + r32) * INC + C_QC + (2 * h + c) * 64 + hi * 8) * 2);
#pragma unroll
      for (int d0 = 0; d0 < 4; ++d0) qr[d0] = *(const bf16x8*)(Pb + (qo + d0 * 32)); }
    const int NT = 2 * (qb + 1);
    LAS unsigned char* L = C.lds; LAS float* wsf = (LAS float*)(L + LDS_WSF + wid * 256);
    const unsigned kofs = (unsigned)((lane * INC + C_KC + (2 * h) * 64 + wid * 8) * 2);
    const unsigned vofs0 = (unsigned)(((16 * (wid & 3) + (lane >> 2)) * INC + C_VC + h * 128 + (wid >> 2) * 32 + (lane & 3) * 8) * 2);
    const unsigned vofs1 = vofs0 + 64 * 2;
    const int kdst = wid * 1024 + lane * 16;
    u32x4 rk0, rk1, rv0, rv1;
#define DIFF_LOAD(t) do { const char* Pt_ = Pb + (size_t)(t) * (64 * INC * 2); rk0 = *(const u32x4*)(Pt_ + kofs); rk1 = *(const u32x4*)(Pt_ + (kofs + 128)); rv0 = *(const u32x4*)(Pt_ + vofs0); rv1 = *(const u32x4*)(Pt_ + vofs1); } while (0)
#define DIFF_WRITE(bo) do { *(LAS u32x4*)(L + (bo) + kdst) = rk0; *(LAS u32x4*)(L + (bo) + 8192 + kdst) = rk1; *(LAS u32x4*)(L + (bo) + 16384 + kdst) = rv0; *(LAS u32x4*)(L + (bo) + 24576 + kdst) = rv1; } while (0)
    DIFF_LOAD(0); DIFF_WRITE(0); __syncthreads();
    f32x16 o[4]; o[0] = f32x16{}; o[1] = f32x16{}; o[2] = f32x16{}; o[3] = f32x16{};
    float m = -1e30f, lsum = 0.f;
#pragma unroll 1
    for (int t = 0; t < NT; ++t) {
        const int tn = (t + 1 < NT) ? t + 1 : t;
        DIFF_LOAD(tn);
        const int kbase = 64 * t, bo = (t & 1) * 32768;
        if (kbase <= q0w + 31) {
            const lds_cptr Ks = (lds_cptr)(L + bo + c * 8192), Vs = (lds_cptr)(L + bo + 16384);
            attn_tile<4, 1>(o, m, lsum, qr, Ks, Vs, wsf, kbase, q0w + r32, lane);
        }
        DIFF_WRITE(((t + 1) & 1) * 32768);
        __syncthreads();
    }
#undef DIFF_LOAD
#undef DIFF_WRITE
    lsum = swapsum(lsum);
    if (hi == 0) wsf[r32] = lsum;
    LAS float* X = (LAS float*)(L + 65536) + wq * 4096 + lane;
    if (c == 1) {
#pragma unroll
        for (int r = 0; r < 16; ++r) { const float rl = 1.0f / wsf[crow(r, hi)];
#pragma unroll
            for (int dh = 0; dh < 4; ++dh) X[(dh * 16 + r) * 64] = o[dh][r] * rl; }
    }
    __syncthreads();
    if (c == 0) {
        char* Cb = (char*)(C.ws + WS_CAT) + (size_t)b * SEQ * DM * 2;
        const unsigned co = (unsigned)(((q0w + 4 * hi) * DM + 1280 + h * 128 + r32) * 2);
#pragma unroll
        for (int r = 0; r < 16; ++r) {
            const float rl = 1.0f / wsf[crow(r, hi)];
            float s = 0.f;
#pragma unroll
            for (int dh = 0; dh < 4; ++dh) { const float d = o[dh][r] * rl - lam * X[(dh * 16 + r) * 64]; o[dh][r] = d; s += d * d; }
#pragma unroll
            for (int off = 1; off < 32; off <<= 1) s += __shfl_xor(s, off);
            const float rn = 1.0f / sqrtf(s * (1.f / 128.f) + 1e-5f);
            const unsigned ro = co + (unsigned)(((r & 3) + 8 * (r >> 2)) * DM * 2);
#pragma unroll
            for (int dh = 0; dh < 4; ++dh) *(bf16_t*)(Cb + (ro + dh * 64)) = (bf16_t)f2bf(o[dh][r] * rn);
        }
    }
}

__device__ __forceinline__ void swa_task(Ctx& C, int l, int b, int q0, int head, f32x16 (&o)[2], float (&ssq)[16]) {
    const int lane = C.lane, wid = C.wave, r32 = lane & 31, hi = lane >> 5;
    const char* Pb = (const char*)(C.ws + WS_PROJ) + (size_t)b * SEQ * INC * 2;
    LAS unsigned char* Lw = C.lds + wid * 16384; LAS float* wsf = (LAS float*)(C.lds + LDS_WSF + wid * 256);
    const int kvh = head / 3;
    bf16x8 qr[4];
    { const unsigned qo = (unsigned)(((q0 + r32) * INC + C_QA + head * 64 + hi * 8) * 2);
#pragma unroll
      for (int d0 = 0; d0 < 4; ++d0) qr[d0] = *(const bf16x8*)(Pb + (qo + d0 * 32)); }
    o[0] = f32x16{}; o[1] = f32x16{};
    float m = C.in[IN_SINKS][l * 12 + head] * LOG2E, lsum = (hi == 0) ? 1.f : 0.f;
    const int tlo = (q0 >= 127 ? q0 - 127 : 0) >> 6, thi = (q0 + 31) >> 6;
    const unsigned kofs = (unsigned)((lane * INC + C_KA + kvh * 64) * 2);
    const unsigned vofs = (unsigned)(((lane >> 2) * INC + C_VA + kvh * 64 + (lane & 3) * 8) * 2);
    for (int t = tlo; t <= thi; ++t) {
        const char* Pt = Pb + (size_t)t * (64 * INC * 2);
        u32x4 kk[8], vv[8];
#pragma unroll
        for (int c8 = 0; c8 < 8; ++c8) kk[c8] = *(const u32x4*)(Pt + (kofs + c8 * 16));
#pragma unroll
        for (int i = 0; i < 8; ++i) vv[i] = *(const u32x4*)(Pt + (vofs + (16 * (i & 3) * INC + (i >> 2) * 32) * 2));
#pragma unroll
        for (int c8 = 0; c8 < 8; ++c8) *(LAS u32x4*)(Lw + c8 * 1024 + lane * 16) = kk[c8];
#pragma unroll
        for (int i = 0; i < 8; ++i) *(LAS u32x4*)(Lw + 8192 + i * 1024 + lane * 16) = vv[i];
        attn_tile<2, 2>(o, m, lsum, qr, (lds_cptr)Lw, (lds_cptr)(Lw + 8192), wsf, 64 * t, q0 + r32, lane);
    }
    lsum = swapsum(lsum);
    if (hi == 0) wsf[r32] = lsum;
#pragma unroll
    for (int r = 0; r < 16; ++r) { const float rl = 1.0f / wsf[crow(r, hi)]; o[0][r] *= rl; o[1][r] *= rl; float s = o[0][r] * o[0][r] + o[1][r] * o[1][r];
#pragma unroll
        for (int off = 1; off < 32; off <<= 1) s += __shfl_xor(s, off);
        ssq[r] = s; }
}
__device__ __forceinline__ void swa_store(Ctx& C, int b, int q0, int head, const f32x16 (&o)[2]) {
    const int lane = C.lane, r32 = lane & 31, hi = lane >> 5;
    char* Cb = (char*)(C.ws + WS_CAT) + (size_t)b * SEQ * DM * 2; const LAS float* tot = (const LAS float*)(C.misc + MI_SSQ) + 12 * 32;
    const unsigned co = (unsigned)(((q0 + 4 * hi) * DM + head * 64 + r32) * 2);
#pragma unroll
    for (int r = 0; r < 16; ++r) { const int qq = (r & 3) + 8 * (r >> 2); const float rn = tot[qq + 4 * hi];
        const unsigned ro = co + (unsigned)(qq * DM * 2);
        *(bf16_t*)(Cb + ro) = (bf16_t)f2bf(o[0][r] * rn); *(bf16_t*)(Cb + (ro + 64)) = (bf16_t)f2bf(o[1][r] * rn); }
}
__device__ __forceinline__ void swa_unit(Ctx& C, int l, int b, int jb) {
    const int lane = C.lane, wid = C.wave, r32 = lane & 31, hi = lane >> 5;
    const int q0 = jb * 32;
    LAS float* ssqL = (LAS float*)(C.misc + MI_SSQ);
    f32x16 oa[2], ob[2]; float sa[16], sb[16];
    swa_task(C, l, b, q0, wid, oa, sa);
    if (r32 == 0) {
#pragma unroll
        for (int r = 0; r < 16; ++r) ssqL[wid * 32 + crow(r, hi)] = sa[r]; }
    if (wid < 4) {
        swa_task(C, l, b, q0, 8 + wid, ob, sb);
        if (r32 == 0) {
#pragma unroll
            for (int r = 0; r < 16; ++r) ssqL[(8 + wid) * 32 + crow(r, hi)] = sb[r]; }
    }
    __syncthreads();
    if (C.tid < 32) { float s = 0.f;
#pragma unroll
        for (int hh = 0; hh < 12; ++hh) s += ssqL[hh * 32 + C.tid];
        ssqL[12 * 32 + C.tid] = 1.0f / sqrtf(s * (1.f / 768.f) + 1e-6f); }
    __syncthreads();
    swa_store(C, b, q0, wid, oa);
    if (wid < 4) swa_store(C, b, q0, 8 + wid, ob);
    __syncthreads();
}

__device__ __forceinline__ void pool_unit(Ctx& C, int b, int blk) {
    const int cg8 = C.tid & 63, ts = C.tid >> 6;
    const int w = 2 << (cg8 >> 4);
    const size_t rowbase = (size_t)b * SEQ;
    const bf16_t* P = (const bf16_t*)(C.ws + WS_PROJ) + C_UB + 8 * cg8; bf16_t* CAT = (bf16_t*)(C.ws + WS_CAT) + 768 + 8 * cg8;
    for (int i = 0; i < 4; ++i) {
        const int s = blk * 32 + ts * 4 + i;
        float acc[8];
#pragma unroll
        for (int j = 0; j < 8; ++j) acc[j] = 0.f;
        const int lo = (s - w + 1) > 0 ? (s - w + 1) : 0;
        u32x4 self = {0, 0, 0, 0};
        for (int sp = lo; sp <= s; ++sp) { const u32x4 v = *(const u32x4*)(P + (rowbase + sp) * INC); self = v;
            acc[0] += bf2f(v.x & 0xffffu); acc[1] += bf2f(v.x >> 16); acc[2] += bf2f(v.y & 0xffffu); acc[3] += bf2f(v.y >> 16);
            acc[4] += bf2f(v.z & 0xffffu); acc[5] += bf2f(v.z >> 16); acc[6] += bf2f(v.w & 0xffffu); acc[7] += bf2f(v.w >> 16); }
        const float rc = 1.0f / (float)(s - lo + 1);
        u32x4 ov;
        ov.x = pk2(acc[0] * rc - bf2f(self.x & 0xffffu), acc[1] * rc - bf2f(self.x >> 16)); ov.y = pk2(acc[2] * rc - bf2f(self.y & 0xffffu), acc[3] * rc - bf2f(self.y >> 16));
        ov.z = pk2(acc[4] * rc - bf2f(self.z & 0xffffu), acc[5] * rc - bf2f(self.z >> 16)); ov.w = pk2(acc[6] * rc - bf2f(self.w & 0xffffu), acc[7] * rc - bf2f(self.w >> 16));
        *(u32x4*)(CAT + (rowbase + s) * DM) = ov;
    }
}

#ifndef MIXSEL
#define MIXSEL 7
#endif
constexpr int NU_DIFF = 2 * 6 * 64, NU_SWA = 2 * 256, NU_POOL = 2 * 256, NU_MIX = NU_DIFF + NU_SWA + NU_POOL;
__device__ __forceinline__ void phase_mixers(Ctx& C, int l, int qslot = -1, int sel = 7) {
    if (C.tid == 0) {
        float s1 = 0.f, s2 = 0.f;
        for (int i = 0; i < 64; ++i) { s1 += C.in[IN_LQ1][l * 64 + i] * C.in[IN_LK1][l * 64 + i]; s2 += C.in[IN_LQ2][l * 64 + i] * C.in[IN_LK2][l * 64 + i]; }
        C.misc[1] = __float_as_int(__expf(s1) - __expf(s2) + lam_init_of(l));
    }
    __syncthreads();
    const float lam = __int_as_float(C.misc[1]);
    unsigned* qctr = (unsigned*)(C.ws + WS_CTL) + CW_QCTR + 64 * (qslot < 0 ? l : qslot);
    for (;;) {
        if (C.tid == 0) C.misc[0] = (int)__hip_atomic_fetch_add(qctr, 1u, __ATOMIC_RELAXED, __HIP_MEMORY_SCOPE_AGENT);
        __syncthreads();
        const int u = C.misc[0];
        __syncthreads();
        if (u >= NU_MIX) break;
        if (sel & 1) if (u < NU_DIFF) { const int qb = 63 - u / 12, bh = u % 12; diff_unit(C, bh / 6, bh % 6, qb, lam); }
        if (sel & 2) if (u >= NU_DIFF && u < NU_DIFF + NU_SWA) { const int v = u - NU_DIFF; swa_unit(C, l, v >> 8, v & 255); }
        if (sel & 4) if (u >= NU_DIFF + NU_SWA) { const int v = u - NU_DIFF - NU_SWA; pool_unit(C, v >> 8, v & 255); }
    }
}

constexpr int XT_PITCH = 4112;
__device__ __forceinline__ void phase_router(Ctx& C, int l) {
    const int lane = C.lane, wid = C.wave, tid = C.tid;
    const float* h = C.out; const float* g = C.in[IN_FNORM] + l * DM;
    bf16_t* XS = (bf16_t*)(C.ws + WS_HN); const bf16_t* WR = (const bf16_t*)(C.ws + WS_WR) + (size_t)l * 96 * DM;
    unsigned* cur = (unsigned*)(C.ws + WS_CTL) + CW_CUR + l * 32 * 64;
    int* toke = (int*)(C.ws + WS_TOKE); float* tokg = (float*)(C.ws + WS_TOKG); int* tokp = (int*)(C.ws + WS_TOKP);
    int* rowtok = (int*)(C.ws + WS_ROWTOK); float* rowgate = (float*)(C.ws + WS_ROWGATE);
    LAS unsigned char* L = C.lds;
    for (int unit = C.bid; unit < T / 32; unit += C.G) {
        const int tok0 = unit * 32;
#pragma unroll 1
        for (int rr = 0; rr < 4; ++rr) {
            const int row = wid * 4 + rr; const size_t m = (size_t)tok0 + row;
            const f32x4* xr = (const f32x4*)(h + m * DM) + lane; f32x4 v[8]; float s = 0.f;
#pragma unroll
            for (int j = 0; j < 8; ++j) { v[j] = xr[64 * j]; s += (v[j][0] * v[j][0] + v[j][1] * v[j][1]) + (v[j][2] * v[j][2] + v[j][3] * v[j][3]); }
            const float rs = 1.0f / sqrtf(wave_sum(s) * (1.f / DM) + 1e-6f);
            const f32x4* gr = (const f32x4*)g + lane; u32x2* o = (u32x2*)(XS + m * DM) + lane;
#pragma unroll
            for (int j = 0; j < 8; ++j) { const f32x4 w = v[j] * rs * gr[64 * j]; u32x2 p; p.x = cvtpk(w[0], w[1]); p.y = cvtpk(w[2], w[3]); o[64 * j] = p;
                *(LAS u32x2*)(L + row * XT_PITCH + (4 * lane + 256 * j) * 2) = p; }
        }
        if (tid < 32) C.misc[MI_LCNT + tid] = 0;
        __syncthreads();
        f32x4 acc[2][3];
#pragma unroll
        for (int rt = 0; rt < 2; ++rt)
#pragma unroll
            for (int ct = 0; ct < 3; ++ct) acc[rt][ct] = (f32x4){0.f, 0.f, 0.f, 0.f};
#pragma unroll 2
        for (int ks = 0; ks < 8; ++ks) {
            const int kk = 256 * wid + 32 * ks + 8 * (lane >> 4);
            bf16x8 a[2];
#pragma unroll
            for (int rt = 0; rt < 2; ++rt) a[rt] = *(const LAS bf16x8*)(L + (16 * rt + (lane & 15)) * XT_PITCH + kk * 2);
#pragma unroll
            for (int ct = 0; ct < 3; ++ct)
#pragma unroll
                for (int hl = 0; hl < 2; ++hl) {
                    const bf16x8 bb = *(const bf16x8*)(WR + (size_t)(hl * 48 + 16 * ct + (lane & 15)) * DM + kk);
#pragma unroll
                    for (int rt = 0; rt < 2; ++rt) acc[rt][ct] = __builtin_amdgcn_mfma_f32_16x16x32_bf16(a[rt], bb, acc[rt][ct], 0, 0, 0);
                }
        }
        __syncthreads();
        LAS float* RED = (LAS float*)L;
#pragma unroll
        for (int rt = 0; rt < 2; ++rt)
#pragma unroll
            for (int ct = 0; ct < 3; ++ct)
#pragma unroll
                for (int q = 0; q < 4; ++q) RED[(wid * 32 + 16 * rt + 4 * (lane >> 4) + q) * 48 + 16 * ct + (lane & 15)] = acc[rt][ct][q];
        __syncthreads();
        LAS float* LG = RED + 8 * 32 * 48;
        for (int i = tid; i < 32 * 48; i += 512) { float sacc = 0.f;
#pragma unroll
            for (int w8 = 0; w8 < 8; ++w8) sacc += RED[w8 * 32 * 48 + i];
            LG[i] = sacc; }
        __syncthreads();
        int e0 = 0, e1 = 0, rk0 = 0, rk1 = 0; float g0 = 0.f, g1 = 0.f;
        if (tid < 32) {
            const LAS float* lg = LG + tid * 48;
            const float* brg = C.in[IN_BRG] + l * 4; const float* bre = C.in[IN_BRE] + l * 32;
            float gl[4]; int gsel = 0; float gm = -__builtin_inff();
#pragma unroll
            for (int j = 0; j < 4; ++j) { gl[j] = lg[j] + brg[j]; if (gl[j] > gm) { gm = gl[j]; gsel = j; } }
            float gs = 0.f;
#pragma unroll
            for (int j = 0; j < 4; ++j) gs += __expf(gl[j] - gm);
            const float pgsel = 1.0f / gs;
            float le[8];
#pragma unroll
            for (int j = 0; j < 8; ++j) le[j] = lg[4 + gsel * 8 + j] + bre[gsel * 8 + j];
            int i0 = 0; float m0 = le[0];
#pragma unroll
            for (int j = 1; j < 8; ++j) if (le[j] > m0) { m0 = le[j]; i0 = j; }
            int i1 = -1; float m1 = -__builtin_inff();
#pragma unroll
            for (int j = 0; j < 8; ++j) if (j != i0 && le[j] > m1) { m1 = le[j]; i1 = j; }
            const float p1 = __expf(m1 - m0), den = 1.0f / (1.0f + p1);
            g0 = pgsel * den; g1 = pgsel * p1 * den;
            e0 = gsel * 8 + i0; e1 = gsel * 8 + i1;
            rk0 = __hip_atomic_fetch_add((LAS int*)(C.misc + MI_LCNT) + e0, 1, __ATOMIC_RELAXED, __HIP_MEMORY_SCOPE_WORKGROUP);
            rk1 = __hip_atomic_fetch_add((LAS int*)(C.misc + MI_LCNT) + e1, 1, __ATOMIC_RELAXED, __HIP_MEMORY_SCOPE_WORKGROUP);
        }
        __syncthreads();
        if (tid < 32) { const int c = C.misc[MI_LCNT + tid]; C.misc[MI_LBASE + tid] = c ? (int)__hip_atomic_fetch_add(cur + tid * 64, (unsigned)c, __ATOMIC_RELAXED, __HIP_MEMORY_SCOPE_AGENT) : 0; }
        __syncthreads();
        if (tid < 32) {
            const int t = tok0 + tid; const int p0 = C.misc[MI_LBASE + e0] + rk0, p1 = C.misc[MI_LBASE + e1] + rk1;
            toke[2 * t] = e0; toke[2 * t + 1] = e1; tokg[2 * t] = g0; tokg[2 * t + 1] = g1; tokp[2 * t] = p0; tokp[2 * t + 1] = p1;
            rowtok[e0 * T + p0] = t; rowtok[e1 * T + p1] = t; rowgate[e0 * T + p0] = g0; rowgate[e1 * T + p1] = g1;
        }
        __syncthreads();
    }
}

__device__ __forceinline__ void phase_gather(Ctx& C, int l) {
    load_starts(C, l);
    const int gw = C.bid * 8 + C.wave, NGW = C.G * 8, lane = C.lane;
    const bf16_t* XS = (const bf16_t*)(C.ws + WS_HN); bf16_t* XSS = (bf16_t*)(C.ws + WS_XSS);
    const int* rowtok = (const int*)(C.ws + WS_ROWTOK); const float* rowgate = (const float*)(C.ws + WS_ROWGATE); float* sgate = (float*)(C.ws + WS_SGATE);
    for (int ci = gw; ci < NASSIGN; ci += NGW) {
        int e = 0;
        while (e < 31 && C.misc[MI_ST + e + 1] <= ci) ++e;
        const int pos = ci - C.misc[MI_ST + e]; const int tok = rowtok[e * T + pos];
        const u32x4* s = (const u32x4*)(XS + (size_t)tok * DM) + lane; u32x4* d = (u32x4*)(XSS + (size_t)ci * DM) + lane;
        const u32x4 a0 = s[0], a1 = s[64], a2 = s[128], a3 = s[192];
        d[0] = a0; d[64] = a1; d[128] = a2; d[192] = a3;
        if (lane == 0) sgate[ci] = rowgate[e * T + pos];
    }
}

#define XB_TMO      128
#define XB_XCNT(j)  (256  + 64 * (j))
#define XB_XSUB(j)  (1280 + 64 * (j))
#define XB_XGEN(j)  (2304 + 64 * (j))
#define XB_TOP      3328
#define XB_TOPGEN   3392
#define XCD_BAR_WORDS 3456
#define XB_SPIN_CAP (1u << 18)

__device__ __forceinline__ unsigned xb_ld(unsigned* p)              { return __hip_atomic_load(p, __ATOMIC_RELAXED, __HIP_MEMORY_SCOPE_AGENT); }
__device__ __forceinline__ unsigned xb_add(unsigned* p, unsigned v) { return __hip_atomic_fetch_add(p, v, __ATOMIC_RELAXED, __HIP_MEMORY_SCOPE_AGENT); }
__device__ __forceinline__ unsigned xb_xcc_id() { return (unsigned)__builtin_amdgcn_s_getreg((3 << 11) | 20) & 0xFu; }
#define XB_SPIN(cond, bar) do { unsigned _sp = 0; while (cond) { __builtin_amdgcn_s_sleep(1); \
    if ((++_sp & 255u) == 0u) { if (xb_ld(&(bar)[XB_TMO])) break; if (_sp > XB_SPIN_CAP) { atomicAdd(&(bar)[XB_TMO], 1u); break; } } } } while (0)

struct XcdBarrier {
    unsigned* bar; unsigned x;
    volatile LAS unsigned* st;
};

__device__ __forceinline__ XcdBarrier xcd_barrier_post(unsigned* bar, volatile LAS unsigned* st) {
    XcdBarrier b; b.bar = bar; b.x = xb_xcc_id(); b.st = st;
    if (threadIdx.x == 0) (void)xb_add(&bar[XB_XCNT(b.x)], 1u);
    return b;
}
__device__ __forceinline__ void xcd_barrier_complete(unsigned* bar, unsigned x, unsigned& nloc, unsigned& nx) {
    const unsigned G = gridDim.x * gridDim.y * gridDim.z;
    unsigned sum, cnt, mine, sp = 0u;
    for (;;) {
        sum = 0u; cnt = 0u; mine = 0u;
#pragma unroll
        for (unsigned j = 0; j < 16; ++j) { const unsigned c = xb_ld(&bar[XB_XCNT(j)]); sum += c; cnt += (c > 0u) ? 1u : 0u; mine = (j == x) ? c : mine; }
        if (sum == G) break;
        __builtin_amdgcn_s_sleep(1);
        if ((++sp & 255u) == 0u) { if (xb_ld(&bar[XB_TMO])) break; if (sp > XB_SPIN_CAP) { atomicAdd(&bar[XB_TMO], 1u); break; } }
    }
    nloc = mine > 0u ? mine : 1u; nx = cnt > 0u ? cnt : 1u;
}

__device__ __forceinline__ void xcd_barrier(const XcdBarrier& b) {
    asm volatile("s_waitcnt vmcnt(0)" ::: "memory");
    __syncthreads();
    if (threadIdx.x == 0) {
        unsigned* bar = b.bar;
        __builtin_amdgcn_s_waitcnt(0);
        unsigned nloc = b.st[0], nx = b.st[1];
        if (nloc == 0u) { xcd_barrier_complete(bar, b.x, nloc, nx); b.st[0] = nloc; b.st[1] = nx; }
        const unsigned old = xb_add(&bar[XB_XSUB(b.x)], 1u);
        const unsigned gen = old / nloc;
        if (old + 1u == (gen + 1u) * nloc) {
            __builtin_amdgcn_fence(__ATOMIC_RELEASE, "agent");
            asm volatile("s_waitcnt vmcnt(0)" ::: "memory");
            const unsigned og = xb_add(&bar[XB_TOP], 1u);
            const unsigned tg = og / nx;
            if (og + 1u == (tg + 1u) * nx) xb_add(&bar[XB_TOPGEN], 1u);
            else XB_SPIN(xb_ld(&bar[XB_TOPGEN]) == tg, bar);
            __builtin_amdgcn_fence(__ATOMIC_ACQUIRE, "agent");
            xb_add(&bar[XB_XGEN(b.x)], 1u);
            asm volatile("s_waitcnt vmcnt(0)" ::: "memory");
        } else {
            XB_SPIN(xb_ld(&bar[XB_XGEN(b.x)]) == gen, bar);
            __builtin_amdgcn_fence(__ATOMIC_ACQUIRE, "agent");
            asm volatile("s_waitcnt vmcnt(0)" ::: "memory");
        }
    }
    __syncthreads();
}


#ifndef PHASE_MASK
#define PHASE_MASK 0x3ff
#endif
#define HAS(k) (((PHASE_MASK) >> (k)) & 1)
struct Args { const float* in[23]; float* out; unsigned char* ws; int ph_lo, ph_hi; };
constexpr int N_PHASES = 18;

__global__ void __launch_bounds__(512, 2) mega_fwd(Args args) {
    extern __shared__ __attribute__((aligned(16))) unsigned char lds_raw[];
    cg::grid_group grid = cg::this_grid();
    Ctx C;
    C.lds = (LAS unsigned char*)lds_raw; C.misc = (volatile LAS int*)(C.lds + LDS_MISC);
    C.tid = threadIdx.x; C.lane = C.tid & 63; C.wave = __builtin_amdgcn_readfirstlane(C.tid >> 6); C.G = gridDim.x; C.bid = blockIdx.x;
    const int lo = args.ph_lo, hi = args.ph_hi;
    if (threadIdx.x < 64) ((volatile LAS int*)(C.lds + LDS_MISC))[threadIdx.x] = 0;
    __syncthreads();
    XcdBarrier xbar = xcd_barrier_post((unsigned*)(args.ws + WS_CTL) + CW_BAR, (volatile LAS unsigned*)(C.lds + LDS_MISC) + 8);
    typedef const Args __attribute__((address_space(4)))* KArgP;
#define CTX_REFRESH() do { KArgP ka_ = (KArgP)__builtin_amdgcn_kernarg_segment_ptr(); asm volatile("" : "+s"(ka_)); \
        _Pragma("unroll") for (int i_ = 0; i_ < 23; ++i_) C.in[i_] = ka_->in[i_]; C.out = ka_->out; C.ws = ka_->ws; \
        int t_ = threadIdx.x; asm volatile("" : "+v"(t_)); C.tid = t_; C.lane = t_ & 63; C.wave = __builtin_amdgcn_readfirstlane(t_ >> 6); } while (0)
#define IN(k) (lo <= (k) && (k) < hi)
#define SEAM(k) do { if (IN(k) && IN((k) + 1)) { if ((k) == 0) grid.sync(); else xcd_barrier(xbar); } } while (0)
#define HN ((bf16_t*)(C.ws + WS_HN))
#define PROJ ((bf16_t*)(C.ws + WS_PROJ))
#define CAT ((bf16_t*)(C.ws + WS_CAT))
#define XSS ((bf16_t*)(C.ws + WS_XSS))
#define ACT ((bf16_t*)(C.ws + WS_ACT))
#define YB ((bf16_t*)(C.ws + WS_PROJ))

    if (HAS(0) && IN(0)) { CTX_REFRESH(); phase_prologue(C); } SEAM(0);
    if (PROBE == 1) { CTX_REFRESH(); phase_prologue(C); xcd_barrier(xbar); }
    for (int l = 0; l < NLAYER; ++l) {
        const int p0 = 1 + 8 * l;
        if (HAS(1) && IN(p0 + 0)) { CTX_REFRESH();
            if (l == 0) phase_norm<0>(C, C.in[IN_X], nullptr, C.in[IN_ANORM], HN, nullptr);
            else { load_starts(C, l - 1); phase_norm<1>(C, C.out, C.out, C.in[IN_ANORM] + l * DM, HN, nullptr); }
        } SEAM(p0 + 0);
        if (PROBE == 8 && l == 0) { CTX_REFRESH(); phase_norm<0>(C, C.in[IN_X], nullptr, C.in[IN_ANORM], HN, nullptr); xcd_barrier(xbar); }
        if (HAS(2) && IN(p0 + 1)) { CTX_REFRESH();
            pg8::Gemm g{HN, (const bf16_t*)(C.ws + WS_WIN) + (size_t)l * INC * DM, T, INC, DM}; pg8::StaticOrder S; S.init(T, INC, C.G, C.bid);
            EpiProj E{PROJ, (const float*)(C.ws + WS_COS), (const float*)(C.ws + WS_SIN)};
            pg8::gemm_phase<EpiProj, pg8::StaticOrder, true, true>(C.lds, g, S, E, C.tid);
        } SEAM(p0 + 1);
        if (PROBE == 2 && l == 0) { CTX_REFRESH();
            pg8::Gemm g{HN, (const bf16_t*)(C.ws + WS_WIN) + (size_t)l * INC * DM, T, INC, DM}; pg8::StaticOrder S; S.init(T, INC, C.G, C.bid);
            EpiProj E{PROJ, (const float*)(C.ws + WS_COS), (const float*)(C.ws + WS_SIN)};
            pg8::gemm_phase<EpiProj, pg8::StaticOrder, true, true>(C.lds, g, S, E, C.tid); xcd_barrier(xbar); }
        if (HAS(3) && IN(p0 + 2)) { CTX_REFRESH(); phase_mixers(C, l); } SEAM(p0 + 2);
        if (PROBE >= 30 && PROBE <= 37 && l == 0) { CTX_REFRESH(); phase_mixers(C, l, 2, PROBE - 30); xcd_barrier(xbar); }
        if (HAS(4) && IN(p0 + 3)) { CTX_REFRESH();
            pg8::Gemm g{CAT, (const bf16_t*)(C.ws + WS_WOUT) + (size_t)l * DM * DM, T, DM, DM}; pg8::StaticOrder S; S.init(T, DM, C.G, C.bid);
            EpiResid E{l == 0 ? C.in[IN_X] : C.out, C.out};
            pg8::gemm_phase<EpiResid, pg8::StaticOrder, true, true>(C.lds, g, S, E, C.tid);
        } SEAM(p0 + 3);
        if (PROBE == 4 && l == 0) { CTX_REFRESH();
            pg8::Gemm g{CAT, (const bf16_t*)(C.ws + WS_WOUT) + (size_t)l * DM * DM, T, DM, DM}; pg8::StaticOrder S; S.init(T, DM, C.G, C.bid);
            EpiResid E{C.in[IN_X], C.out};
            pg8::gemm_phase<EpiResid, pg8::StaticOrder, true, true>(C.lds, g, S, E, C.tid); xcd_barrier(xbar); }
        if (HAS(5) && IN(p0 + 4)) { CTX_REFRESH(); phase_router(C, l); } SEAM(p0 + 4);
        if (HAS(6) && IN(p0 + 5)) { CTX_REFRESH(); phase_gather(C, l); } SEAM(p0 + 5);
        if (PROBE == 5 && l == 0) { CTX_REFRESH(); phase_gather(C, l); xcd_barrier(xbar); }
        if (HAS(7) && IN(p0 + 6)) { CTX_REFRESH();
            load_starts(C, l);
            pg8::Gemm g{XSS, (const bf16_t*)(C.ws + WS_WGU) + (size_t)l * NEXP * 1024 * DM, NASSIGN, 1024, DM};
            pg8::MoeOrder S{(const LAS int*)(C.lds + LDS_MISC) + MI_ST, (const LAS int*)(C.lds + LDS_MISC) + MI_TP, 4, 1024, C.G, C.bid};
            EpiGU E{ACT};
            pg8::gemm_phase<EpiGU, pg8::MoeOrder, true, true>(C.lds, g, S, E, C.tid);
        } SEAM(p0 + 6);
        if (PROBE == 6 && l == 0) { CTX_REFRESH();
            load_starts(C, l);
            pg8::Gemm g{XSS, (const bf16_t*)(C.ws + WS_WGU) + (size_t)l * NEXP * 1024 * DM, NASSIGN, 1024, DM};
            pg8::MoeOrder S{(const LAS int*)(C.lds + LDS_MISC) + MI_ST, (const LAS int*)(C.lds + LDS_MISC) + MI_TP, 4, 1024, C.G, C.bid};
            EpiGU E{ACT};
            pg8::gemm_phase<EpiGU, pg8::MoeOrder, true, true>(C.lds, g, S, E, C.tid); xcd_barrier(xbar); }
        if (HAS(8) && IN(p0 + 7)) { CTX_REFRESH();
            load_starts(C, l);
            pg8::Gemm g{ACT, (const bf16_t*)(C.ws + WS_WDN) + (size_t)l * NEXP * DM * DFF, NASSIGN, DM, DFF};
            pg8::MoeOrder S{(const LAS int*)(C.lds + LDS_MISC) + MI_ST, (const LAS int*)(C.lds + LDS_MISC) + MI_TP, 8, DM, C.G, C.bid};
            EpiDown E{YB, (const float*)(C.ws + WS_SGATE)};
            pg8::gemm_phase<EpiDown, pg8::MoeOrder, true, true>(C.lds, g, S, E, C.tid);
        } SEAM(p0 + 7);
        if (PROBE == 7 && l == 0) { CTX_REFRESH();
            load_starts(C, l);
            pg8::Gemm g{ACT, (const bf16_t*)(C.ws + WS_WDN) + (size_t)l * NEXP * DM * DFF, NASSIGN, DM, DFF};
            pg8::MoeOrder S{(const LAS int*)(C.lds + LDS_MISC) + MI_ST, (const LAS int*)(C.lds + LDS_MISC) + MI_TP, 8, DM, C.G, C.bid};
            EpiDown E{YB, (const float*)(C.ws + WS_SGATE)};
            pg8::gemm_phase<EpiDown, pg8::MoeOrder, true, true>(C.lds, g, S, E, C.tid); xcd_barrier(xbar); }
    }
    if (HAS(9) && IN(17)) { CTX_REFRESH(); load_starts(C, NLAYER - 1); phase_norm<2>(C, C.out, nullptr, C.in[IN_FINAL], nullptr, C.out); }
#undef IN
#undef SEAM
#undef HN
#undef PROJ
#undef CAT
#undef XSS
#undef ACT
#undef YB
}

#ifndef MK_PER_PHASE
#define MK_PER_PHASE 0
#endif
extern "C" void kernel_launch(void* const* d_in, const int* in_sizes, int n_in, void* d_out, int out_size, void* d_ws, size_t ws_size, hipStream_t stream) {
    static int grid = 0;
    if (grid == 0) {
        if (n_in != 23 || in_sizes[0] != T * DM || out_size != T * DM || ws_size < WS_END) { fprintf(stderr, "kernel_launch: unexpected shapes (n_in %d, in0 %d, out %d, ws %zu < %zu)\n", n_in, n_in > 0 ? in_sizes[0] : -1, out_size, ws_size, (size_t)WS_END); grid = -1; return; }
        int dev = 0, cus = 0, per_cu = 0;
        hipGetDevice(&dev); hipDeviceGetAttribute(&cus, hipDeviceAttributeMultiprocessorCount, dev);
        if (hipFuncSetAttribute((const void*)mega_fwd, hipFuncAttributeMaxDynamicSharedMemorySize, LDS_BYTES) != hipSuccess) { fprintf(stderr, "kernel_launch: hipFuncSetAttribute failed\n"); grid = -1; return; }
        if (hipOccupancyMaxActiveBlocksPerMultiprocessor(&per_cu, (const void*)mega_fwd, 512, LDS_BYTES) != hipSuccess || per_cu < 1) { fprintf(stderr, "kernel_launch: occupancy query says %d blocks per CU\n", per_cu); per_cu = 1; }
        (void)hipGetLastError();
        grid = cus * 1;
        fprintf(stderr, "kernel_launch: %d CUs, occupancy %d/CU, grid %d\n", cus, per_cu, grid);
    }
    if (grid < 0) return;
    hipMemsetAsync((char*)d_ws + WS_CTL, 0, CTL_ZERO_BYTES, stream);
    Args a{};
    for (int i = 0; i < 23; ++i) a.in[i] = (const float*)d_in[i];
    a.out = (float*)d_out; a.ws = (unsigned char*)d_ws;
#if MK_PER_PHASE
    for (int p = 0; p < N_PHASES; ++p) {
        a.ph_lo = p; a.ph_hi = p + 1; void* kargs[] = {&a};
        hipError_t e = hipLaunchCooperativeKernel((const void*)mega_fwd, dim3(grid), dim3(512), kargs, LDS_BYTES, stream);
        if (e != hipSuccess) { fprintf(stderr, "launch of phase %d failed: %s\n", p, hipGetErrorString(e)); break; }
    }
#else
    a.ph_lo = 0; a.ph_hi = N_PHASES; void* kargs[] = {&a};
    hipError_t e = hipLaunchCooperativeKernel((const void*)mega_fwd, dim3(grid), dim3(512), kargs, LDS_BYTES, stream);
    if (e != hipSuccess) fprintf(stderr, "cooperative launch failed: %s (grid %d)\n", hipGetErrorString(e), grid);
#endif
}
```

```cpp
#include <hip/hip_runtime.h>
#include <hip/hip_cooperative_groups.h>
#include <cstdio>
#include <cstdint>
namespace cg = cooperative_groups;
#ifndef PROBE
#define PROBE 0
#endif
#ifndef MK_PER_PHASE
#define MK_PER_PHASE 0
#endif

namespace pg8 {
#define PG8_LAS __attribute__((address_space(3)))
typedef unsigned short bf16_t;
typedef short bf16x8 __attribute__((ext_vector_type(8)));
typedef float f32x4 __attribute__((ext_vector_type(4)));
typedef unsigned u32x4 __attribute__((ext_vector_type(4)));
constexpr int BM = 256, BK = 64, HALF = 128, HTB = HALF * BK * 2  , STAGE_BYTES = 8 * HTB, NXCD = 8, WGM = 8;

__host__ __device__ __forceinline__ int lds_byte(int r, int c) { const int st = (r >> 4) * 2 + (c >> 5), rr = r & 15, cc = c & 31, ob = rr * 64 + cc * 2; return st * 1024 + (ob ^ (((ob >> 9) & 1) << 5)); }
__host__ __device__ __forceinline__ void stage_rc(int b, int& R, int& C) { const int st = b / 1024, sb = b % 1024, swz = sb ^ (((sb >> 9) & 1) << 5); R = (st >> 1) * 16 + swz / 64; C = (st & 1) * 32 + (swz % 64) / 2; }
__host__ __device__ __forceinline__ int perm32(int rho) { const int n = rho >> 4, i = rho & 15; return 8 * (i >> 2) + 4 * n + (i & 3); }

struct Unit { int am, bn, pm, pn, e, valid; };
struct Gemm { const bf16_t* A; const bf16_t* Bt; int M, N, K; };

struct StaticOrder {
    int nM, nN, nwg, G, c;
    __device__ void init(int M, int N, int G_, int c_) { nM = M / BM; nN = N / BM; nwg = nM * nN; G = G_; c = c_; }
    __device__ bool next(int i, Unit& u) const {
        const long L = (long)i * G + c; if (L >= nwg) return false;
        int wgid = (int)L; { const int q = nwg / NXCD, r = nwg % NXCD, xcd = wgid % NXCD, off = wgid / NXCD; wgid = (xcd < r ? xcd * (q + 1) : r * (q + 1) + (xcd - r) * q) + off; }
        const int nig = WGM * nN, gid = wgid / nig, fm = gid * WGM, gsz = (nM - fm) < WGM ? (nM - fm) : WGM;
        u.pm = fm + ((wgid % nig) % gsz); u.pn = (wgid % nig) / gsz; u.am = u.pm * BM; u.bn = u.pn * BM; u.e = 0; u.valid = BM; return true;
    }
    __device__ __forceinline__ void a_ready(const Unit&) const {}
    __device__ __forceinline__ void done(const Unit&) const {}
};
struct MoeOrder {
    const PG8_LAS int* ST;
    const PG8_LAS int* TP;
    int NP, NB, G, c;
    __device__ bool next(int i, Unit& u) const {
#define RFL(x) __builtin_amdgcn_readfirstlane(x)
        const int U = RFL(TP[32]) * NP, CH = (U + NXCD - 1) / NXCD;
        const int x = c % NXCD, j = c / NXCD + (G / NXCD) * i;
        if (j >= CH) return false;
        const int ui = x * CH + j; if (ui >= U) return false;
        const int t = ui / NP, pn = ui % NP;
        int e = 0;
        while (e < 31 && RFL(TP[e + 1]) <= t) ++e;
        const int tpe = RFL(TP[e]), ste = RFL(ST[e]), ste1 = RFL(ST[e + 1]);
        const int mt = t - tpe, cnt = ste1 - ste;
        u.e = e; u.pm = mt; u.pn = pn; u.am = ste + mt * BM; u.bn = e * NB + pn * BM; u.valid = (cnt - mt * BM) < BM ? (cnt - mt * BM) : BM; return true;
#undef RFL
    }
    __device__ __forceinline__ void a_ready(const Unit&) const {}
    __device__ __forceinline__ void done(const Unit&) const {}
};

__device__ __forceinline__ unsigned cvt_pk_bf16(float lo, float hi) { unsigned r; asm volatile("v_cvt_pk_bf16_f32 %0, %1, %2" : "=v"(r) : "v"(lo), "v"(hi)); return r; }

template <class Epi, class Sched, bool ALIGN_EPI = false, bool SP2 = false, bool GATHER = false>
__device__ __forceinline__ void gemm_phase(PG8_LAS unsigned char* lds, const Gemm g, const Sched& S, const Epi& E, const int tid, const PG8_LAS int* tk = nullptr) {
    static_assert(SP2 || !GATHER, "gather needs the SP2 loop");
    const int wid = __builtin_amdgcn_readfirstlane(tid >> 6), lane = tid & 63, wr = wid >> 2, wc = wid & 3, fr = lane & 15, fq = lane >> 4;
    const int K = g.K, nt = K / BK;
    unsigned voffA[2], voffB[2]; int gR[2]; unsigned gC[2];
    { int R, C; stage_rc(tid * 16, R, C); const int Rb = Epi::PERM ? ((R & ~31) + perm32(R & 31)) : R;
      voffA[0] = (unsigned)(R * K + C) * 2u; voffB[0] = (unsigned)(Rb * K + C) * 2u; gR[0] = R; gC[0] = (unsigned)C * 2u;
      voffA[1] = voffA[0] + (unsigned)(64 * K * 2); voffB[1] = voffB[0] + (unsigned)(64 * K * 2); gR[1] = R + 64; gC[1] = gC[0]; }
    const size_t kstep = (size_t)(BK * 2);
    const size_t hstep = (size_t)HALF * K * 2;
    const size_t rowb = (size_t)K * 2;
    const unsigned ldsw = (unsigned)wid * 1024u;
    const int aoff = lds_byte(wr * 64 + fr, fq * 8), boff = lds_byte(wc * 32 + fr, fq * 8);
#define PG8_SA(b, h) (((b) * 2 + (h)) * HTB)
#define PG8_SB(b, h) ((4 + (b) * 2 + (h)) * HTB)
#define PG8_STAGE(bufoff, gbase, voff) do { _Pragma("unroll") for (int _i = 0; _i < 2; ++_i) \
        __builtin_amdgcn_global_load_lds((const unsigned*)((const char*)(gbase) + (size_t)_i * (64 * rowb) + (voff)[0]), (PG8_LAS unsigned*)(lds + (bufoff) + ldsw + _i * 8192), 16, 0, 0); } while (0)
#define PG8_STAGE2(bufoff, gbase, voff) do { _Pragma("unroll") for (int _i = 0; _i < 2; ++_i) \
        __builtin_amdgcn_global_load_lds((const unsigned*)((const char*)(gbase) + (voff)[_i]), (PG8_LAS unsigned*)(lds + (bufoff) + ldsw + _i * 8192), 16, 0, 0); } while (0)
#define PG8_STAGE_A(bufoff, h, ptr, kb, nx) do { if constexpr (GATHER) { unsigned go_[2]; const int ub_ = ((nx) ? ui + 1 : ui) * 256 + (h) * 128 + gR[0]; \
        go_[0] = (unsigned)tk[ub_] * (unsigned)(K * 2) + gC[0]; go_[1] = (unsigned)tk[ub_ + 64] * (unsigned)(K * 2) + gC[0]; \
        PG8_STAGE2(bufoff, (const char*)g.A + (kb), go_); } else { PG8_STAGE(bufoff, ptr, voffA); } } while (0)
#define PG8_LDA(dst, b, h) do { _Pragma("unroll") for (int m = 0; m < 4; ++m) _Pragma("unroll") for (int k = 0; k < 2; ++k) dst[m][k] = *(const PG8_LAS bf16x8*)(lds + PG8_SA(b, h) + aoff + m * 2048 + k * 1024); } while (0)
#define PG8_LDB(dst, b, h) do { _Pragma("unroll") for (int n = 0; n < 2; ++n) _Pragma("unroll") for (int k = 0; k < 2; ++k) dst[n][k] = *(const PG8_LAS bf16x8*)(lds + PG8_SB(b, h) + boff + n * 2048 + k * 1024); } while (0)
#define PG8_MMA(ai, bj, At, Bt) do { __builtin_amdgcn_s_setprio(1); _Pragma("unroll") for (int m = 0; m < 4; ++m) _Pragma("unroll") for (int n = 0; n < 2; ++n) _Pragma("unroll") for (int k = 0; k < 2; ++k) \
        acc[ai][bj][m][n] = __builtin_amdgcn_mfma_f32_16x16x32_bf16(Bt[n][k], At[m][k], acc[ai][bj][m][n], 0, 0, 0); __builtin_amdgcn_s_setprio(0); } while (0)
#define PG8_WAIT_V(n) asm volatile("s_waitcnt vmcnt(" #n ")" ::: "memory")
#define PG8_WAIT_L(n) asm volatile("s_waitcnt lgkmcnt(" #n ")" ::: "memory")
#define PG8_BAR __builtin_amdgcn_s_barrier()
#define PG8_SCHED __builtin_amdgcn_sched_barrier(0)
    Unit cur, nxt; int ui = 0;
    if (!S.next(0, cur)) return;
    f32x4 acc[2][2][4][2];
#pragma unroll
    for (int a = 0; a < 2; ++a)
#pragma unroll
        for (int b = 0; b < 2; ++b)
#pragma unroll
            for (int m = 0; m < 4; ++m)
#pragma unroll
                for (int n = 0; n < 2; ++n) acc[a][b][m][n] = (f32x4){0.f, 0.f, 0.f, 0.f};
    bf16x8 At[4][2], B0[2][2], B1[2][2];
    const char* cA = (const char*)g.A + (size_t)cur.am * rowb; const char* cB = (const char*)g.Bt + (size_t)cur.bn * rowb;
    S.a_ready(cur);
    if constexpr (SP2) {
        PG8_STAGE(PG8_SB(0, 0), cB, voffB); PG8_STAGE(PG8_SB(0, 1), cB + hstep, voffB); PG8_STAGE_A(PG8_SA(0, 0), 0, cA, 0, false); PG8_STAGE_A(PG8_SA(0, 1), 1, cA + hstep, 0, false);
        if (wr == 1) PG8_BAR;
        PG8_WAIT_V(2); PG8_BAR;
        PG8_STAGE(PG8_SB(1, 0), cB + kstep, voffB); PG8_STAGE_A(PG8_SA(1, 0), 0, cA + kstep, kstep, false); PG8_STAGE(PG8_SB(1, 1), cB + hstep + kstep, voffB);
        PG8_WAIT_V(6); PG8_BAR;
    } else {
        PG8_STAGE(PG8_SB(0, 0), cB, voffB); PG8_STAGE(PG8_SA(0, 0), cA, voffA); PG8_STAGE(PG8_SB(0, 1), cB + hstep, voffB); PG8_STAGE(PG8_SA(0, 1), cA + hstep, voffA);
        if (wr == 1) PG8_BAR;
        PG8_WAIT_V(4); PG8_BAR;
        PG8_STAGE(PG8_SB(1, 0), cB + kstep, voffB); PG8_STAGE(PG8_SA(1, 0), cA + kstep, voffA); PG8_STAGE(PG8_SB(1, 1), cB + hstep + kstep, voffB);
        PG8_WAIT_V(6); PG8_BAR;
    }
    for (;;) {
        const bool has_next = S.next(ui + 1, nxt);
        const char* nA = has_next ? (const char*)g.A + (size_t)nxt.am * rowb : cA; const char* nB = has_next ? (const char*)g.Bt + (size_t)nxt.bn * rowb : cB;
        for (int t = 0; t < nt; t += 2) {
            const bool last = (t == nt - 2);
            const char* a1 = cA + (size_t)(t + 1) * kstep;
            const char* a2 = last ? nA : cA + (size_t)(t + 2) * kstep; const char* b2 = last ? nB : cB + (size_t)(t + 2) * kstep;
            const char* a3 = a2 + kstep; const char* b3 = b2 + kstep;
            const size_t gk2 = last ? 0 : (size_t)(t + 2) * kstep; const bool gnx = last && has_next;
            if (last && has_next) S.a_ready(nxt);
            if constexpr (SP2) {
            PG8_LDB(B0, 0, 0); PG8_LDB(B1, 0, 1); PG8_SCHED; PG8_LDA(At, 0, 0); PG8_STAGE_A(PG8_SA(1, 1), 1, a1 + hstep, (size_t)(t + 1) * kstep, false);
            PG8_WAIT_V(8); PG8_WAIT_L(0); PG8_BAR; PG8_MMA(0, 0, At, B0); PG8_MMA(0, 1, At, B1); PG8_BAR; PG8_SCHED;
            PG8_LDA(At, 0, 1); PG8_STAGE(PG8_SB(0, 0), b2, voffB); PG8_STAGE(PG8_SB(0, 1), b2 + hstep, voffB); PG8_STAGE_A(PG8_SA(0, 0), 0, a2, gk2, gnx);
            PG8_WAIT_V(8); PG8_WAIT_L(0); PG8_BAR; PG8_MMA(1, 0, At, B0); PG8_MMA(1, 1, At, B1); PG8_BAR; PG8_SCHED;
            PG8_LDB(B0, 1, 0); PG8_LDB(B1, 1, 1); PG8_SCHED; PG8_LDA(At, 1, 0); PG8_STAGE_A(PG8_SA(0, 1), 1, a2 + hstep, gk2, gnx);
            PG8_WAIT_V(8); PG8_WAIT_L(0); PG8_BAR; PG8_MMA(0, 0, At, B0); PG8_MMA(0, 1, At, B1); PG8_BAR; PG8_SCHED;
            PG8_LDA(At, 1, 1); PG8_STAGE(PG8_SB(1, 0), b3, voffB); PG8_STAGE(PG8_SB(1, 1), b3 + hstep, voffB); PG8_STAGE_A(PG8_SA(1, 0), 0, a3, gk2 + kstep, gnx);
            PG8_WAIT_V(8); PG8_WAIT_L(0); PG8_BAR; PG8_MMA(1, 0, At, B0); PG8_MMA(1, 1, At, B1); PG8_BAR; PG8_SCHED;
            } else {
            PG8_LDB(B0, 0, 0); PG8_SCHED; PG8_LDA(At, 0, 0); PG8_STAGE(PG8_SA(1, 1), a1 + hstep, voffA);
            PG8_WAIT_L(8); PG8_BAR; PG8_WAIT_L(0); PG8_MMA(0, 0, At, B0); PG8_BAR; PG8_SCHED;
            PG8_LDB(B1, 0, 1); PG8_STAGE(PG8_SB(0, 0), b2, voffB);
            PG8_BAR; PG8_WAIT_L(0); PG8_MMA(0, 1, At, B1); PG8_BAR;
            PG8_LDA(At, 0, 1); PG8_STAGE(PG8_SA(0, 0), a2, voffA);
            PG8_BAR; PG8_WAIT_L(0); PG8_MMA(1, 0, At, B0); PG8_BAR; PG8_SCHED;
            PG8_STAGE(PG8_SB(0, 1), b2 + hstep, voffB);
            PG8_WAIT_V(6); PG8_BAR; PG8_MMA(1, 1, At, B1); PG8_BAR;
            PG8_LDB(B0, 1, 0); PG8_SCHED; PG8_LDA(At, 1, 0); PG8_STAGE(PG8_SA(0, 1), a2 + hstep, voffA);
            PG8_WAIT_L(8); PG8_BAR; PG8_WAIT_L(0); PG8_MMA(0, 0, At, B0); PG8_BAR; PG8_SCHED;
            PG8_LDB(B1, 1, 1); PG8_STAGE(PG8_SB(1, 0), b3, voffB);
            PG8_BAR; PG8_WAIT_L(0); PG8_MMA(0, 1, At, B1); PG8_BAR;
            PG8_LDA(At, 1, 1); PG8_STAGE(PG8_SA(1, 0), a3, voffA);
            PG8_BAR; PG8_WAIT_L(0); PG8_MMA(1, 0, At, B0); PG8_BAR; PG8_SCHED;
            PG8_STAGE(PG8_SB(1, 1), b3 + hstep, voffB);
            PG8_WAIT_V(6); PG8_BAR; PG8_MMA(1, 1, At, B1); PG8_BAR;
            }
        }
        if constexpr (ALIGN_EPI) { if (wr == 0) PG8_BAR; }
        if constexpr (!Epi::AFTER_DRAIN) { E(acc, cur, wr, wc, fr, fq); S.done(cur); }
        if (!has_next) break;
#pragma unroll
        for (int a = 0; a < 2; ++a)
#pragma unroll
            for (int b = 0; b < 2; ++b)
#pragma unroll
                for (int m = 0; m < 4; ++m)
#pragma unroll
                    for (int n = 0; n < 2; ++n) acc[a][b][m][n] = (f32x4){0.f, 0.f, 0.f, 0.f};
        cur = nxt; cA = nA; cB = nB; ++ui;
        if constexpr (ALIGN_EPI) { if (wr == 1) PG8_BAR; }
    }
    PG8_WAIT_V(0);
    if constexpr (!ALIGN_EPI) { if (wr == 0) PG8_BAR; }
    PG8_BAR;
    if constexpr (Epi::AFTER_DRAIN) { E.fused(acc, cur, wr, wc, fr, fq, lds, wid, lane); S.done(cur); }
#undef PG8_SA
#undef PG8_SB
#undef PG8_STAGE
#undef PG8_STAGE2
#undef PG8_STAGE_A
#undef PG8_LDA
#undef PG8_LDB
#undef PG8_MMA
#undef PG8_WAIT_V
#undef PG8_WAIT_L
#undef PG8_BAR
#undef PG8_SCHED
}
}

#define LAS __attribute__((address_space(3)))
typedef unsigned short bf16_t;
typedef short bf16x8 __attribute__((ext_vector_type(8)));
typedef float f32x4 __attribute__((ext_vector_type(4)));
typedef float f32x16 __attribute__((ext_vector_type(16)));
typedef unsigned u32x4 __attribute__((ext_vector_type(4)));
typedef unsigned u32x2 __attribute__((ext_vector_type(2)));
typedef short s16x4 __attribute__((ext_vector_type(4)));
typedef LAS const char* lds_cptr;
using pg8::Unit;

constexpr int T = 16384, SEQ = 8192, DM = 2048, INC = 4096, NEXP = 32, DFF = 512, NASSIGN = 2 * T, NLAYER = 2;
constexpr float LOG2E = 1.4426950408889634f;
constexpr float C2 = 0.125f * LOG2E;
constexpr int C_QA = 0, C_KA = 768, C_VA = 1024, C_UB = 1280, C_QC = 1792, C_KC = 2560, C_VC = 3328;

constexpr size_t MiB = 1u << 20;
constexpr size_t WS_CTL = 0, CTL_ZERO_BYTES = 1 * MiB;
constexpr size_t WS_COS = 2 * MiB, WS_SIN = 4 * MiB;
constexpr size_t WS_TOKE = 6 * MiB, WS_TOKG = 6 * MiB + 256 * 1024, WS_TOKP = 6 * MiB + 512 * 1024, WS_SGATE = 6 * MiB + 768 * 1024;
constexpr size_t WS_ROWTOK = 8 * MiB, WS_ROWGATE = 10 * MiB;
constexpr size_t WS_LAM = 6 * MiB + 1000 * 1024;
constexpr size_t WS_WR = 12 * MiB;
constexpr size_t WS_WIN = 16 * MiB, WS_WOUT = 48 * MiB, WS_WGU = 64 * MiB, WS_WDN = 320 * MiB;
constexpr size_t WS_HN = 448 * MiB, WS_PROJ = 512 * MiB, WS_CAT = 642 * MiB, WS_XSS = 706 * MiB, WS_ACT = 835 * MiB, WS_END = 868 * MiB;
constexpr int CW_QCTR = 0;
constexpr int CW_CUR = 1024;
constexpr int CW_BAR = 8192;

constexpr int LDS_WSF = 135168, LDS_MISC = 137216, LDS_BYTES = 147456;
constexpr int MI_ST = 16, MI_TP = 64, MI_LCNT = 128, MI_LBASE = 160, MI_SSQ = 256;

#define LDS_WAIT() asm volatile("s_waitcnt lgkmcnt(0)" ::: "memory")
__device__ __forceinline__ unsigned f2bf(float f) { unsigned u = __builtin_bit_cast(unsigned, f); return (u + 0x7fffu + ((u >> 16) & 1u)) >> 16; }
__device__ __forceinline__ unsigned pk2(float lo, float hi) { return f2bf(lo) | (f2bf(hi) << 16); }
__device__ __forceinline__ float bf2f(unsigned b) { return __builtin_bit_cast(float, b << 16); }
typedef float f32x2_t __attribute__((ext_vector_type(2))); typedef __bf16 bf16x2_t __attribute__((ext_vector_type(2)));
__device__ __forceinline__ unsigned cvtpk(float lo, float hi) { f32x2_t v = {lo, hi}; bf16x2_t b = __builtin_convertvector(v, bf16x2_t); return __builtin_bit_cast(unsigned, b); }
__device__ __forceinline__ float wave_sum(float v) {
#pragma unroll
    for (int o = 1; o < 64; o <<= 1) v += __shfl_xor(v, o);
    return v;
}

struct Ctx {
    const float* in[23]; float* out; unsigned char* ws;
    LAS unsigned char* lds; volatile LAS int* misc;
    int tid, lane, wave, G, bid;
};
#define IN_X 0
#define IN_POS 1
#define IN_ANORM 2
#define IN_WIN 3
#define IN_SINKS 4
#define IN_BNA 5
#define IN_WPOOL 6
#define IN_PSCALE 7
#define IN_LQ1 8
#define IN_LK1 9
#define IN_LQ2 10
#define IN_LK2 11
#define IN_SUBLN 12
#define IN_WOUT 13
#define IN_FNORM 14
#define IN_WRG 15
#define IN_BRG 16
#define IN_WRE 17
#define IN_BRE 18
#define IN_WG 19
#define IN_WU 20
#define IN_WD 21
#define IN_FINAL 22

struct EpiProj {
    static constexpr bool PERM = true, AFTER_DRAIN = false;
    bf16_t* O; const float* cosT; const float* sinT;
    __device__ __forceinline__ void operator()(const f32x4 (&acc)[2][2][4][2], const Unit& u, int wr, int wc, int fr, int fq) const {
        const int pn = u.pn;
        const bool rope = (0x1F8Fu >> pn) & 1u;
        const float sc = ((0x0387u >> pn) & 1u) ? C2 : 1.f;
        const int row0 = u.pm * 256 + wr * 64 + fr, col0 = pn * 256 + wc * 32 + 8 * fq, fi = 16 * (wc & 1) + 4 * fq;
#pragma unroll
        for (int ai = 0; ai < 2; ++ai)
#pragma unroll
            for (int m = 0; m < 4; ++m) {
                const int row = row0 + ai * 128 + m * 16;
                f32x4 cs = {1.f, 1.f, 1.f, 1.f}, sn = {0.f, 0.f, 0.f, 0.f};
                if (rope) { cs = *(const f32x4*)(cosT + (size_t)row * 32 + fi); sn = *(const f32x4*)(sinT + (size_t)row * 32 + fi); }
                bf16_t* rowp = O + (size_t)row * INC + col0;
#pragma unroll
                for (int bj = 0; bj < 2; ++bj) {
                    const f32x4 v0 = acc[ai][bj][m][0], v1 = acc[ai][bj][m][1];
                    const f32x4 o0 = (v0 * cs - v1 * sn) * sc, o1 = (v1 * cs + v0 * sn) * sc;
                    u32x4 w; w.x = cvtpk(o0[0], o0[1]); w.y = cvtpk(o0[2], o0[3]); w.z = cvtpk(o1[0], o1[1]); w.w = cvtpk(o1[2], o1[3]);
                    *(u32x4*)(rowp + bj * 128) = w;
                }
            }
    }
};
struct EpiResid {
    static constexpr bool PERM = false, AFTER_DRAIN = false;
    const float* src; float* dst;
    __device__ __forceinline__ void operator()(const f32x4 (&acc)[2][2][4][2], const Unit& u, int wr, int wc, int fr, int fq) const {
        const int row0 = u.pm * 256 + wr * 64 + fr, col0 = u.pn * 256 + wc * 32 + 4 * fq;
#pragma unroll
        for (int ai = 0; ai < 2; ++ai)
#pragma unroll
            for (int m = 0; m < 4; ++m) {
                const size_t off = (size_t)(row0 + ai * 128 + m * 16) * DM + col0;
#pragma unroll
                for (int bj = 0; bj < 2; ++bj)
#pragma unroll
                    for (int n = 0; n < 2; ++n) { const f32x4 s = *(const f32x4*)(src + off + bj * 128 + n * 16); *(f32x4*)(dst + off + bj * 128 + n * 16) = s + acc[ai][bj][m][n]; }
            }
    }
};
struct EpiGU {
    static constexpr bool PERM = true, AFTER_DRAIN = false;
    bf16_t* ACT;
    __device__ __forceinline__ void operator()(const f32x4 (&acc)[2][2][4][2], const Unit& u, int wr, int wc, int fr, int fq) const {
        const int col0 = u.pn * 128 + wc * 32 + 8 * fq;
#pragma unroll
        for (int ai = 0; ai < 2; ++ai)
#pragma unroll
            for (int m = 0; m < 4; ++m) {
                const int r = ai * 128 + wr * 64 + m * 16 + fr;
                if (r < u.valid) {
                    float a[8];
#pragma unroll
                    for (int n = 0; n < 2; ++n)
#pragma unroll
                        for (int j = 0; j < 4; ++j) { const float g = acc[ai][0][m][n][j], up = acc[ai][1][m][n][j]; a[n * 4 + j] = g * __builtin_amdgcn_rcpf(1.f + __builtin_amdgcn_exp2f(-g * LOG2E)) * up; }
                    u32x4 w; w.x = cvtpk(a[0], a[1]); w.y = cvtpk(a[2], a[3]); w.z = cvtpk(a[4], a[5]); w.w = cvtpk(a[6], a[7]);
                    *(u32x4*)(ACT + (size_t)(u.am + r) * DFF + col0) = w;
                }
            }
    }
};
struct EpiDown {
    static constexpr bool PERM = true, AFTER_DRAIN = false;
    bf16_t* YB; const float* sgate;
    __device__ __forceinline__ void operator()(const f32x4 (&acc)[2][2][4][2], const Unit& u, int wr, int wc, int fr, int fq) const {
        const int col0 = u.pn * 256 + wc * 32 + 8 * fq;
#pragma unroll
        for (int ai = 0; ai < 2; ++ai)
#pragma unroll
            for (int m = 0; m < 4; ++m) {
                const int r = ai * 128 + wr * 64 + m * 16 + fr;
                if (r < u.valid) {
                    const float gt = sgate[u.e * T + u.pm * 256 + r];
                    bf16_t* rowp = YB + (size_t)(u.am + r) * DM + col0;
#pragma unroll
                    for (int bj = 0; bj < 2; ++bj) {
                        const f32x4 v0 = acc[ai][bj][m][0] * gt, v1 = acc[ai][bj][m][1] * gt;
                        u32x4 w; w.x = cvtpk(v0[0], v0[1]); w.y = cvtpk(v0[2], v0[3]); w.z = cvtpk(v1[0], v1[1]); w.w = cvtpk(v1[2], v1[3]);
                        *(u32x4*)(rowp + bj * 128) = w;
                    }
                }
            }
    }
};

template <class F> __device__ __forceinline__ void tr_item(const F& f, int K, bf16_t* WT, LAS float* scr, int kb, int nb, int lane) {
    const int k0 = 64 * kb, n0 = 32 * nb;
#pragma unroll 8
    for (int i = 0; i < 32; ++i) { const int kk = 2 * i + (lane >> 5); scr[kk * 33 + (lane & 31)] = f(k0 + kk, n0 + (lane & 31)); }
    LDS_WAIT(); asm volatile("" ::: "memory");
    const int c = lane & 7;
#pragma unroll
    for (int j = 0; j < 4; ++j) { const int n = (lane >> 3) + 8 * j; const LAS float* s = scr + (8 * c) * 33 + n;
        u32x4 o; o.x = pk2(s[0 * 33], s[1 * 33]); o.y = pk2(s[2 * 33], s[3 * 33]); o.z = pk2(s[4 * 33], s[5 * 33]); o.w = pk2(s[6 * 33], s[7 * 33]);
        *(u32x4*)(WT + (size_t)(n0 + n) * K + k0 + 8 * c) = o; }
    LDS_WAIT(); asm volatile("" ::: "memory");
}
__device__ __forceinline__ float lam_init_of(int l) { return l == 0 ? 0.2f : (0.8f - 0.6f * 0.74081822068171788f); }

struct FWin { const float* w;
    __device__ __forceinline__ float operator()(int k, int n) const {
        const int pn = n >> 8; int col = n;
        if ((pn <= 3) || (pn >= 7 && pn <= 12)) { const int cw = n & 63; col = (n & ~63) + 32 * ((cw >> 2) & 1) + 4 * (cw >> 3) + (cw & 3); }
        return w[(size_t)k * INC + col]; } };
struct FWgu { const float* w;
    __device__ __forceinline__ float operator()(int k, int n) const {
        const int col = 128 * (n >> 8) + (n & 127);
        return w[(size_t)k * DFF + col]; } };
struct FWdn { const float* w;
    __device__ __forceinline__ float operator()(int k, int n) const { return w[(size_t)k * DM + n]; } };
struct FWr { const float* wrg; const float* wre;
    __device__ __forceinline__ float operator()(int k, int n) const {
        const int hl = n >= 48, j = hl ? n - 48 : n;
        const bool isg = j < 4, ise = j >= 4 && j < 36;
        const float* base = isg ? wrg + j : wre + (ise ? j - 4 : 0); const int stride = isg ? 4 : 32;
        const float v = (isg || ise) ? base[(size_t)k * stride] : 0.f * base[(size_t)k * stride];
        const float hi = bf2f(f2bf(v)); return hl ? v - hi : v; } };

__device__ __forceinline__ void fold_item(const float* wout, const float* wpool, const float* pscale, bf16_t* WT, LAS float* scr, int g, int kbh, int nb, int lane) {
    const int n = 64 * nb + lane;
    const float* wp = wpool + ((size_t)g * 128 + 64 * kbh) * 128; const float* ps = pscale + g * 128; const float* wo = wout + (size_t)(768 + g * 128) * DM + n;
#pragma unroll 1
    for (int ih = 0; ih < 2; ++ih) {
        { const f32x4* src = (const f32x4*)(wp + (size_t)(32 * ih) * 128) + lane; f32x4 t[16];
#pragma unroll
          for (int q = 0; q < 16; ++q) t[q] = src[q * 64];
#pragma unroll
          for (int q = 0; q < 16; ++q) *(LAS f32x4*)(scr + (q * 64 + lane) * 4) = t[q]; }
        LDS_WAIT(); asm volatile("" ::: "memory");
        float acc[32];
#pragma unroll
        for (int i = 0; i < 32; ++i) acc[i] = 0.f;
#pragma unroll 1
        for (int jb = 0; jb < 16; ++jb) {
            float bv[8];
            { const float* wj = wo + (size_t)(jb * 8) * DM; const float* pj = ps + jb * 8;
#pragma unroll
              for (int jj = 0; jj < 8; ++jj) bv[jj] = wj[(size_t)jj * DM] * pj[jj]; }
#pragma unroll
            for (int ic = 0; ic < 8; ++ic) {
#pragma unroll
                for (int i = 4 * ic; i < 4 * ic + 4; ++i) { const LAS float* ar = scr + i * 128 + jb * 8; const f32x4 a0 = *(const LAS f32x4*)ar, a1 = *(const LAS f32x4*)(ar + 4);
                    acc[i] = fmaf(a0[0], bv[0], acc[i]); acc[i] = fmaf(a0[1], bv[1], acc[i]); acc[i] = fmaf(a0[2], bv[2], acc[i]); acc[i] = fmaf(a0[3], bv[3], acc[i]);
                    acc[i] = fmaf(a1[0], bv[4], acc[i]); acc[i] = fmaf(a1[1], bv[5], acc[i]); acc[i] = fmaf(a1[2], bv[6], acc[i]); acc[i] = fmaf(a1[3], bv[7], acc[i]); }
                __builtin_amdgcn_sched_barrier(0);
            }
        }
        u32x4* dst = (u32x4*)(WT + (size_t)n * DM + 768 + g * 128 + 64 * kbh + 32 * ih);
#pragma unroll
        for (int c = 0; c < 4; ++c) { u32x4 o; o.x = cvtpk(acc[8 * c], acc[8 * c + 1]); o.y = cvtpk(acc[8 * c + 2], acc[8 * c + 3]); o.z = cvtpk(acc[8 * c + 4], acc[8 * c + 5]); o.w = cvtpk(acc[8 * c + 6], acc[8 * c + 7]); dst[c] = o; }
        LDS_WAIT(); asm volatile("" ::: "memory");
    }
}
constexpr int I_FOLD = 4 * 2 * 32, I_WR = 32 * 3, I_SLOW = I_FOLD + I_WR;
constexpr int I_WIN = 32 * 128, I_WOUT = 24 * 64, I_WGU1 = 32 * 32, I_WDN1 = 8 * 64;
constexpr int I_FAST = I_WIN + I_WOUT + NEXP * I_WGU1 + NEXP * I_WDN1;
struct TrDesc { const float* src; const float* sptr; bf16_t* dst; float smul; int N, K; unsigned coloff; };
constexpr int I_PRO = I_WOUT + I_WIN;
constexpr int I_EXP = NEXP * I_WGU1 + NEXP * I_WDN1;
#define BLK2D(q, NBLK, kq_, nb_) do { const int g_ = (q) >> 3, r8_ = (q) & 7; nb_ = (g_ % ((NBLK) / 2)) * 2 + (r8_ & 1); kq_ = (g_ / ((NBLK) / 2)) * 4 + (r8_ >> 1); } while (0)
__device__ __forceinline__ TrDesc tr_mk(Ctx& C, int l, int r, int lane) {
    const int rr = lane >> 3, cc = lane & 7, nl = lane & 31, kh = lane >> 5;
    TrDesc d; d.sptr = nullptr; d.smul = 1.f;
    int kb, nb, n;
    if (r < I_WOUT) { int kq; BLK2D(r, 64, kq, nb); kb = kq < 12 ? kq : kq + 8; n = 32 * nb + nl;
        d.src = C.in[IN_WOUT] + (size_t)l * DM * DM; d.N = DM; d.K = DM; d.coloff = (unsigned)n * 4u; d.dst = (bf16_t*)(C.ws + WS_WOUT) + (size_t)l * DM * DM;
        if (kb < 12) d.sptr = C.in[IN_BNA] + l * 768 + 64 * kb + 32 * kh; else { d.sptr = C.in[IN_SUBLN] + l * 128 + ((64 * kb - 1280) & 127) + 32 * kh; d.smul = 1.f - lam_init_of(l); } }
    else if ((r -= I_WOUT) < I_WIN) { BLK2D(r, 128, kb, nb); n = 32 * nb + nl; const int pn = n >> 8; int col = n;
        if ((pn <= 3) || (pn >= 7 && pn <= 12)) { const int cw = n & 63; col = (n & ~63) + 32 * ((cw >> 2) & 1) + 4 * (cw >> 3) + (cw & 3); }
        d.src = C.in[IN_WIN] + (size_t)l * DM * INC; d.N = INC; d.K = DM; d.coloff = (unsigned)col * 4u; d.dst = (bf16_t*)(C.ws + WS_WIN) + (size_t)l * INC * DM; }
    else if ((r -= I_WIN) < NEXP * I_WGU1) { const int e = r / I_WGU1, q = r % I_WGU1; BLK2D(q, 32, kb, nb); n = 32 * nb + nl; const size_t eo = ((size_t)l * NEXP + e) * DM * DFF;
        d.src = ((nb & 4) ? C.in[IN_WU] : C.in[IN_WG]) + eo; d.N = DFF; d.K = DM; d.coloff = (unsigned)(128 * (n >> 8) + (n & 127)) * 4u; d.dst = (bf16_t*)(C.ws + WS_WGU) + ((size_t)l * NEXP + e) * 1024 * DM; }
    else { r -= NEXP * I_WGU1; const int e = r / I_WDN1, q = r % I_WDN1; BLK2D(q, 64, kb, nb); n = 32 * nb + nl;
        d.src = C.in[IN_WD] + ((size_t)l * NEXP + e) * DFF * DM; d.N = DM; d.K = DFF; d.coloff = (unsigned)n * 4u; d.dst = (bf16_t*)(C.ws + WS_WDN) + ((size_t)l * NEXP + e) * DM * DFF; }
    d.src += (size_t)(64 * kb + 32 * kh) * d.N;
    d.dst += (size_t)(32 * nb + rr) * d.K + 64 * kb + 8 * cc;
    return d;
}
#undef BLK2D
#define TR_LOAD(v, d) do { const char* rp_ = (const char*)(d).src + (d).coloff; const size_t rs_ = (size_t)(d).N * 4; _Pragma("unroll") for (int j = 0; j < 32; ++j) v[j] = *(const float*)(rp_ + j * rs_); } while (0)
#define TR_STORE(v, d) do { if (!EXPERT) if ((d).sptr) { _Pragma("unroll") for (int j = 0; j < 32; ++j) v[j] *= (d).sptr[j] * (d).smul; }     \
        _Pragma("unroll") for (int c = 0; c < 4; ++c) { u32x4 o; o.x = cvtpk(v[8 * c], v[8 * c + 1]); o.y = cvtpk(v[8 * c + 2], v[8 * c + 3]); o.z = cvtpk(v[8 * c + 4], v[8 * c + 5]); o.w = cvtpk(v[8 * c + 6], v[8 * c + 7]); \
            *(LAS u32x4*)(sc_ + nl * 144 + kh * 64 + c * 16) = o; } \
        LDS_WAIT(); asm volatile("" ::: "memory"); \
        _Pragma("unroll") for (int g = 0; g < 4; ++g) { const u32x4 o = *(const LAS u32x4*)(sc_ + (8 * g + rr) * 144 + cc * 16); *(u32x4*)((d).dst + (size_t)(8 * g) * (d).K) = o; } \
        LDS_WAIT(); asm volatile("" ::: "memory"); } while (0)
template <bool EXPERT> __device__ __forceinline__ void conv_run(Ctx& C, int lfix, int i0, int i1, int stride) {
    const int lane = C.lane, rr = lane >> 3, cc = lane & 7, nl = lane & 31, kh = lane >> 5;
    LAS unsigned char* sc_ = C.lds + C.wave * 16384;
#define TR_MK(i) (EXPERT ? tr_mk(C, lfix, I_PRO + (i), lane) : tr_mk(C, (i) / I_PRO, (i) % I_PRO, lane))
    float vA[32], vB[32]; TrDesc dA, dB;
    int it = i0;
    if (it >= i1) return;
    dA = TR_MK(it); TR_LOAD(vA, dA);
    for (;;) {
        const int itB = it + stride; const bool hB = itB < i1;
        dB = TR_MK(hB ? itB : it); TR_LOAD(vB, dB);
        TR_STORE(vA, dA);
        if (!hB) break;
        it = itB + stride; const bool hA = it < i1;
        dA = TR_MK(hA ? it : itB); TR_LOAD(vA, dA);
        TR_STORE(vB, dB);
        if (!hA) break;
    }
#undef TR_MK
}
#undef TR_LOAD
#undef TR_STORE
__device__ __forceinline__ void phase_prologue(Ctx& C) {
    LAS float* scr = (LAS float*)(C.lds + C.wave * 16384);
    const int gw = C.bid * 8 + C.wave, NGW = C.G * 8, lane = C.lane;
    for (int it = C.bid + C.G * C.wave; it < NLAYER * I_SLOW; it += NGW) {
        const int l = it / I_SLOW, r = it % I_SLOW;
        if (r < I_FOLD) fold_item(C.in[IN_WOUT] + (size_t)l * DM * DM, C.in[IN_WPOOL] + (size_t)l * 4 * 128 * 128, C.in[IN_PSCALE] + l * 512, (bf16_t*)(C.ws + WS_WOUT) + (size_t)l * DM * DM, scr, r / 64, (r / 32) & 1, r % 32, lane);
        else { const int q = r - I_FOLD; FWr f{C.in[IN_WRG] + (size_t)l * DM * 4, C.in[IN_WRE] + (size_t)l * DM * 32}; tr_item(f, DM, (bf16_t*)(C.ws + WS_WR) + (size_t)l * 96 * DM, scr, q / 3, q % 3, lane); }
    }
    conv_run<false>(C, 0, gw, NLAYER * I_PRO, NGW);
    if (C.bid == 0 && C.wave == 0) {
        for (int l = 0; l < NLAYER; ++l) { const int i = C.lane;
            const float s1 = wave_sum(C.in[IN_LQ1][l * 64 + i] * C.in[IN_LK1][l * 64 + i]), s2 = wave_sum(C.in[IN_LQ2][l * 64 + i] * C.in[IN_LK2][l * 64 + i]);
            if (i == 0) ((float*)(C.ws + WS_LAM))[l] = __expf(s1) - __expf(s2) + lam_init_of(l); } }
    float* cosT = (float*)(C.ws + WS_COS); float* sinT = (float*)(C.ws + WS_SIN); const int* pos = (const int*)C.in[IN_POS];
    for (int i = C.bid * 512 + C.tid; i < T * 32; i += C.G * 512) {
        const int tok = i >> 5, fi = i & 31;
        double inv = 1.0; for (int q = 0; q < fi; ++q) inv *= 0.74989420933245582;
        const double rev = (double)pos[tok] * inv * 0.15915494309189535;
        const float fr = (float)(rev - __builtin_floor(rev));
        cosT[i] = __builtin_amdgcn_cosf(fr); sinT[i] = __builtin_amdgcn_sinf(fr);
    }
}

__device__ __forceinline__ void load_starts(Ctx& C, int l) {
    const unsigned* cur = (const unsigned*)(C.ws + WS_CTL) + CW_CUR + l * 32 * 64;
    if (C.tid < NEXP) C.misc[MI_LCNT + C.tid] = (int)__hip_atomic_load(cur + C.tid * 64, __ATOMIC_RELAXED, __HIP_MEMORY_SCOPE_AGENT);
    __syncthreads();
    if (C.tid == 0) { int s = 0, tp = 0;
        for (int e = 0; e < NEXP; ++e) { C.misc[MI_ST + e] = s; C.misc[MI_TP + e] = tp; const int c = C.misc[MI_LCNT + e]; s += c; tp += (c + 255) >> 8; }
        C.misc[MI_ST + NEXP] = s; C.misc[MI_TP + NEXP] = tp; }
    __syncthreads();
}
template <int MODE> __device__ __forceinline__ void phase_norm(Ctx& C, const float* src, float* dsth, const float* g, bf16_t* hn, float* outf) {
    const int gw = C.bid * 8 + C.wave, NGW = C.G * 8, lane = C.lane;
    const bf16_t* YB = (const bf16_t*)(C.ws + WS_PROJ);
    const int* toke = (const int*)(C.ws + WS_TOKE); const int* tokp = (const int*)(C.ws + WS_TOKP);
    int en0 = 0, en1 = 0, pn0 = 0, pn1 = 0;
    if (MODE >= 1 && gw < T) { en0 = toke[2 * gw]; en1 = toke[2 * gw + 1]; pn0 = tokp[2 * gw]; pn1 = tokp[2 * gw + 1]; }
    for (int m = gw; m < T; m += NGW) {
        const f32x4* xr = (const f32x4*)(src + (size_t)m * DM) + lane;
        f32x4 v[8];
#pragma unroll
        for (int j = 0; j < 8; ++j) v[j] = xr[64 * j];
        if (MODE >= 1) {
            const int r0 = C.misc[MI_ST + en0] + pn0, r1 = C.misc[MI_ST + en1] + pn1;
            { const int mn = (m + NGW < T) ? m + NGW : m; en0 = toke[2 * mn]; en1 = toke[2 * mn + 1]; pn0 = tokp[2 * mn]; pn1 = tokp[2 * mn + 1]; }
            const u32x2* y0 = (const u32x2*)(YB + (size_t)r0 * DM) + lane; const u32x2* y1 = (const u32x2*)(YB + (size_t)r1 * DM) + lane;
#pragma unroll
            for (int j = 0; j < 8; ++j) { const u32x2 a = y0[64 * j], b = y1[64 * j];
                v[j][0] += bf2f(a.x & 0xffffu) + bf2f(b.x & 0xffffu); v[j][1] += bf2f(a.x >> 16) + bf2f(b.x >> 16);
                v[j][2] += bf2f(a.y & 0xffffu) + bf2f(b.y & 0xffffu); v[j][3] += bf2f(a.y >> 16) + bf2f(b.y >> 16); }
        }
        if (MODE == 1) { f32x4* hr = (f32x4*)(dsth + (size_t)m * DM) + lane;
#pragma unroll
            for (int j = 0; j < 8; ++j) hr[64 * j] = v[j]; }
        float s = 0.f;
#pragma unroll
        for (int j = 0; j < 8; ++j) s += (v[j][0] * v[j][0] + v[j][1] * v[j][1]) + (v[j][2] * v[j][2] + v[j][3] * v[j][3]);
        const float rs = 1.0f / sqrtf(wave_sum(s) * (1.f / DM) + 1e-6f);
        const f32x4* gr = (const f32x4*)g + lane;
        if (MODE == 2) { f32x4* o = (f32x4*)(outf + (size_t)m * DM) + lane;
#pragma unroll
            for (int j = 0; j < 8; ++j) o[64 * j] = v[j] * rs * gr[64 * j]; }
        else { u32x2* o = (u32x2*)(hn + (size_t)m * DM) + lane;
#pragma unroll
            for (int j = 0; j < 8; ++j) { const f32x4 w = v[j] * rs * gr[64 * j]; u32x2 p; p.x = cvtpk(w[0], w[1]); p.y = cvtpk(w[2], w[3]); o[64 * j] = p; } }
    }
}

__device__ __forceinline__ int crow(int r, int hi) { return (r & 3) + 8 * (r >> 2) + 4 * hi; }
typedef short v4i16_t __attribute__((ext_vector_type(4)));
__device__ __forceinline__ s16x4 vtr(lds_cptr p) { return __builtin_bit_cast(s16x4, __builtin_amdgcn_ds_read_tr16_b64_v4i16((LAS v4i16_t*)p)); }
__device__ __forceinline__ float max3f(float a, float b, float c) { float r; asm("v_max3_f32 %0, %1, %2, %3" : "=v"(r) : "v"(a), "v"(b), "v"(c)); return r; }
__device__ __forceinline__ float swapmax(float v) { auto rr = __builtin_amdgcn_permlane32_swap(__float_as_uint(v), __float_as_uint(v), false, false); return fmaxf(__uint_as_float(rr[0]), __uint_as_float(rr[1])); }
__device__ __forceinline__ float swapsum(float v) { auto rr = __builtin_amdgcn_permlane32_swap(__float_as_uint(v), __float_as_uint(v), false, false); return __uint_as_float(rr[0]) + __uint_as_float(rr[1]); }

template <int NDH, int MASK>
__device__ __forceinline__ void attn_tile(f32x16 (&o)[NDH], float& m, float& l, const bf16x8 (&qr)[4], lds_cptr Kslot, lds_cptr Vslot, LAS float* wsf, int kbase, int qrow, int lane) {
    const int r32 = lane & 31, hi = lane >> 5;
    const lds_cptr kp = Kslot + hi * 1024 + r32 * 16;
    f32x16 p0 = {}, p1 = {};
#pragma unroll
    for (int d0 = 0; d0 < 4; ++d0) {
        const bf16x8 b0 = *(const LAS bf16x8*)(kp + d0 * 2048), b1 = *(const LAS bf16x8*)(kp + d0 * 2048 + 512);
        p0 = __builtin_amdgcn_mfma_f32_32x32x16_bf16(b0, qr[d0], p0, 0, 0, 0);
        p1 = __builtin_amdgcn_mfma_f32_32x32x16_bf16(b1, qr[d0], p1, 0, 0, 0);
    }
    __builtin_amdgcn_sched_barrier(0);
    if (MASK) {
#pragma unroll
        for (int r = 0; r < 16; ++r) {
            const int k0 = kbase + crow(r, hi), k1 = k0 + 32;
            bool v0 = k0 <= qrow, v1 = k1 <= qrow;
            if (MASK == 2) { v0 = v0 && (qrow - k0 < 128); v1 = v1 && (qrow - k1 < 128); }
            p0[r] = v0 ? p0[r] : -__builtin_inff(); p1[r] = v1 ? p1[r] : -__builtin_inff();
        }
    }
    float mx = fmaxf(p0[0], p1[0]);
#pragma unroll
    for (int r = 1; r < 16; ++r) mx = fmaxf(mx, fmaxf(p0[r], p1[r]));
    mx = swapmax(mx);
    const float mn = fmaxf(m, mx);
    const float alpha = __builtin_amdgcn_exp2f(m - mn);
    m = mn;
    float s = 0.f;
#pragma unroll
    for (int r = 0; r < 16; ++r) { p0[r] = __builtin_amdgcn_exp2f(p0[r] - mn); p1[r] = __builtin_amdgcn_exp2f(p1[r] - mn); s += p0[r] + p1[r]; }
    l = l * alpha + s;
    if (__any(alpha != 1.0f)) {
        if (hi == 0) wsf[r32] = alpha;
#pragma unroll
        for (int r = 0; r < 16; ++r) { const float a = wsf[crow(r, hi)];
#pragma unroll
            for (int dh = 0; dh < NDH; ++dh) o[dh][r] *= a; }
    }
    __builtin_amdgcn_sched_barrier(0);
    u32x4 pw[4];
    pw[0] = (u32x4){cvtpk(p0[0], p0[1]), cvtpk(p0[2], p0[3]), cvtpk(p0[4], p0[5]), cvtpk(p0[6], p0[7])};
    pw[1] = (u32x4){cvtpk(p0[8], p0[9]), cvtpk(p0[10], p0[11]), cvtpk(p0[12], p0[13]), cvtpk(p0[14], p0[15])};
    pw[2] = (u32x4){cvtpk(p1[0], p1[1]), cvtpk(p1[2], p1[3]), cvtpk(p1[4], p1[5]), cvtpk(p1[6], p1[7])};
    pw[3] = (u32x4){cvtpk(p1[8], p1[9]), cvtpk(p1[10], p1[11]), cvtpk(p1[12], p1[13]), cvtpk(p1[14], p1[15])};
    __builtin_amdgcn_sched_barrier(0);
    const lds_cptr vp = Vslot + ((lane >> 4) & 1) * 32 + (lane & 3) * 8 + (4 * hi + ((lane & 15) >> 2)) * 64;
#pragma unroll
    for (int dh = 0; dh < NDH; ++dh)
#pragma unroll
        for (int ks = 0; ks < 4; ++ks) {
            const s16x4 lo = vtr(vp + dh * 4096 + ks * 1024), hh = vtr(vp + dh * 4096 + ks * 1024 + 512);
            const bf16x8 vb = (bf16x8){lo[0], lo[1], lo[2], lo[3], hh[0], hh[1], hh[2], hh[3]};
            o[dh] = __builtin_amdgcn_mfma_f32_32x32x16_bf16(__builtin_bit_cast(bf16x8, pw[ks]), vb, o[dh], 0, 0, 0);
            if (ks == 3) __builtin_amdgcn_sched_barrier(0);
        }
}

#define DBAR() asm volatile("s_waitcnt lgkmcnt(0)\n\ts_barrier" ::: "memory")
#define VMWAIT0() asm volatile("s_waitcnt vmcnt(0)" ::: "memory")
__device__ __forceinline__ void glds16(const void* gsrc, unsigned lds_dst) { unsigned keep;
    asm volatile("s_mov_b32 %0, m0\n\ts_mov_b32 m0, %2\n\ts_nop 0\n\tglobal_load_lds_dwordx4 %1, off\n\ts_mov_b32 m0, %0" : "=&s"(keep) : "v"(gsrc), "s"(lds_dst) : "memory"); }
template <int ABL = 0> __device__ __forceinline__ void diff_unit(Ctx& C, int b, int h, int qb, float lam) {
    const int lane = C.lane, wid = C.wave, r32 = lane & 31, hi = lane >> 5, c = wid >> 2, wq = wid & 3;
    const int q0w = qb * 128 + wq * 32, qrow = q0w + r32;
    const char* Pb = (const char*)(C.ws + WS_PROJ) + (size_t)b * SEQ * INC * 2;
    bf16x8 qr[4];
    { const unsigned qo = (unsigned)(((q0w + r32) * INC + C_QC + (2 * h + c) * 64 + hi * 8) * 2);
#pragma unroll
      for (int d0 = 0; d0 < 4; ++d0) qr[d0] = *(const bf16x8*)(Pb + (qo + d0 * 32)); }
    const int NT = 2 * (qb + 1);
    LAS unsigned char* L = C.lds; LAS float* wsf = (LAS float*)(L + LDS_WSF + wid * 256);
    const unsigned kofs = (unsigned)((lane * INC + C_KC + (2 * h) * 64 + wid * 8) * 2);
    const unsigned vofs0 = (unsigned)(((16 * (wid & 3) + (lane >> 2)) * INC + C_VC + h * 128 + (wid >> 2) * 32 + (lane & 3) * 8) * 2);
    const unsigned vofs1 = vofs0 + 64 * 2;
    const int kfo = c * 8192 + hi * 1024 + r32 * 16;
    const int vfo = 16384 + ((lane >> 4) & 1) * 32 + (lane & 3) * 8 + (4 * hi + ((lane & 15) >> 2)) * 64;
    const unsigned ldsw = (unsigned)(uintptr_t)(unsigned char*)L + (unsigned)wid * 1024u;
#define DIFF_DMA(t, bo) do { const char* Pt_ = Pb + (size_t)(t) * (64 * INC * 2); const unsigned d_ = (unsigned)__builtin_amdgcn_readfirstlane(ldsw + (bo)); \
        glds16(Pt_ + kofs, d_); glds16(Pt_ + (kofs + 128), d_ + 8192u); glds16(Pt_ + vofs0, d_ + 16384u); glds16(Pt_ + vofs1, d_ + 24576u); } while (0)
#define DIFF_KF(bo) do { _Pragma("unroll") for (int d0 = 0; d0 < 4; ++d0) { kf[2 * d0] = *(const LAS bf16x8*)(L + (bo) + kfo + d0 * 2048); kf[2 * d0 + 1] = *(const LAS bf16x8*)(L + (bo) + kfo + d0 * 2048 + 512); } } while (0)
#define DIFF_VF(lo_, hi_, bo, dh) do { if ((ABL & 32) && t > 0) break; _Pragma("unroll") for (int ks = 0; ks < 4; ++ks) { lo_[ks] = vtr((lds_cptr)(L + (bo) + vfo + (dh) * 4096 + ks * 1024)); hi_[ks] = vtr((lds_cptr)(L + (bo) + vfo + (dh) * 4096 + ks * 1024 + 512)); } } while (0)
#define DIFF_PV(dh, lo_, hi_) do { _Pragma("unroll") for (int ks = 0; ks < 4; ++ks) { if (ABL & 8) { o[dh][ks] += __builtin_bit_cast(float, (int)lo_[ks][0] | ((int)hi_[ks][1] << 16)) + __builtin_bit_cast(float, pw[ks].x); continue; }  const bf16x8 vb_ = (bf16x8){lo_[ks][0], lo_[ks][1], lo_[ks][2], lo_[ks][3], hi_[ks][0], hi_[ks][1], hi_[ks][2], hi_[ks][3]}; \
        o[dh] = __builtin_amdgcn_mfma_f32_32x32x16_bf16(__builtin_bit_cast(bf16x8, pw[ks]), vb_, o[dh], 0, 0, 0); } } while (0)
    DIFF_DMA(0, 0); DIFF_DMA(1, 32768); if (NT > 2) DIFF_DMA(2, 65536); VMWAIT0();
    DBAR();
    bf16x8 kf[8]; DIFF_KF(0);
    f32x16 o[4]; o[0] = f32x16{}; o[1] = f32x16{}; o[2] = f32x16{}; o[3] = f32x16{};
    float m = 0.f, lsum = 0.f;
    u32x4 pw[4]; s16x4 va_lo[4], va_hi[4], vb_lo[4], vb_hi[4];
    f32x16 negm = f32x16{};
    pw[0] = pw[1] = pw[2] = pw[3] = (u32x4){0u, 0u, 0u, 0u};
    if (c == 1) DBAR();
    int s0 = 0, s1 = 32768, s2 = 65536, s3 = 98304;
#if PROBE >= 201 && PROBE <= 219
    unsigned long long tacc_ = 0, tcnt_ = 0, ts0_, ts1_, ts2_, ts3_, ts4_, tsa_ = 0, tsb_ = 0, tsc_ = 0;
#define STAMP(v) do { v = __builtin_amdgcn_s_memtime(); asm volatile("s_waitcnt lgkmcnt(0)" ::: "memory"); } while (0)
#else
#define STAMP(v) do {} while (0)
#endif
#pragma unroll 1
    for (int t = 0; t < NT; ++t) {
        STAMP(ts0_);
        const int kbase = 64 * t; const bool act = kbase <= q0w + 31;
        if (act) {
            f32x16 p0, p1;
            __builtin_amdgcn_s_setprio(2);
#pragma unroll
            for (int d0 = 0; d0 < 4; ++d0) { if (ABL & 2) { p0[d0] += __builtin_bit_cast(float, (int)kf[2 * d0][0]); p1[d0] += __builtin_bit_cast(float, (int)kf[2 * d0 + 1][1]); }
                else { p0 = __builtin_amdgcn_mfma_f32_32x32x16_bf16(kf[2 * d0], qr[d0], d0 == 0 ? negm : p0, 0, 0, 0); p1 = __builtin_amdgcn_mfma_f32_32x32x16_bf16(kf[2 * d0 + 1], qr[d0], d0 == 0 ? negm : p1, 0, 0, 0); } }
            __builtin_amdgcn_s_setprio(1);
            DIFF_VF(va_lo, va_hi, s0, 0); DIFF_VF(vb_lo, vb_hi, s0, 1);
            asm volatile("s_nop 15\n\ts_nop 7" : "+v"(p0), "+v"(p1));
            if (kbase + 63 > q0w) {
                const int dq = qrow - kbase - 4 * hi;
#pragma unroll
                for (int r = 0; r < 16; ++r) { const int cr = (r & 3) + 8 * (r >> 2); p0[r] = (cr <= dq) ? p0[r] : -__builtin_inff(); p1[r] = (cr + 32 <= dq) ? p1[r] : -__builtin_inff(); }
            }
            if (!(ABL & 4)) {
            float mxa = max3f(p0[0], p0[1], p0[2]), mxb = max3f(p0[3], p0[4], p0[5]), mxc = max3f(p1[0], p1[1], p1[2]), mxd = max3f(p1[3], p1[4], p1[5]);
            mxa = max3f(mxa, p0[6], p0[7]); mxb = max3f(mxb, p0[8], p0[9]); mxc = max3f(mxc, p1[6], p1[7]); mxd = max3f(mxd, p1[8], p1[9]);
            mxa = max3f(mxa, p0[10], p0[11]); mxb = max3f(mxb, p0[12], p0[13]); mxc = max3f(mxc, p1[10], p1[11]); mxd = max3f(mxd, p1[12], p1[13]);
            mxa = max3f(mxa, p0[14], p0[15]); mxc = max3f(mxc, p1[14], p1[15]);
            float mx = max3f(mxa, mxb, fmaxf(mxc, mxd));
            mx = swapmax(mx);
            const bool any_grow = __any(mx > 8.0f) || (t == 0);
            if (any_grow) {
                const float dl = (t == 0) ? mx : fmaxf(mx, 0.f);
                m += dl;
#pragma unroll
                for (int r = 0; r < 16; ++r) { p0[r] -= dl; p1[r] -= dl; negm[r] = -m; }
                const float alpha = __builtin_amdgcn_exp2f(-dl);
                lsum *= alpha;
                if (hi == 0) wsf[r32] = alpha;
#pragma unroll
                for (int r = 0; r < 16; ++r) { const float a = wsf[crow(r, hi)];
#pragma unroll
                    for (int dh = 0; dh < 4; ++dh) o[dh][r] *= a; }
            }
            float sa = 0.f, sb = 0.f, sc = 0.f, sd = 0.f;
#pragma unroll
            for (int r = 0; r < 16; r += 2) { p0[r] = __builtin_amdgcn_exp2f(p0[r]); p0[r + 1] = __builtin_amdgcn_exp2f(p0[r + 1]); p1[r] = __builtin_amdgcn_exp2f(p1[r]); p1[r + 1] = __builtin_amdgcn_exp2f(p1[r + 1]);
                sa += p0[r]; sb += p0[r + 1]; sc += p1[r]; sd += p1[r + 1]; }
            lsum += (sa + sb) + (sc + sd);
            }
            pw[0] = (u32x4){cvtpk(p0[0], p0[1]), cvtpk(p0[2], p0[3]), cvtpk(p0[4], p0[5]), cvtpk(p0[6], p0[7])};
            pw[1] = (u32x4){cvtpk(p0[8], p0[9]), cvtpk(p0[10], p0[11]), cvtpk(p0[12], p0[13]), cvtpk(p0[14], p0[15])};
            pw[2] = (u32x4){cvtpk(p1[0], p1[1]), cvtpk(p1[2], p1[3]), cvtpk(p1[4], p1[5]), cvtpk(p1[6], p1[7])};
            pw[3] = (u32x4){cvtpk(p1[8], p1[9]), cvtpk(p1[10], p1[11]), cvtpk(p1[12], p1[13]), cvtpk(p1[14], p1[15])};
        }
        __builtin_amdgcn_s_setprio(0);
        STAMP(ts1_);
        if (c == 0) { if (t + 2 < NT) asm volatile("s_waitcnt vmcnt(4)" ::: "memory"); else VMWAIT0(); }
        DBAR();
        STAMP(ts2_);
        if (!(ABL & 1)) if (t + 3 < NT) DIFF_DMA(t + 3, s3);
        if (act) {
            DIFF_PV(0, va_lo, va_hi);
            DIFF_VF(va_lo, va_hi, s0, 2);
            DIFF_PV(1, vb_lo, vb_hi);
            DIFF_VF(vb_lo, vb_hi, s0, 3);
            DIFF_PV(2, va_lo, va_hi);
            DIFF_PV(3, vb_lo, vb_hi);
        }
        if (!(ABL & 16) || t == 0) if (t + 1 < NT && kbase + 64 <= q0w + 31) DIFF_KF(s1);
        STAMP(ts3_);
        if (c == 1) { if (t + 3 < NT) asm volatile("s_waitcnt vmcnt(4)" ::: "memory"); else VMWAIT0(); }
        DBAR();
        { const int tmp = s0; s0 = s1; s1 = s2; s2 = s3; s3 = tmp; }
#if PROBE >= 201 && PROBE <= 219
        STAMP(ts4_);
        if (t + 4 < NT) { tcnt_ += 1;
            tacc_ += (PROBE == 201) ? (ts1_ - ts0_) : (PROBE == 202) ? (ts2_ - ts1_) : (PROBE == 203) ? (ts3_ - ts2_) : (PROBE == 204) ? (ts4_ - ts3_) : (ts4_ - ts0_); }
#endif
    }
#if PROBE >= 201 && PROBE <= 219
    if (wid == 0 && lane == 0 && qb == 63 && b == 0 && h == 0 && tcnt_ > 0) *(float*)(C.ws + WS_SGATE + 140 * 1024) = (float)tacc_ / (float)tcnt_;
#endif
    if (c == 0) DBAR();
#undef DIFF_DMA
#undef DIFF_KF
#undef DIFF_VF
#undef DIFF_PV
    lsum = swapsum(lsum);
    if (hi == 0) wsf[r32] = lsum;
    LAS float* X = (LAS float*)L + wq * 4096 + lane;
    if (c == 1) {
#pragma unroll
        for (int r = 0; r < 16; ++r) { const float rl = 1.0f / wsf[crow(r, hi)];
#pragma unroll
            for (int dh = 0; dh < 4; ++dh) X[(dh * 16 + r) * 64] = o[dh][r] * rl; }
    }
    __syncthreads();
    if (c == 0) {
        char* Cb = (char*)(C.ws + (ABL ? WS_XSS : WS_CAT)) + (size_t)b * SEQ * DM * 2;
        const unsigned co = (unsigned)(((q0w + 4 * hi) * DM + 1280 + h * 128 + r32) * 2);
#pragma unroll
        for (int r = 0; r < 16; ++r) {
            const float rl = 1.0f / wsf[crow(r, hi)];
            float s = 0.f;
#pragma unroll
            for (int dh = 0; dh < 4; ++dh) { const float d = o[dh][r] * rl - lam * X[(dh * 16 + r) * 64]; o[dh][r] = d; s += d * d; }
#pragma unroll
            for (int off = 1; off < 32; off <<= 1) s += __shfl_xor(s, off);
            const float rn = 1.0f / sqrtf(s * (1.f / 128.f) + 1e-5f);
            const unsigned ro = co + (unsigned)(((r & 3) + 8 * (r >> 2)) * DM * 2);
#pragma unroll
            for (int dh = 0; dh < 4; ++dh) *(bf16_t*)(Cb + (ro + dh * 64)) = (bf16_t)f2bf(o[dh][r] * rn);
        }
    }
    __syncthreads();
}

__device__ __forceinline__ void swa_task(Ctx& C, int l, int b, int q0, int head, f32x16 (&o)[2], float (&ssq)[16]) {
    const int lane = C.lane, wid = C.wave, r32 = lane & 31, hi = lane >> 5;
    const char* Pb = (const char*)(C.ws + WS_PROJ) + (size_t)b * SEQ * INC * 2;
    LAS unsigned char* Lw = C.lds + wid * 16384; LAS float* wsf = (LAS float*)(C.lds + LDS_WSF + wid * 256);
    const int kvh = head / 3;
    bf16x8 qr[4];
    { const unsigned qo = (unsigned)(((q0 + r32) * INC + C_QA + head * 64 + hi * 8) * 2);
#pragma unroll
      for (int d0 = 0; d0 < 4; ++d0) qr[d0] = *(const bf16x8*)(Pb + (qo + d0 * 32)); }
    o[0] = f32x16{}; o[1] = f32x16{};
    float m = C.in[IN_SINKS][l * 12 + head] * LOG2E, lsum = (hi == 0) ? 1.f : 0.f;
    const int tlo = (q0 >= 127 ? q0 - 127 : 0) >> 6, thi = (q0 + 31) >> 6;
    const unsigned kofs = (unsigned)((lane * INC + C_KA + kvh * 64) * 2);
    const unsigned vofs = (unsigned)(((lane >> 2) * INC + C_VA + kvh * 64 + (lane & 3) * 8) * 2);
    const unsigned ldsw = (unsigned)(uintptr_t)(unsigned char*)Lw;
    for (int t = tlo; t <= thi; ++t) {
        const char* Pt = Pb + (size_t)t * (64 * INC * 2);
        asm volatile("s_waitcnt lgkmcnt(0)" ::: "memory");
#pragma unroll
        for (int c8 = 0; c8 < 8; ++c8) glds16(Pt + (kofs + c8 * 16), (unsigned)__builtin_amdgcn_readfirstlane(ldsw + c8 * 1024));
#pragma unroll
        for (int i = 0; i < 8; ++i) glds16(Pt + (vofs + (16 * (i & 3) * INC + (i >> 2) * 32) * 2), (unsigned)__builtin_amdgcn_readfirstlane(ldsw + 8192 + i * 1024));
        VMWAIT0();
        attn_tile<2, 2>(o, m, lsum, qr, (lds_cptr)Lw, (lds_cptr)(Lw + 8192), wsf, 64 * t, q0 + r32, lane);
    }
    lsum = swapsum(lsum);
    if (hi == 0) wsf[r32] = lsum;
#pragma unroll
    for (int r = 0; r < 16; ++r) { const float rl = 1.0f / wsf[crow(r, hi)]; o[0][r] *= rl; o[1][r] *= rl; float s = o[0][r] * o[0][r] + o[1][r] * o[1][r];
#pragma unroll
        for (int off = 1; off < 32; off <<= 1) s += __shfl_xor(s, off);
        ssq[r] = s; }
}
__device__ __forceinline__ void swa_store(Ctx& C, int b, int q0, int head, const f32x16 (&o)[2]) {
    const int lane = C.lane, r32 = lane & 31, hi = lane >> 5;
    char* Cb = (char*)(C.ws + WS_CAT) + (size_t)b * SEQ * DM * 2; const LAS float* tot = (const LAS float*)(C.misc + MI_SSQ) + 12 * 32;
    const unsigned co = (unsigned)(((q0 + 4 * hi) * DM + head * 64 + r32) * 2);
#pragma unroll
    for (int r = 0; r < 16; ++r) { const int qq = (r & 3) + 8 * (r >> 2); const float rn = tot[qq + 4 * hi];
        const unsigned ro = co + (unsigned)(qq * DM * 2);
        *(bf16_t*)(Cb + ro) = (bf16_t)f2bf(o[0][r] * rn); *(bf16_t*)(Cb + (ro + 64)) = (bf16_t)f2bf(o[1][r] * rn); }
}
__device__ __forceinline__ void swa_unit(Ctx& C, int l, int b, int jb) {
    const int lane = C.lane, wid = C.wave, r32 = lane & 31, hi = lane >> 5;
    const int q0 = jb * 32;
    LAS float* ssqL = (LAS float*)(C.misc + MI_SSQ);
    f32x16 oa[2], ob[2]; float sa[16], sb[16];
    swa_task(C, l, b, q0, wid, oa, sa);
    if (r32 == 0) {
#pragma unroll
        for (int r = 0; r < 16; ++r) ssqL[wid * 32 + crow(r, hi)] = sa[r]; }
    if (wid < 4) {
        swa_task(C, l, b, q0, 8 + wid, ob, sb);
        if (r32 == 0) {
#pragma unroll
            for (int r = 0; r < 16; ++r) ssqL[(8 + wid) * 32 + crow(r, hi)] = sb[r]; }
    }
    __syncthreads();
    if (C.tid < 32) { float s = 0.f;
#pragma unroll
        for (int hh = 0; hh < 12; ++hh) s += ssqL[hh * 32 + C.tid];
        ssqL[12 * 32 + C.tid] = 1.0f / sqrtf(s * (1.f / 768.f) + 1e-6f); }
    __syncthreads();
    swa_store(C, b, q0, wid, oa);
    if (wid < 4) swa_store(C, b, q0, 8 + wid, ob);
    __syncthreads();
}

__device__ __forceinline__ void pool_unit(Ctx& C, int b, int blk) {
    const int tid = C.tid, s0 = blk * 32;
    const char* Pb = (const char*)(C.ws + WS_PROJ) + (size_t)b * SEQ * INC * 2 + C_UB * 2;
    LAS unsigned char* L = C.lds;
    const int r0 = s0 >= 15 ? s0 - 15 : 0, nrows = s0 + 32 - r0;
    for (int i = tid; i < nrows * 64; i += 512) { const int rr = i >> 6, ch = i & 63;
        *(LAS u32x4*)(L + rr * 1040 + ch * 16) = *(const u32x4*)(Pb + (size_t)(r0 + rr) * (INC * 2) + ch * 16); }
    __syncthreads();
    const int cg8 = tid & 63, ts = tid >> 6, w = 2 << (cg8 >> 4);
    char* Cb = (char*)(C.ws + WS_CAT) + (size_t)b * SEQ * DM * 2 + (768 + 8 * cg8) * 2;
#pragma unroll 1
    for (int i = 0; i < 4; ++i) {
        const int s = s0 + ts * 4 + i, lo = (s - w + 1) > 0 ? (s - w + 1) : 0;
        float acc[8];
#pragma unroll
        for (int j = 0; j < 8; ++j) acc[j] = 0.f;
        u32x4 self = {0, 0, 0, 0};
        for (int sp = lo; sp <= s; ++sp) { const u32x4 v = *(const LAS u32x4*)(L + (sp - r0) * 1040 + cg8 * 16); self = v;
            acc[0] += bf2f(v.x & 0xffffu); acc[1] += bf2f(v.x >> 16); acc[2] += bf2f(v.y & 0xffffu); acc[3] += bf2f(v.y >> 16);
            acc[4] += bf2f(v.z & 0xffffu); acc[5] += bf2f(v.z >> 16); acc[6] += bf2f(v.w & 0xffffu); acc[7] += bf2f(v.w >> 16); }
        const float rc = 1.0f / (float)(s - lo + 1);
        u32x4 ov;
        ov.x = pk2(acc[0] * rc - bf2f(self.x & 0xffffu), acc[1] * rc - bf2f(self.x >> 16)); ov.y = pk2(acc[2] * rc - bf2f(self.y & 0xffffu), acc[3] * rc - bf2f(self.y >> 16));
        ov.z = pk2(acc[4] * rc - bf2f(self.z & 0xffffu), acc[5] * rc - bf2f(self.z >> 16)); ov.w = pk2(acc[6] * rc - bf2f(self.w & 0xffffu), acc[7] * rc - bf2f(self.w >> 16));
        *(u32x4*)(Cb + (size_t)s * (DM * 2)) = ov;
    }
    __syncthreads();
}

#ifndef MIXSELDEF
#define MIXSELDEF 15
#endif
#ifndef MIXSEL
#define MIXSEL 7
#endif
constexpr int NU_DIFF = 2 * 6 * 64, NU_SWA = 2 * 256, NU_POOL = 2 * 256, NU_CONV = 512, CONV_PER = I_EXP / NU_CONV;
constexpr int NU_MIX = NU_DIFF + NU_CONV + NU_SWA + NU_POOL;
static_assert(I_EXP % NU_CONV == 0 && NU_DIFF * 2 == NU_CONV * 3, "queue interleave: 3 attention units : 2 conversion units");
__device__ __forceinline__ void conv_unit(Ctx& C, int l, int j) {
    conv_run<true>(C, l, j * CONV_PER + C.wave, (j + 1) * CONV_PER, 8);
    asm volatile("s_waitcnt vmcnt(0) lgkmcnt(0)" ::: "memory");
    __syncthreads();
}
template <int ABL = 0> __device__ __forceinline__ void phase_mixers(Ctx& C, int l, int qslot = -1, int sel = MIXSELDEF) {
    const float lam = ((const float*)(C.ws + WS_LAM))[l];
    unsigned* qctr = (unsigned*)(C.ws + WS_CTL) + CW_QCTR + 64 * (qslot < 0 ? l : qslot);
    int unext = 0;
    if (C.tid == 0) unext = (int)__hip_atomic_fetch_add(qctr, 1u, __ATOMIC_RELAXED, __HIP_MEMORY_SCOPE_AGENT);
    for (;;) {
        if (C.tid == 0) { C.misc[0] = unext; unext = (int)__hip_atomic_fetch_add(qctr, 1u, __ATOMIC_RELAXED, __HIP_MEMORY_SCOPE_AGENT); }
        __syncthreads();
        const int u = C.misc[0];
        __syncthreads();
        if (u >= NU_MIX) break;
        { int l_ = C.lane; asm volatile("" : "+v"(l_)); C.lane = l_; C.tid = C.wave * 64 + l_; }
        if (u < NU_DIFF + NU_CONV) { const int grp = u / 5, k5 = u % 5;
            if (k5 < 3) { if (sel & 1) { const int ud = grp * 3 + k5, qb = 63 - ud / 12, bh = ud % 12; diff_unit<ABL>(C, bh / 6, bh % 6, qb, lam); } }
            else { if (sel & 8) conv_unit(C, l, grp * 2 + (k5 - 3)); } }
        else if (u < NU_DIFF + NU_CONV + NU_SWA) { if (sel & 2) { const int v = u - NU_DIFF - NU_CONV; swa_unit(C, l, v >> 8, v & 255); } }
        else { if (sel & 4) { const int v = u - NU_DIFF - NU_CONV - NU_SWA; pool_unit(C, v >> 8, v & 255); } }
    }
}

constexpr int XT_PITCH = 4112;
__device__ __forceinline__ void phase_router(Ctx& C, int l) {
    const int lane = C.lane, wid = C.wave, tid = C.tid;
    const float* h = C.out; const float* g = C.in[IN_FNORM] + l * DM;
    bf16_t* XS = (bf16_t*)(C.ws + WS_HN); const bf16_t* WR = (const bf16_t*)(C.ws + WS_WR) + (size_t)l * 96 * DM;
    unsigned* cur = (unsigned*)(C.ws + WS_CTL) + CW_CUR + l * 32 * 64;
    int* toke = (int*)(C.ws + WS_TOKE); float* tokg = (float*)(C.ws + WS_TOKG); int* tokp = (int*)(C.ws + WS_TOKP);
    int* rowtok = (int*)(C.ws + WS_ROWTOK); float* rowgate = (float*)(C.ws + WS_ROWGATE);
    LAS unsigned char* L = C.lds;
    for (int unit = C.bid; unit < T / 32; unit += C.G) {
        const int tok0 = unit * 32;
        {
            f32x4 v[4][8];
#pragma unroll
            for (int rr = 0; rr < 4; ++rr) { const f32x4* xr = (const f32x4*)(h + ((size_t)tok0 + wid * 4 + rr) * DM) + lane;
#pragma unroll
                for (int j = 0; j < 8; ++j) v[rr][j] = xr[64 * j]; }
            const f32x4* gr = (const f32x4*)g + lane;
#pragma unroll
            for (int rr = 0; rr < 4; ++rr) {
                const int row = wid * 4 + rr; const size_t m = (size_t)tok0 + row; float s = 0.f;
#pragma unroll
                for (int j = 0; j < 8; ++j) s += (v[rr][j][0] * v[rr][j][0] + v[rr][j][1] * v[rr][j][1]) + (v[rr][j][2] * v[rr][j][2] + v[rr][j][3] * v[rr][j][3]);
                const float rs = 1.0f / sqrtf(wave_sum(s) * (1.f / DM) + 1e-6f);
                u32x2* o = (u32x2*)(XS + m * DM) + lane;
#pragma unroll
                for (int j = 0; j < 8; ++j) { const f32x4 w = v[rr][j] * rs * gr[64 * j]; u32x2 p; p.x = cvtpk(w[0], w[1]); p.y = cvtpk(w[2], w[3]); o[64 * j] = p;
                    *(LAS u32x2*)(L + row * XT_PITCH + (4 * lane + 256 * j) * 2) = p; }
            }
        }
        if (tid < 32) C.misc[MI_LCNT + tid] = 0;
        __syncthreads();
        f32x4 acc[2][3];
#pragma unroll
        for (int rt = 0; rt < 2; ++rt)
#pragma unroll
            for (int ct = 0; ct < 3; ++ct) acc[rt][ct] = (f32x4){0.f, 0.f, 0.f, 0.f};
#pragma unroll 4
        for (int ks = 0; ks < 8; ++ks) {
            const int kk = 256 * wid + 32 * ks + 8 * (lane >> 4);
            bf16x8 a[2];
#pragma unroll
            for (int rt = 0; rt < 2; ++rt) a[rt] = *(const LAS bf16x8*)(L + (16 * rt + (lane & 15)) * XT_PITCH + kk * 2);
#pragma unroll
            for (int ct = 0; ct < 3; ++ct)
#pragma unroll
                for (int hl = 0; hl < 2; ++hl) {
                    const bf16x8 bb = *(const bf16x8*)(WR + (size_t)(hl * 48 + 16 * ct + (lane & 15)) * DM + kk);
#pragma unroll
                    for (int rt = 0; rt < 2; ++rt) acc[rt][ct] = __builtin_amdgcn_mfma_f32_16x16x32_bf16(a[rt], bb, acc[rt][ct], 0, 0, 0);
                }
        }
        __syncthreads();
        LAS float* RED = (LAS float*)L;
#pragma unroll
        for (int rt = 0; rt < 2; ++rt)
#pragma unroll
            for (int ct = 0; ct < 3; ++ct)
#pragma unroll
                for (int q = 0; q < 4; ++q) RED[(wid * 32 + 16 * rt + 4 * (lane >> 4) + q) * 48 + 16 * ct + (lane & 15)] = acc[rt][ct][q];
        __syncthreads();
        LAS float* LG = RED + 8 * 32 * 48;
        for (int i = tid; i < 32 * 48; i += 512) { float sacc = 0.f;
#pragma unroll
            for (int w8 = 0; w8 < 8; ++w8) sacc += RED[w8 * 32 * 48 + i];
            LG[i] = sacc; }
        __syncthreads();
        int e0 = 0, e1 = 0, rk0 = 0, rk1 = 0; float g0 = 0.f, g1 = 0.f;
        if (tid < 32) {
            const LAS float* lg = LG + tid * 48;
            const float* brg = C.in[IN_BRG] + l * 4; const float* bre = C.in[IN_BRE] + l * 32;
            float gl[4]; int gsel = 0; float gm = -__builtin_inff();
#pragma unroll
            for (int j = 0; j < 4; ++j) { gl[j] = lg[j] + brg[j]; if (gl[j] > gm) { gm = gl[j]; gsel = j; } }
            float gs = 0.f;
#pragma unroll
            for (int j = 0; j < 4; ++j) gs += __expf(gl[j] - gm);
            const float pgsel = 1.0f / gs;
            float le[8];
#pragma unroll
            for (int j = 0; j < 8; ++j) le[j] = lg[4 + gsel * 8 + j] + bre[gsel * 8 + j];
            int i0 = 0; float m0 = le[0];
#pragma unroll
            for (int j = 1; j < 8; ++j) if (le[j] > m0) { m0 = le[j]; i0 = j; }
            int i1 = -1; float m1 = -__builtin_inff();
#pragma unroll
            for (int j = 0; j < 8; ++j) if (j != i0 && le[j] > m1) { m1 = le[j]; i1 = j; }
            const float p1 = __expf(m1 - m0), den = 1.0f / (1.0f + p1);
            g0 = pgsel * den; g1 = pgsel * p1 * den;
            e0 = gsel * 8 + i0; e1 = gsel * 8 + i1;
            rk0 = __hip_atomic_fetch_add((LAS int*)(C.misc + MI_LCNT) + e0, 1, __ATOMIC_RELAXED, __HIP_MEMORY_SCOPE_WORKGROUP);
            rk1 = __hip_atomic_fetch_add((LAS int*)(C.misc + MI_LCNT) + e1, 1, __ATOMIC_RELAXED, __HIP_MEMORY_SCOPE_WORKGROUP);
        }
        __syncthreads();
        if (tid < 32) { const int c = C.misc[MI_LCNT + tid]; C.misc[MI_LBASE + tid] = c ? (int)__hip_atomic_fetch_add(cur + tid * 64, (unsigned)c, __ATOMIC_RELAXED, __HIP_MEMORY_SCOPE_AGENT) : 0; }
        __syncthreads();
        if (tid < 32) {
            const int t = tok0 + tid; const int p0 = C.misc[MI_LBASE + e0] + rk0, p1 = C.misc[MI_LBASE + e1] + rk1;
            toke[2 * t] = e0; toke[2 * t + 1] = e1; tokg[2 * t] = g0; tokg[2 * t + 1] = g1; tokp[2 * t] = p0; tokp[2 * t + 1] = p1;
            rowtok[e0 * T + p0] = t; rowtok[e1 * T + p1] = t; rowgate[e0 * T + p0] = g0; rowgate[e1 * T + p1] = g1;
        }
        __syncthreads();
    }
}

__device__ __forceinline__ void phase_gather(Ctx& C, int l) {
    load_starts(C, l);
    const int gw = C.bid * 8 + C.wave, NGW = C.G * 8, lane = C.lane;
    const bf16_t* XS = (const bf16_t*)(C.ws + WS_HN); bf16_t* XSS = (bf16_t*)(C.ws + WS_XSS);
    const int* rowtok = (const int*)(C.ws + WS_ROWTOK); const float* rowgate = (const float*)(C.ws + WS_ROWGATE); float* sgate = (float*)(C.ws + WS_SGATE);
    for (int ci = gw; ci < NASSIGN; ci += NGW) {
        int e = 0;
        while (e < 31 && C.misc[MI_ST + e + 1] <= ci) ++e;
        const int pos = ci - C.misc[MI_ST + e]; const int tok = rowtok[e * T + pos];
        const u32x4* s = (const u32x4*)(XS + (size_t)tok * DM) + lane; u32x4* d = (u32x4*)(XSS + (size_t)ci * DM) + lane;
        const u32x4 a0 = s[0], a1 = s[64], a2 = s[128], a3 = s[192];
        d[0] = a0; d[64] = a1; d[128] = a2; d[192] = a3;
        if (lane == 0) sgate[ci] = rowgate[e * T + pos];
    }
}

#define XB_TMO      128
#define XB_XCNT(j)  (256  + 64 * (j))
#define XB_XSUB(j)  (1280 + 64 * (j))
#define XB_XGEN(j)  (2304 + 64 * (j))
#define XB_TOP      3328
#define XB_TOPGEN   3392
#define XCD_BAR_WORDS 3456
#define XB_SPIN_CAP (1u << 18)

__device__ __forceinline__ unsigned xb_ld(unsigned* p)              { return __hip_atomic_load(p, __ATOMIC_RELAXED, __HIP_MEMORY_SCOPE_AGENT); }
__device__ __forceinline__ unsigned xb_add(unsigned* p, unsigned v) { return __hip_atomic_fetch_add(p, v, __ATOMIC_RELAXED, __HIP_MEMORY_SCOPE_AGENT); }
__device__ __forceinline__ unsigned xb_xcc_id() { return (unsigned)__builtin_amdgcn_s_getreg((3 << 11) | 20) & 0xFu; }
#define XB_SPIN(cond, bar) do { unsigned _sp = 0; while (cond) { __builtin_amdgcn_s_sleep(1); \
    if ((++_sp & 255u) == 0u) { if (xb_ld(&(bar)[XB_TMO])) break; if (_sp > XB_SPIN_CAP) { atomicAdd(&(bar)[XB_TMO], 1u); break; } } } } while (0)

__device__ __forceinline__ int lane_id_v() { int l; asm volatile("v_mbcnt_lo_u32_b32 %0, -1, 0\n\tv_mbcnt_hi_u32_b32 %0, -1, %0" : "=v"(l)); return l; }
struct XcdBarrier {
    int wv;
    unsigned* bar; unsigned x;
    volatile LAS unsigned* st;
};

__device__ __forceinline__ XcdBarrier xcd_barrier_post(unsigned* bar, volatile LAS unsigned* st) {
    XcdBarrier b; b.bar = bar; b.x = xb_xcc_id(); b.st = st;
    if (threadIdx.x == 0) (void)xb_add(&bar[XB_XCNT(b.x)], 1u);
    return b;
}
__device__ __forceinline__ void xcd_barrier_complete(unsigned* bar, unsigned x, unsigned& nloc, unsigned& nx) {
    const unsigned G = gridDim.x * gridDim.y * gridDim.z;
    unsigned sum, cnt, mine, sp = 0u;
    for (;;) {
        sum = 0u; cnt = 0u; mine = 0u;
#pragma unroll 1
        for (unsigned j = 0; j < 16; ++j) { const unsigned c = xb_ld(&bar[XB_XCNT(j)]); sum += c; cnt += (c > 0u) ? 1u : 0u; mine = (j == x) ? c : mine; }
        if (sum == G) break;
        __builtin_amdgcn_s_sleep(1);
        if ((++sp & 255u) == 0u) { if (xb_ld(&bar[XB_TMO])) break; if (sp > XB_SPIN_CAP) { atomicAdd(&bar[XB_TMO], 1u); break; } }
    }
    nloc = mine > 0u ? mine : 1u; nx = cnt > 0u ? cnt : 1u;
}

__device__ __forceinline__ void xcd_barrier(const XcdBarrier& b) {
    asm volatile("s_waitcnt vmcnt(0)" ::: "memory");
    __syncthreads();
    if (b.wv == 0 && lane_id_v() == 0) {
        unsigned* bar = b.bar; unsigned bx = b.x;
        asm volatile("" : "+s"(bar), "+s"(bx));
        __builtin_amdgcn_s_waitcnt(0);
        unsigned nloc = b.st[0], nx = b.st[1];
        if (nloc == 0u) { xcd_barrier_complete(bar, bx, nloc, nx); b.st[0] = nloc; b.st[1] = nx; }
        const unsigned old = xb_add(&bar[XB_XSUB(bx)], 1u);
        const unsigned gen = old / nloc;
        if (old + 1u == (gen + 1u) * nloc) {
            __builtin_amdgcn_fence(__ATOMIC_RELEASE, "agent");
            asm volatile("s_waitcnt vmcnt(0)" ::: "memory");
            const unsigned og = xb_add(&bar[XB_TOP], 1u);
            const unsigned tg = og / nx;
            if (og + 1u == (tg + 1u) * nx) xb_add(&bar[XB_TOPGEN], 1u);
            else XB_SPIN(xb_ld(&bar[XB_TOPGEN]) == tg, bar);
            __builtin_amdgcn_fence(__ATOMIC_ACQUIRE, "agent");
            xb_add(&bar[XB_XGEN(bx)], 1u);
            asm volatile("s_waitcnt vmcnt(0)" ::: "memory");
        } else {
            XB_SPIN(xb_ld(&bar[XB_XGEN(bx)]) == gen, bar);
            __builtin_amdgcn_fence(__ATOMIC_ACQUIRE, "agent");
            asm volatile("s_waitcnt vmcnt(0)" ::: "memory");
        }
    }
    __syncthreads();
}


#ifndef PHASE_MASK
#define PHASE_MASK 0x3ff
#endif
#define HAS(k) (((PHASE_MASK) >> (k)) & 1)
struct Args { const float* in[23]; float* out; unsigned char* ws; int ph_lo, ph_hi; };
constexpr int N_PHASES = 18;

__global__ void __launch_bounds__(512, 2) mega_fwd(Args args) {
    extern __shared__ __attribute__((aligned(16))) unsigned char lds_raw[];
    cg::grid_group grid = cg::this_grid();
    Ctx C;
    C.lds = (LAS unsigned char*)lds_raw; C.misc = (volatile LAS int*)(C.lds + LDS_MISC);
    const int wv0 = __builtin_amdgcn_readfirstlane((int)threadIdx.x >> 6);
    C.tid = threadIdx.x; C.lane = C.tid & 63; C.wave = wv0; C.G = gridDim.x; C.bid = blockIdx.x;
    const int lo = args.ph_lo, hi = args.ph_hi;
    if (threadIdx.x < 64) ((volatile LAS int*)(C.lds + LDS_MISC))[threadIdx.x] = 0;
    __syncthreads();
    XcdBarrier xbar = xcd_barrier_post((unsigned*)(args.ws + WS_CTL) + CW_BAR, (volatile LAS unsigned*)(C.lds + LDS_MISC) + 8);
    xbar.wv = wv0;
    typedef const Args __attribute__((address_space(4)))* KArgP;
#define CTX_REFRESH() do { KArgP ka_ = (KArgP)__builtin_amdgcn_kernarg_segment_ptr(); asm volatile("" : "+s"(ka_)); \
        _Pragma("unroll") for (int i_ = 0; i_ < 23; ++i_) C.in[i_] = ka_->in[i_]; C.out = ka_->out; C.ws = ka_->ws; \
        int w_ = wv0; asm volatile("" : "+s"(w_)); int l_ = lane_id_v(); asm volatile("" : "+v"(l_)); C.wave = w_; C.lane = l_; C.tid = w_ * 64 + l_; } while (0)
#if MK_PER_PHASE
#define IN(k) (lo <= (k) && (k) < hi)
#else
#define IN(k) true
#endif
#define XBAR() do { xbar.bar = (unsigned*)(C.ws + WS_CTL) + CW_BAR; xcd_barrier(xbar); } while (0)
#define SEAM(k) do { if (IN(k) && IN((k) + 1)) XBAR(); } while (0)
#define HN ((bf16_t*)(C.ws + WS_HN))
#define PROJ ((bf16_t*)(C.ws + WS_PROJ))
#define CAT ((bf16_t*)(C.ws + WS_CAT))
#define XSS ((bf16_t*)(C.ws + WS_XSS))
#define ACT ((bf16_t*)(C.ws + WS_ACT))
#define YB ((bf16_t*)(C.ws + WS_PROJ))

#if PROBE >= 300 && PROBE < 400
    unsigned long long ptacc_ = 0, pt0_ = __builtin_amdgcn_s_memrealtime();
#define PH_END(id) do { const unsigned long long n_ = __builtin_amdgcn_s_memrealtime(); if ((PROBE - 300) == (id)) ptacc_ += n_ - pt0_; pt0_ = n_; } while (0)
#else
#define PH_END(id) do {} while (0)
#endif
    if (lo == 0x7fffffff) grid.sync();
    if (HAS(0) && IN(0)) { CTX_REFRESH(); phase_prologue(C); phase_norm<0>(C, C.in[IN_X], nullptr, C.in[IN_ANORM], HN, nullptr); } SEAM(0); PH_END(0);
    if (PROBE == 1) { CTX_REFRESH(); phase_prologue(C); XBAR(); }
    for (int l = 0; l < NLAYER; ++l) {
        const int p0 = 1 + 8 * l;
        if (HAS(1) && IN(p0 + 0)) { CTX_REFRESH();
            if (l > 0) { load_starts(C, l - 1); phase_norm<1>(C, C.out, C.out, C.in[IN_ANORM] + l * DM, HN, nullptr); }
        } if (l > 0) SEAM(p0 + 0); PH_END(p0 + 0);
        if (PROBE == 8 && l == 0) { CTX_REFRESH(); phase_norm<0>(C, C.in[IN_X], nullptr, C.in[IN_ANORM], HN, nullptr); XBAR(); }
        if (HAS(2) && IN(p0 + 1)) { CTX_REFRESH();
            pg8::Gemm g{HN, (const bf16_t*)(C.ws + WS_WIN) + (size_t)l * INC * DM, T, INC, DM}; pg8::StaticOrder S; S.init(T, INC, C.G, C.bid);
            EpiProj E{PROJ, (const float*)(C.ws + WS_COS), (const float*)(C.ws + WS_SIN)};
            pg8::gemm_phase<EpiProj, pg8::StaticOrder, true, true>(C.lds, g, S, E, C.tid);
        } SEAM(p0 + 1); PH_END(p0 + 1);
        if (PROBE == 2 && l == 0) { CTX_REFRESH();
            pg8::Gemm g{HN, (const bf16_t*)(C.ws + WS_WIN) + (size_t)l * INC * DM, T, INC, DM}; pg8::StaticOrder S; S.init(T, INC, C.G, C.bid);
            EpiProj E{PROJ, (const float*)(C.ws + WS_COS), (const float*)(C.ws + WS_SIN)};
            pg8::gemm_phase<EpiProj, pg8::StaticOrder, true, true>(C.lds, g, S, E, C.tid); XBAR(); }
        if (HAS(3) && IN(p0 + 2)) { CTX_REFRESH(); phase_mixers(C, l); } SEAM(p0 + 2); PH_END(p0 + 2);
        if (PROBE >= 30 && PROBE <= 37 && l == 0) { CTX_REFRESH(); phase_mixers(C, l, 2, PROBE - 30); XBAR(); }
#if PROBE >= 100 && PROBE < 200
        if (l == 0) { CTX_REFRESH(); phase_mixers<128 | (PROBE - 100)>(C, l, 2, 1); XBAR(); }
#endif
        if (HAS(4) && IN(p0 + 3)) { CTX_REFRESH();
            pg8::Gemm g{CAT, (const bf16_t*)(C.ws + WS_WOUT) + (size_t)l * DM * DM, T, DM, DM}; pg8::StaticOrder S; S.init(T, DM, C.G, C.bid);
            EpiResid E{l == 0 ? C.in[IN_X] : C.out, C.out};
            pg8::gemm_phase<EpiResid, pg8::StaticOrder, true, true>(C.lds, g, S, E, C.tid);
        } SEAM(p0 + 3); PH_END(p0 + 3);
        if (PROBE == 4 && l == 0) { CTX_REFRESH();
            pg8::Gemm g{CAT, (const bf16_t*)(C.ws + WS_WOUT) + (size_t)l * DM * DM, T, DM, DM}; pg8::StaticOrder S; S.init(T, DM, C.G, C.bid);
            EpiResid E{C.in[IN_X], C.out};
            pg8::gemm_phase<EpiResid, pg8::StaticOrder, true, true>(C.lds, g, S, E, C.tid); XBAR(); }
        if (HAS(5) && IN(p0 + 4)) { CTX_REFRESH(); phase_router(C, l); } SEAM(p0 + 4); PH_END(p0 + 4);
        if (HAS(7) && IN(p0 + 6)) { CTX_REFRESH();
            load_starts(C, l);
            pg8::Gemm g{HN, (const bf16_t*)(C.ws + WS_WGU) + (size_t)l * NEXP * 1024 * DM, T, 1024, DM};
            pg8::MoeOrder S{(const LAS int*)(C.lds + LDS_MISC) + MI_ST, (const LAS int*)(C.lds + LDS_MISC) + MI_TP, 4, 1024, C.G, C.bid};
            LAS int* tk = (LAS int*)(C.lds + LDS_MISC + 4096);
            { const int* rowtok = (const int*)(C.ws + WS_ROWTOK);
#pragma unroll 1
              for (int i = 0; i < 6; ++i) { Unit u; if (!S.next(i, u)) break; if (C.tid < 256) tk[i * 256 + C.tid] = (C.tid < u.valid) ? rowtok[u.e * T + u.pm * 256 + C.tid] : 0; }
              __syncthreads(); }
            EpiGU E{ACT};
            pg8::gemm_phase<EpiGU, pg8::MoeOrder, true, true, true>(C.lds, g, S, E, C.tid, (const LAS int*)tk);
        } SEAM(p0 + 6); PH_END(p0 + 6);
        if (HAS(8) && IN(p0 + 7)) { CTX_REFRESH();
            load_starts(C, l);
            pg8::Gemm g{ACT, (const bf16_t*)(C.ws + WS_WDN) + (size_t)l * NEXP * DM * DFF, NASSIGN, DM, DFF};
            pg8::MoeOrder S{(const LAS int*)(C.lds + LDS_MISC) + MI_ST, (const LAS int*)(C.lds + LDS_MISC) + MI_TP, 8, DM, C.G, C.bid};
            EpiDown E{YB, (const float*)(C.ws + WS_ROWGATE)};
            pg8::gemm_phase<EpiDown, pg8::MoeOrder, true, true>(C.lds, g, S, E, C.tid);
        } SEAM(p0 + 7); PH_END(p0 + 7);
        if (PROBE == 7 && l == 0) { CTX_REFRESH();
            load_starts(C, l);
            pg8::Gemm g{ACT, (const bf16_t*)(C.ws + WS_WDN) + (size_t)l * NEXP * DM * DFF, NASSIGN, DM, DFF};
            pg8::MoeOrder S{(const LAS int*)(C.lds + LDS_MISC) + MI_ST, (const LAS int*)(C.lds + LDS_MISC) + MI_TP, 8, DM, C.G, C.bid};
            EpiDown E{YB, (const float*)(C.ws + WS_ROWGATE)};
            pg8::gemm_phase<EpiDown, pg8::MoeOrder, true, true>(C.lds, g, S, E, C.tid); XBAR(); }
    }
    if (HAS(9) && IN(17)) { CTX_REFRESH(); load_starts(C, NLAYER - 1); phase_norm<2>(C, C.out, nullptr, C.in[IN_FINAL], nullptr, C.out); }
#if PROBE >= 300 && PROBE < 400
    PH_END(17);
    if (C.bid == 0 && C.wave == 0 && C.lane == 0) { const unsigned long long t0_ = __builtin_amdgcn_s_memrealtime(); while (__builtin_amdgcn_s_memrealtime() - t0_ < ptacc_) __builtin_amdgcn_s_sleep(8); }
#endif
#if PROBE >= 201 && PROBE <= 219
    if (C.bid == 0 && C.tid == 0) { const float v_ = *(volatile float*)(C.ws + WS_SGATE + 140 * 1024); const unsigned long long t0_ = __builtin_amdgcn_s_memrealtime(), dt_ = (unsigned long long)(v_ * 10.f);
        while (__builtin_amdgcn_s_memrealtime() - t0_ < dt_) __builtin_amdgcn_s_sleep(8); }
#endif
#undef IN
#undef SEAM
#undef HN
#undef PROJ
#undef CAT
#undef XSS
#undef ACT
#undef YB
}

extern "C" void kernel_launch(void* const* d_in, const int* in_sizes, int n_in, void* d_out, int out_size, void* d_ws, size_t ws_size, hipStream_t stream) {
    static int grid = 0;
    if (grid == 0) {
        if (n_in != 23 || in_sizes[0] != T * DM || out_size != T * DM || ws_size < WS_END) { fprintf(stderr, "kernel_launch: unexpected shapes (n_in %d, in0 %d, out %d, ws %zu < %zu)\n", n_in, n_in > 0 ? in_sizes[0] : -1, out_size, ws_size, (size_t)WS_END); grid = -1; return; }
        int dev = 0, cus = 0, per_cu = 0;
        hipGetDevice(&dev); hipDeviceGetAttribute(&cus, hipDeviceAttributeMultiprocessorCount, dev);
        if (hipFuncSetAttribute((const void*)mega_fwd, hipFuncAttributeMaxDynamicSharedMemorySize, LDS_BYTES) != hipSuccess) { fprintf(stderr, "kernel_launch: hipFuncSetAttribute failed\n"); grid = -1; return; }
        if (hipOccupancyMaxActiveBlocksPerMultiprocessor(&per_cu, (const void*)mega_fwd, 512, LDS_BYTES) != hipSuccess || per_cu < 1) { fprintf(stderr, "kernel_launch: occupancy query says %d blocks per CU\n", per_cu); per_cu = 1; }
        (void)hipGetLastError();
        grid = cus * 1;
        fprintf(stderr, "kernel_launch: %d CUs, occupancy %d/CU, grid %d\n", cus, per_cu, grid);
    }
    if (grid < 0) return;
    hipMemsetAsync((char*)d_ws + WS_CTL, 0, CTL_ZERO_BYTES, stream);
    Args a{};
    for (int i = 0; i < 23; ++i) a.in[i] = (const float*)d_in[i];
    a.out = (float*)d_out; a.ws = (unsigned char*)d_ws;
#if MK_PER_PHASE
    for (int p = 0; p < N_PHASES; ++p) {
        a.ph_lo = p; a.ph_hi = p + 1; void* kargs[] = {&a};
        hipError_t e = hipLaunchCooperativeKernel((const void*)mega_fwd, dim3(grid), dim3(512), kargs, LDS_BYTES, stream);
        if (e != hipSuccess) { fprintf(stderr, "launch of phase %d failed: %s\n", p, hipGetErrorString(e)); break; }
    }
#else
    a.ph_lo = 0; a.ph_hi = N_PHASES; void* kargs[] = {&a};
    hipError_t e = hipLaunchCooperativeKernel((const void*)mega_fwd, dim3(grid), dim3(512), kargs, LDS_BYTES, stream);
    if (e != hipSuccess) fprintf(stderr, "cooperative launch failed: %s (grid %d)\n", hipGetErrorString(e), grid);
#endif
}
```

```cpp
#include <hip/hip_runtime.h>
#include <hip/hip_cooperative_groups.h>
#include <cstdio>
#include <cstdint>
namespace cg = cooperative_groups;
#ifndef PROBE
#define PROBE 0
#endif
#ifndef MK_PER_PHASE
#define MK_PER_PHASE 0
#endif

namespace pg8 {
#define PG8_LAS __attribute__((address_space(3)))
typedef unsigned short bf16_t;
typedef short bf16x8 __attribute__((ext_vector_type(8)));
typedef float f32x4 __attribute__((ext_vector_type(4)));
typedef unsigned u32x4 __attribute__((ext_vector_type(4)));
constexpr int BM = 256, BK = 64, HALF = 128, HTB = HALF * BK * 2  , STAGE_BYTES = 8 * HTB, NXCD = 8, WGM = 8;

__host__ __device__ __forceinline__ int lds_byte(int r, int c) { const int st = (r >> 4) * 2 + (c >> 5), rr = r & 15, cc = c & 31, ob = rr * 64 + cc * 2; return st * 1024 + (ob ^ (((ob >> 9) & 1) << 5)); }
__host__ __device__ __forceinline__ void stage_rc(int b, int& R, int& C) { const int st = b / 1024, sb = b % 1024, swz = sb ^ (((sb >> 9) & 1) << 5); R = (st >> 1) * 16 + swz / 64; C = (st & 1) * 32 + (swz % 64) / 2; }
__host__ __device__ __forceinline__ int perm32(int rho) { const int n = rho >> 4, i = rho & 15; return 8 * (i >> 2) + 4 * n + (i & 3); }

struct Unit { int am, bn, pm, pn, e, valid; };
struct Gemm { const bf16_t* A; const bf16_t* Bt; int M, N, K; };

struct StaticOrder {
    int nM, nN, nwg, G, c;
    __device__ void init(int M, int N, int G_, int c_) { nM = M / BM; nN = N / BM; nwg = nM * nN; G = G_; c = c_; }
    __device__ bool next(int i, Unit& u) const {
        const long L = (long)i * G + c; if (L >= nwg) return false;
        int wgid = (int)L; { const int q = nwg / NXCD, r = nwg % NXCD, xcd = wgid % NXCD, off = wgid / NXCD; wgid = (xcd < r ? xcd * (q + 1) : r * (q + 1) + (xcd - r) * q) + off; }
        const int nig = WGM * nN, gid = wgid / nig, fm = gid * WGM, gsz = (nM - fm) < WGM ? (nM - fm) : WGM;
        u.pm = fm + ((wgid % nig) % gsz); u.pn = (wgid % nig) / gsz; u.am = u.pm * BM; u.bn = u.pn * BM; u.e = 0; u.valid = BM; return true;
    }
    __device__ __forceinline__ void a_ready(const Unit&) const {}
    __device__ __forceinline__ void done(const Unit&) const {}
};
struct MoeOrder {
    const PG8_LAS int* ST;
    const PG8_LAS int* TP;
    int NP, NB, G, c;
    __device__ bool next(int i, Unit& u) const {
#define RFL(x) __builtin_amdgcn_readfirstlane(x)
        const int U = RFL(TP[32]) * NP, CH = (U + NXCD - 1) / NXCD;
        const int x = c % NXCD, j = c / NXCD + (G / NXCD) * i;
        if (j >= CH) return false;
        const int ui = x * CH + j; if (ui >= U) return false;
        const int t = ui / NP, pn = ui % NP;
        int e = 0;
        while (e < 31 && RFL(TP[e + 1]) <= t) ++e;
        const int tpe = RFL(TP[e]), ste = RFL(ST[e]), ste1 = RFL(ST[e + 1]);
        const int mt = t - tpe, cnt = ste1 - ste;
        u.e = e; u.pm = mt; u.pn = pn; u.am = ste + mt * BM; u.bn = e * NB + pn * BM; u.valid = (cnt - mt * BM) < BM ? (cnt - mt * BM) : BM; return true;
#undef RFL
    }
    __device__ __forceinline__ void a_ready(const Unit&) const {}
    __device__ __forceinline__ void done(const Unit&) const {}
};

__device__ __forceinline__ unsigned cvt_pk_bf16(float lo, float hi) { unsigned r; asm volatile("v_cvt_pk_bf16_f32 %0, %1, %2" : "=v"(r) : "v"(lo), "v"(hi)); return r; }

template <class Epi, class Sched, bool ALIGN_EPI = false, bool SP2 = false, bool GATHER = false>
__device__ __forceinline__ void gemm_phase(PG8_LAS unsigned char* lds, const Gemm g, const Sched& S, const Epi& E, const int tid, const PG8_LAS int* tk = nullptr) {
    static_assert(SP2 || !GATHER, "gather needs the SP2 loop");
    const int wid = __builtin_amdgcn_readfirstlane(tid >> 6), lane = tid & 63, wr = wid >> 2, wc = wid & 3, fr = lane & 15, fq = lane >> 4;
    const int K = g.K, nt = K / BK;
    unsigned voffA[2], voffB[2]; int gR[2]; unsigned gC[2];
    { int R, C; stage_rc(tid * 16, R, C); const int Rb = Epi::PERM ? ((R & ~31) + perm32(R & 31)) : R;
      voffA[0] = (unsigned)(R * K + C) * 2u; voffB[0] = (unsigned)(Rb * K + C) * 2u; gR[0] = R; gC[0] = (unsigned)C * 2u;
      voffA[1] = voffA[0] + (unsigned)(64 * K * 2); voffB[1] = voffB[0] + (unsigned)(64 * K * 2); gR[1] = R + 64; gC[1] = gC[0]; }
    const size_t kstep = (size_t)(BK * 2);
    const size_t hstep = (size_t)HALF * K * 2;
    const size_t rowb = (size_t)K * 2;
    const unsigned ldsw = (unsigned)wid * 1024u;
    const int aoff = lds_byte(wr * 64 + fr, fq * 8), boff = lds_byte(wc * 32 + fr, fq * 8);
#define PG8_SA(b, h) (((b) * 2 + (h)) * HTB)
#define PG8_SB(b, h) ((4 + (b) * 2 + (h)) * HTB)
#define PG8_STAGE(bufoff, gbase, voff) do { _Pragma("unroll") for (int _i = 0; _i < 2; ++_i) \
        __builtin_amdgcn_global_load_lds((const unsigned*)((const char*)(gbase) + (size_t)_i * (64 * rowb) + (voff)[0]), (PG8_LAS unsigned*)(lds + (bufoff) + ldsw + _i * 8192), 16, 0, 0); } while (0)
#define PG8_STAGE2(bufoff, gbase, voff) do { _Pragma("unroll") for (int _i = 0; _i < 2; ++_i) \
        __builtin_amdgcn_global_load_lds((const unsigned*)((const char*)(gbase) + (voff)[_i]), (PG8_LAS unsigned*)(lds + (bufoff) + ldsw + _i * 8192), 16, 0, 0); } while (0)
#define PG8_STAGE_A(bufoff, h, ptr, kb, nx) do { if constexpr (GATHER) { unsigned go_[2]; const int ub_ = ((nx) ? ui + 1 : ui) * 256 + (h) * 128 + gR[0]; \
        go_[0] = (unsigned)tk[ub_] * (unsigned)(K * 2) + gC[0]; go_[1] = (unsigned)tk[ub_ + 64] * (unsigned)(K * 2) + gC[0]; \
        PG8_STAGE2(bufoff, (const char*)g.A + (kb), go_); } else { PG8_STAGE(bufoff, ptr, voffA); } } while (0)
#define PG8_LDA(dst, b, h) do { _Pragma("unroll") for (int m = 0; m < 4; ++m) _Pragma("unroll") for (int k = 0; k < 2; ++k) dst[m][k] = *(const PG8_LAS bf16x8*)(lds + PG8_SA(b, h) + aoff + m * 2048 + k * 1024); } while (0)
#define PG8_LDB(dst, b, h) do { _Pragma("unroll") for (int n = 0; n < 2; ++n) _Pragma("unroll") for (int k = 0; k < 2; ++k) dst[n][k] = *(const PG8_LAS bf16x8*)(lds + PG8_SB(b, h) + boff + n * 2048 + k * 1024); } while (0)
#define PG8_MMA(ai, bj, At, Bt) do { __builtin_amdgcn_s_setprio(1); _Pragma("unroll") for (int m = 0; m < 4; ++m) _Pragma("unroll") for (int n = 0; n < 2; ++n) _Pragma("unroll") for (int k = 0; k < 2; ++k) \
        acc[ai][bj][m][n] = __builtin_amdgcn_mfma_f32_16x16x32_bf16(Bt[n][k], At[m][k], acc[ai][bj][m][n], 0, 0, 0); __builtin_amdgcn_s_setprio(0); } while (0)
#define PG8_WAIT_V(n) asm volatile("s_waitcnt vmcnt(" #n ")" ::: "memory")
#define PG8_WAIT_L(n) asm volatile("s_waitcnt lgkmcnt(" #n ")" ::: "memory")
#define PG8_BAR __builtin_amdgcn_s_barrier()
#define PG8_SCHED __builtin_amdgcn_sched_barrier(0)
    Unit cur, nxt; int ui = 0;
    if (!S.next(0, cur)) return;
    f32x4 acc[2][2][4][2];
#pragma unroll
    for (int a = 0; a < 2; ++a)
#pragma unroll
        for (int b = 0; b < 2; ++b)
#pragma unroll
            for (int m = 0; m < 4; ++m)
#pragma unroll
                for (int n = 0; n < 2; ++n) acc[a][b][m][n] = (f32x4){0.f, 0.f, 0.f, 0.f};
    bf16x8 At[4][2], B0[2][2], B1[2][2];
    const char* cA = (const char*)g.A + (size_t)cur.am * rowb; const char* cB = (const char*)g.Bt + (size_t)cur.bn * rowb;
    S.a_ready(cur);
    if constexpr (SP2) {
        PG8_STAGE(PG8_SB(0, 0), cB, voffB); PG8_STAGE(PG8_SB(0, 1), cB + hstep, voffB); PG8_STAGE_A(PG8_SA(0, 0), 0, cA, 0, false); PG8_STAGE_A(PG8_SA(0, 1), 1, cA + hstep, 0, false);
        if (wr == 1) PG8_BAR;
        PG8_WAIT_V(2); PG8_BAR;
        PG8_STAGE(PG8_SB(1, 0), cB + kstep, voffB); PG8_STAGE_A(PG8_SA(1, 0), 0, cA + kstep, kstep, false); PG8_STAGE(PG8_SB(1, 1), cB + hstep + kstep, voffB);
        PG8_WAIT_V(6); PG8_BAR;
    } else {
        PG8_STAGE(PG8_SB(0, 0), cB, voffB); PG8_STAGE(PG8_SA(0, 0), cA, voffA); PG8_STAGE(PG8_SB(0, 1), cB + hstep, voffB); PG8_STAGE(PG8_SA(0, 1), cA + hstep, voffA);
        if (wr == 1) PG8_BAR;
        PG8_WAIT_V(4); PG8_BAR;
        PG8_STAGE(PG8_SB(1, 0), cB + kstep, voffB); PG8_STAGE(PG8_SA(1, 0), cA + kstep, voffA); PG8_STAGE(PG8_SB(1, 1), cB + hstep + kstep, voffB);
        PG8_WAIT_V(6); PG8_BAR;
    }
    for (;;) {
        const bool has_next = S.next(ui + 1, nxt);
        const char* nA = has_next ? (const char*)g.A + (size_t)nxt.am * rowb : cA; const char* nB = has_next ? (const char*)g.Bt + (size_t)nxt.bn * rowb : cB;
        for (int t = 0; t < nt; t += 2) {
            const bool last = (t == nt - 2);
            const char* a1 = cA + (size_t)(t + 1) * kstep;
            const char* a2 = last ? nA : cA + (size_t)(t + 2) * kstep; const char* b2 = last ? nB : cB + (size_t)(t + 2) * kstep;
            const char* a3 = a2 + kstep; const char* b3 = b2 + kstep;
            const size_t gk2 = last ? 0 : (size_t)(t + 2) * kstep; const bool gnx = last && has_next;
            if (last && has_next) S.a_ready(nxt);
            if constexpr (SP2) {
            PG8_LDB(B0, 0, 0); PG8_LDB(B1, 0, 1); PG8_SCHED; PG8_LDA(At, 0, 0); PG8_STAGE_A(PG8_SA(1, 1), 1, a1 + hstep, (size_t)(t + 1) * kstep, false);
            PG8_WAIT_V(8); PG8_WAIT_L(0); PG8_BAR; PG8_MMA(0, 0, At, B0); PG8_MMA(0, 1, At, B1); PG8_BAR; PG8_SCHED;
            PG8_LDA(At, 0, 1); PG8_STAGE(PG8_SB(0, 0), b2, voffB); PG8_STAGE(PG8_SB(0, 1), b2 + hstep, voffB); PG8_STAGE_A(PG8_SA(0, 0), 0, a2, gk2, gnx);
            PG8_WAIT_V(8); PG8_WAIT_L(0); PG8_BAR; PG8_MMA(1, 0, At, B0); PG8_MMA(1, 1, At, B1); PG8_BAR; PG8_SCHED;
            PG8_LDB(B0, 1, 0); PG8_LDB(B1, 1, 1); PG8_SCHED; PG8_LDA(At, 1, 0); PG8_STAGE_A(PG8_SA(0, 1), 1, a2 + hstep, gk2, gnx);
            PG8_WAIT_V(8); PG8_WAIT_L(0); PG8_BAR; PG8_MMA(0, 0, At, B0); PG8_MMA(0, 1, At, B1); PG8_BAR; PG8_SCHED;
            PG8_LDA(At, 1, 1); PG8_STAGE(PG8_SB(1, 0), b3, voffB); PG8_STAGE(PG8_SB(1, 1), b3 + hstep, voffB); PG8_STAGE_A(PG8_SA(1, 0), 0, a3, gk2 + kstep, gnx);
            PG8_WAIT_V(8); PG8_WAIT_L(0); PG8_BAR; PG8_MMA(1, 0, At, B0); PG8_MMA(1, 1, At, B1); PG8_BAR; PG8_SCHED;
            } else {
            PG8_LDB(B0, 0, 0); PG8_SCHED; PG8_LDA(At, 0, 0); PG8_STAGE(PG8_SA(1, 1), a1 + hstep, voffA);
            PG8_WAIT_L(8); PG8_BAR; PG8_WAIT_L(0); PG8_MMA(0, 0, At, B0); PG8_BAR; PG8_SCHED;
            PG8_LDB(B1, 0, 1); PG8_STAGE(PG8_SB(0, 0), b2, voffB);
            PG8_BAR; PG8_WAIT_L(0); PG8_MMA(0, 1, At, B1); PG8_BAR;
            PG8_LDA(At, 0, 1); PG8_STAGE(PG8_SA(0, 0), a2, voffA);
            PG8_BAR; PG8_WAIT_L(0); PG8_MMA(1, 0, At, B0); PG8_BAR; PG8_SCHED;
            PG8_STAGE(PG8_SB(0, 1), b2 + hstep, voffB);
            PG8_WAIT_V(6); PG8_BAR; PG8_MMA(1, 1, At, B1); PG8_BAR;
            PG8_LDB(B0, 1, 0); PG8_SCHED; PG8_LDA(At, 1, 0); PG8_STAGE(PG8_SA(0, 1), a2 + hstep, voffA);
            PG8_WAIT_L(8); PG8_BAR; PG8_WAIT_L(0); PG8_MMA(0, 0, At, B0); PG8_BAR; PG8_SCHED;
            PG8_LDB(B1, 1, 1); PG8_STAGE(PG8_SB(1, 0), b3, voffB);
            PG8_BAR; PG8_WAIT_L(0); PG8_MMA(0, 1, At, B1); PG8_BAR;
            PG8_LDA(At, 1, 1); PG8_STAGE(PG8_SA(1, 0), a3, voffA);
            PG8_BAR; PG8_WAIT_L(0); PG8_MMA(1, 0, At, B0); PG8_BAR; PG8_SCHED;
            PG8_STAGE(PG8_SB(1, 1), b3 + hstep, voffB);
            PG8_WAIT_V(6); PG8_BAR; PG8_MMA(1, 1, At, B1); PG8_BAR;
            }
        }
        if constexpr (ALIGN_EPI) { if (wr == 0) PG8_BAR; }
        if constexpr (!Epi::AFTER_DRAIN) { E(acc, cur, wr, wc, fr, fq); S.done(cur); }
        if (!has_next) break;
#pragma unroll
        for (int a = 0; a < 2; ++a)
#pragma unroll
            for (int b = 0; b < 2; ++b)
#pragma unroll
                for (int m = 0; m < 4; ++m)
#pragma unroll
                    for (int n = 0; n < 2; ++n) acc[a][b][m][n] = (f32x4){0.f, 0.f, 0.f, 0.f};
        cur = nxt; cA = nA; cB = nB; ++ui;
        if constexpr (ALIGN_EPI) { if (wr == 1) PG8_BAR; }
    }
    PG8_WAIT_V(0);
    if constexpr (!ALIGN_EPI) { if (wr == 0) PG8_BAR; }
    PG8_BAR;
    if constexpr (Epi::AFTER_DRAIN) { E.fused(acc, cur, wr, wc, fr, fq, lds, wid, lane); S.done(cur); }
#undef PG8_SA
#undef PG8_SB
#undef PG8_STAGE
#undef PG8_STAGE2
#undef PG8_STAGE_A
#undef PG8_LDA
#undef PG8_LDB
#undef PG8_MMA
#undef PG8_WAIT_V
#undef PG8_WAIT_L
#undef PG8_BAR
#undef PG8_SCHED
}
}

#define LAS __attribute__((address_space(3)))
typedef unsigned short bf16_t;
typedef short bf16x8 __attribute__((ext_vector_type(8)));
typedef float f32x4 __attribute__((ext_vector_type(4)));
typedef float f32x16 __attribute__((ext_vector_type(16)));
typedef unsigned u32x4 __attribute__((ext_vector_type(4)));
typedef unsigned u32x2 __attribute__((ext_vector_type(2)));
typedef short s16x4 __attribute__((ext_vector_type(4)));
typedef LAS const char* lds_cptr;
using pg8::Unit;

constexpr int T = 16384, SEQ = 8192, DM = 2048, INC = 4096, NEXP = 32, DFF = 512, NASSIGN = 2 * T, NLAYER = 2;
constexpr float LOG2E = 1.4426950408889634f;
constexpr float C2 = 0.125f * LOG2E;
constexpr int C_QA = 0, C_KA = 768, C_VA = 1024, C_UB = 1280, C_QC = 1792, C_KC = 2560, C_VC = 3328;

constexpr size_t MiB = 1u << 20;
constexpr size_t WS_CTL = 0, CTL_ZERO_BYTES = 1 * MiB;
constexpr size_t WS_COS = 2 * MiB, WS_SIN = 4 * MiB;
constexpr size_t WS_TOKE = 6 * MiB, WS_TOKG = 6 * MiB + 256 * 1024, WS_TOKP = 6 * MiB + 512 * 1024, WS_SGATE = 6 * MiB + 768 * 1024;
constexpr size_t WS_ROWTOK = 8 * MiB, WS_ROWGATE = 10 * MiB;
constexpr size_t WS_LAM = 6 * MiB + 1000 * 1024;
constexpr size_t WS_WR = 12 * MiB;
constexpr size_t WS_WIN = 16 * MiB, WS_WOUT = 48 * MiB, WS_WGU = 64 * MiB, WS_WDN = 320 * MiB;
constexpr size_t WS_HN = 448 * MiB, WS_PROJ = 512 * MiB, WS_CAT = 642 * MiB, WS_XSS = 706 * MiB, WS_ACT = 835 * MiB, WS_END = 868 * MiB;
constexpr int CW_QCTR = 0;
constexpr int CW_CUR = 1024;
constexpr int CW_BAR = 8192;

constexpr int LDS_WSF = 135168, LDS_MISC = 137216, LDS_BYTES = 147456;
constexpr int MI_ST = 16, MI_TP = 64, MI_LCNT = 128, MI_LBASE = 160, MI_SSQ = 256;

#define LDS_WAIT() asm volatile("s_waitcnt lgkmcnt(0)" ::: "memory")
__device__ __forceinline__ unsigned f2bf(float f) { unsigned u = __builtin_bit_cast(unsigned, f); return (u + 0x7fffu + ((u >> 16) & 1u)) >> 16; }
__device__ __forceinline__ unsigned pk2(float lo, float hi) { return f2bf(lo) | (f2bf(hi) << 16); }
__device__ __forceinline__ float bf2f(unsigned b) { return __builtin_bit_cast(float, b << 16); }
typedef float f32x2_t __attribute__((ext_vector_type(2))); typedef __bf16 bf16x2_t __attribute__((ext_vector_type(2)));
__device__ __forceinline__ unsigned cvtpk(float lo, float hi) { f32x2_t v = {lo, hi}; bf16x2_t b = __builtin_convertvector(v, bf16x2_t); return __builtin_bit_cast(unsigned, b); }
__device__ __forceinline__ float wave_sum(float v) {
#pragma unroll
    for (int o = 1; o < 64; o <<= 1) v += __shfl_xor(v, o);
    return v;
}

struct Ctx {
    const float* in[23]; float* out; unsigned char* ws;
    LAS unsigned char* lds; volatile LAS int* misc;
    int tid, lane, wave, G, bid;
};
#define IN_X 0
#define IN_POS 1
#define IN_ANORM 2
#define IN_WIN 3
#define IN_SINKS 4
#define IN_BNA 5
#define IN_WPOOL 6
#define IN_PSCALE 7
#define IN_LQ1 8
#define IN_LK1 9
#define IN_LQ2 10
#define IN_LK2 11
#define IN_SUBLN 12
#define IN_WOUT 13
#define IN_FNORM 14
#define IN_WRG 15
#define IN_BRG 16
#define IN_WRE 17
#define IN_BRE 18
#define IN_WG 19
#define IN_WU 20
#define IN_WD 21
#define IN_FINAL 22

struct EpiProj {
    static constexpr bool PERM = true, AFTER_DRAIN = false;
    bf16_t* O; const float* cosT; const float* sinT;
    __device__ __forceinline__ void operator()(const f32x4 (&acc)[2][2][4][2], const Unit& u, int wr, int wc, int fr, int fq) const {
        const int pn = u.pn;
        const bool rope = (0x1F8Fu >> pn) & 1u;
        const float sc = ((0x0387u >> pn) & 1u) ? C2 : 1.f;
        const int row0 = u.pm * 256 + wr * 64 + fr, col0 = pn * 256 + wc * 32 + 8 * fq, fi = 16 * (wc & 1) + 4 * fq;
#pragma unroll
        for (int ai = 0; ai < 2; ++ai)
#pragma unroll
            for (int m = 0; m < 4; ++m) {
                const int row = row0 + ai * 128 + m * 16;
                f32x4 cs = {1.f, 1.f, 1.f, 1.f}, sn = {0.f, 0.f, 0.f, 0.f};
                if (rope) { cs = *(const f32x4*)(cosT + (size_t)row * 32 + fi); sn = *(const f32x4*)(sinT + (size_t)row * 32 + fi); }
                bf16_t* rowp = O + (size_t)row * INC + col0;
#pragma unroll
                for (int bj = 0; bj < 2; ++bj) {
                    const f32x4 v0 = acc[ai][bj][m][0], v1 = acc[ai][bj][m][1];
                    const f32x4 o0 = (v0 * cs - v1 * sn) * sc, o1 = (v1 * cs + v0 * sn) * sc;
                    u32x4 w; w.x = cvtpk(o0[0], o0[1]); w.y = cvtpk(o0[2], o0[3]); w.z = cvtpk(o1[0], o1[1]); w.w = cvtpk(o1[2], o1[3]);
                    *(u32x4*)(rowp + bj * 128) = w;
                }
            }
    }
};
struct EpiResid {
    static constexpr bool PERM = false, AFTER_DRAIN = false;
    const float* src; float* dst;
    __device__ __forceinline__ void operator()(const f32x4 (&acc)[2][2][4][2], const Unit& u, int wr, int wc, int fr, int fq) const {
        const int row0 = u.pm * 256 + wr * 64 + fr, col0 = u.pn * 256 + wc * 32 + 4 * fq;
#pragma unroll
        for (int ai = 0; ai < 2; ++ai)
#pragma unroll
            for (int m = 0; m < 4; ++m) {
                const size_t off = (size_t)(row0 + ai * 128 + m * 16) * DM + col0;
#pragma unroll
                for (int bj = 0; bj < 2; ++bj)
#pragma unroll
                    for (int n = 0; n < 2; ++n) { const f32x4 s = *(const f32x4*)(src + off + bj * 128 + n * 16); *(f32x4*)(dst + off + bj * 128 + n * 16) = s + acc[ai][bj][m][n]; }
            }
    }
};
struct EpiGU {
    static constexpr bool PERM = true, AFTER_DRAIN = false;
    bf16_t* ACT;
    __device__ __forceinline__ void operator()(const f32x4 (&acc)[2][2][4][2], const Unit& u, int wr, int wc, int fr, int fq) const {
        const int col0 = u.pn * 128 + wc * 32 + 8 * fq;
#pragma unroll
        for (int ai = 0; ai < 2; ++ai)
#pragma unroll
            for (int m = 0; m < 4; ++m) {
                const int r = ai * 128 + wr * 64 + m * 16 + fr;
                if (r < u.valid) {
                    float a[8];
#pragma unroll
                    for (int n = 0; n < 2; ++n)
#pragma unroll
                        for (int j = 0; j < 4; ++j) { const float g = acc[ai][0][m][n][j], up = acc[ai][1][m][n][j]; a[n * 4 + j] = g * __builtin_amdgcn_rcpf(1.f + __builtin_amdgcn_exp2f(-g * LOG2E)) * up; }
                    u32x4 w; w.x = cvtpk(a[0], a[1]); w.y = cvtpk(a[2], a[3]); w.z = cvtpk(a[4], a[5]); w.w = cvtpk(a[6], a[7]);
                    *(u32x4*)(ACT + (size_t)(u.am + r) * DFF + col0) = w;
                }
            }
    }
};
struct EpiDown {
    static constexpr bool PERM = true, AFTER_DRAIN = false;
    bf16_t* YB; const float* sgate;
    __device__ __forceinline__ void operator()(const f32x4 (&acc)[2][2][4][2], const Unit& u, int wr, int wc, int fr, int fq) const {
        const int col0 = u.pn * 256 + wc * 32 + 8 * fq;
#pragma unroll
        for (int ai = 0; ai < 2; ++ai)
#pragma unroll
            for (int m = 0; m < 4; ++m) {
                const int r = ai * 128 + wr * 64 + m * 16 + fr;
                if (r < u.valid) {
                    const float gt = sgate[u.e * T + u.pm * 256 + r];
                    bf16_t* rowp = YB + (size_t)(u.am + r) * DM + col0;
#pragma unroll
                    for (int bj = 0; bj < 2; ++bj) {
                        const f32x4 v0 = acc[ai][bj][m][0] * gt, v1 = acc[ai][bj][m][1] * gt;
                        u32x4 w; w.x = cvtpk(v0[0], v0[1]); w.y = cvtpk(v0[2], v0[3]); w.z = cvtpk(v1[0], v1[1]); w.w = cvtpk(v1[2], v1[3]);
                        *(u32x4*)(rowp + bj * 128) = w;
                    }
                }
            }
    }
};

template <class F> __device__ __forceinline__ void tr_item(const F& f, int K, bf16_t* WT, LAS float* scr, int kb, int nb, int lane) {
    const int k0 = 64 * kb, n0 = 32 * nb;
#pragma unroll 8
    for (int i = 0; i < 32; ++i) { const int kk = 2 * i + (lane >> 5); scr[kk * 33 + (lane & 31)] = f(k0 + kk, n0 + (lane & 31)); }
    LDS_WAIT(); asm volatile("" ::: "memory");
    const int c = lane & 7;
#pragma unroll
    for (int j = 0; j < 4; ++j) { const int n = (lane >> 3) + 8 * j; const LAS float* s = scr + (8 * c) * 33 + n;
        u32x4 o; o.x = pk2(s[0 * 33], s[1 * 33]); o.y = pk2(s[2 * 33], s[3 * 33]); o.z = pk2(s[4 * 33], s[5 * 33]); o.w = pk2(s[6 * 33], s[7 * 33]);
        *(u32x4*)(WT + (size_t)(n0 + n) * K + k0 + 8 * c) = o; }
    LDS_WAIT(); asm volatile("" ::: "memory");
}
__device__ __forceinline__ float lam_init_of(int l) { return l == 0 ? 0.2f : (0.8f - 0.6f * 0.74081822068171788f); }

struct FWin { const float* w;
    __device__ __forceinline__ float operator()(int k, int n) const {
        const int pn = n >> 8; int col = n;
        if ((pn <= 3) || (pn >= 7 && pn <= 12)) { const int cw = n & 63; col = (n & ~63) + 32 * ((cw >> 2) & 1) + 4 * (cw >> 3) + (cw & 3); }
        return w[(size_t)k * INC + col]; } };
struct FWgu { const float* w;
    __device__ __forceinline__ float operator()(int k, int n) const {
        const int col = 128 * (n >> 8) + (n & 127);
        return w[(size_t)k * DFF + col]; } };
struct FWdn { const float* w;
    __device__ __forceinline__ float operator()(int k, int n) const { return w[(size_t)k * DM + n]; } };
struct FWr { const float* wrg; const float* wre;
    __device__ __forceinline__ float operator()(int k, int n) const {
        const int hl = n >= 48, j = hl ? n - 48 : n;
        const bool isg = j < 4, ise = j >= 4 && j < 36;
        const float* base = isg ? wrg + j : wre + (ise ? j - 4 : 0); const int stride = isg ? 4 : 32;
        const float v = (isg || ise) ? base[(size_t)k * stride] : 0.f * base[(size_t)k * stride];
        const float hi = bf2f(f2bf(v)); return hl ? v - hi : v; } };

__device__ __forceinline__ void fold_item(const float* wout, const float* wpool, const float* pscale, bf16_t* WT, LAS float* scr, int g, int kbh, int nb, int lane) {
    const int n = 64 * nb + lane;
    const float* wp = wpool + ((size_t)g * 128 + 64 * kbh) * 128; const float* ps = pscale + g * 128; const float* wo = wout + (size_t)(768 + g * 128) * DM + n;
#pragma unroll 1
    for (int ih = 0; ih < 2; ++ih) {
        { const f32x4* src = (const f32x4*)(wp + (size_t)(32 * ih) * 128) + lane; f32x4 t[16];
#pragma unroll
          for (int q = 0; q < 16; ++q) t[q] = src[q * 64];
#pragma unroll
          for (int q = 0; q < 16; ++q) *(LAS f32x4*)(scr + (q * 64 + lane) * 4) = t[q]; }
        LDS_WAIT(); asm volatile("" ::: "memory");
        float acc[32];
#pragma unroll
        for (int i = 0; i < 32; ++i) acc[i] = 0.f;
#pragma unroll 1
        for (int jb = 0; jb < 16; ++jb) {
            float bv[8];
            { const float* wj = wo + (size_t)(jb * 8) * DM; const float* pj = ps + jb * 8;
#pragma unroll
              for (int jj = 0; jj < 8; ++jj) bv[jj] = wj[(size_t)jj * DM] * pj[jj]; }
#pragma unroll
            for (int ic = 0; ic < 8; ++ic) {
#pragma unroll
                for (int i = 4 * ic; i < 4 * ic + 4; ++i) { const LAS float* ar = scr + i * 128 + jb * 8; const f32x4 a0 = *(const LAS f32x4*)ar, a1 = *(const LAS f32x4*)(ar + 4);
                    acc[i] = fmaf(a0[0], bv[0], acc[i]); acc[i] = fmaf(a0[1], bv[1], acc[i]); acc[i] = fmaf(a0[2], bv[2], acc[i]); acc[i] = fmaf(a0[3], bv[3], acc[i]);
                    acc[i] = fmaf(a1[0], bv[4], acc[i]); acc[i] = fmaf(a1[1], bv[5], acc[i]); acc[i] = fmaf(a1[2], bv[6], acc[i]); acc[i] = fmaf(a1[3], bv[7], acc[i]); }
                __builtin_amdgcn_sched_barrier(0);
            }
        }
        u32x4* dst = (u32x4*)(WT + (size_t)n * DM + 768 + g * 128 + 64 * kbh + 32 * ih);
#pragma unroll
        for (int c = 0; c < 4; ++c) { u32x4 o; o.x = cvtpk(acc[8 * c], acc[8 * c + 1]); o.y = cvtpk(acc[8 * c + 2], acc[8 * c + 3]); o.z = cvtpk(acc[8 * c + 4], acc[8 * c + 5]); o.w = cvtpk(acc[8 * c + 6], acc[8 * c + 7]); dst[c] = o; }
        LDS_WAIT(); asm volatile("" ::: "memory");
    }
}
constexpr int I_FOLD = 4 * 2 * 32, I_WR = 32 * 3, I_SLOW = I_FOLD + I_WR;
constexpr int I_WIN = 32 * 128, I_WOUT = 24 * 64, I_WGU1 = 32 * 32, I_WDN1 = 8 * 64;
constexpr int I_FAST = I_WIN + I_WOUT + NEXP * I_WGU1 + NEXP * I_WDN1;
struct TrDesc { const float* src; const float* sptr; bf16_t* dst; float smul; int N, K; unsigned coloff; };
constexpr int I_PRO = I_WOUT + I_WIN;
constexpr int I_EXP = NEXP * I_WGU1 + NEXP * I_WDN1;
#define BLK2D(q, NBLK, kq_, nb_) do { const int g_ = (q) >> 3, r8_ = (q) & 7; nb_ = (g_ % ((NBLK) / 2)) * 2 + (r8_ & 1); kq_ = (g_ / ((NBLK) / 2)) * 4 + (r8_ >> 1); } while (0)
__device__ __forceinline__ TrDesc tr_mk(Ctx& C, int l, int r, int lane) {
    const int rr = lane >> 3, cc = lane & 7, nl = lane & 31, kh = lane >> 5;
    TrDesc d; d.sptr = nullptr; d.smul = 1.f;
    int kb, nb, n;
    if (r < I_WOUT) { int kq; BLK2D(r, 64, kq, nb); kb = kq < 12 ? kq : kq + 8; n = 32 * nb + nl;
        d.src = C.in[IN_WOUT] + (size_t)l * DM * DM; d.N = DM; d.K = DM; d.coloff = (unsigned)n * 4u; d.dst = (bf16_t*)(C.ws + WS_WOUT) + (size_t)l * DM * DM;
        if (kb < 12) d.sptr = C.in[IN_BNA] + l * 768 + 64 * kb + 32 * kh; else { d.sptr = C.in[IN_SUBLN] + l * 128 + ((64 * kb - 1280) & 127) + 32 * kh; d.smul = 1.f - lam_init_of(l); } }
    else if ((r -= I_WOUT) < I_WIN) { BLK2D(r, 128, kb, nb); n = 32 * nb + nl; const int pn = n >> 8; int col = n;
        if ((pn <= 3) || (pn >= 7 && pn <= 12)) { const int cw = n & 63; col = (n & ~63) + 32 * ((cw >> 2) & 1) + 4 * (cw >> 3) + (cw & 3); }
        d.src = C.in[IN_WIN] + (size_t)l * DM * INC; d.N = INC; d.K = DM; d.coloff = (unsigned)col * 4u; d.dst = (bf16_t*)(C.ws + WS_WIN) + (size_t)l * INC * DM; }
    else if ((r -= I_WIN) < NEXP * I_WGU1) { const int e = r / I_WGU1, q = r % I_WGU1; BLK2D(q, 32, kb, nb); n = 32 * nb + nl; const size_t eo = ((size_t)l * NEXP + e) * DM * DFF;
        d.src = ((nb & 4) ? C.in[IN_WU] : C.in[IN_WG]) + eo; d.N = DFF; d.K = DM; d.coloff = (unsigned)(128 * (n >> 8) + (n & 127)) * 4u; d.dst = (bf16_t*)(C.ws + WS_WGU) + ((size_t)l * NEXP + e) * 1024 * DM; }
    else { r -= NEXP * I_WGU1; const int e = r / I_WDN1, q = r % I_WDN1; BLK2D(q, 64, kb, nb); n = 32 * nb + nl;
        d.src = C.in[IN_WD] + ((size_t)l * NEXP + e) * DFF * DM; d.N = DM; d.K = DFF; d.coloff = (unsigned)n * 4u; d.dst = (bf16_t*)(C.ws + WS_WDN) + ((size_t)l * NEXP + e) * DM * DFF; }
    d.src += (size_t)(64 * kb + 32 * kh) * d.N;
    d.dst += (size_t)(32 * nb + rr) * d.K + 64 * kb + 8 * cc;
    return d;
}
#undef BLK2D
#define TR_LOAD(v, d) do { const char* rp_ = (const char*)(d).src + (d).coloff; const size_t rs_ = (size_t)(d).N * 4; _Pragma("unroll") for (int j = 0; j < 32; ++j) v[j] = __builtin_nontemporal_load((const float*)(rp_ + j * rs_)); } while (0)
#define TR_STORE(v, d) do { if (!EXPERT) if ((d).sptr) { _Pragma("unroll") for (int j = 0; j < 32; ++j) v[j] *= (d).sptr[j] * (d).smul; }     \
        _Pragma("unroll") for (int c = 0; c < 4; ++c) { u32x4 o; o.x = cvtpk(v[8 * c], v[8 * c + 1]); o.y = cvtpk(v[8 * c + 2], v[8 * c + 3]); o.z = cvtpk(v[8 * c + 4], v[8 * c + 5]); o.w = cvtpk(v[8 * c + 6], v[8 * c + 7]); \
            *(LAS u32x4*)(sc_ + nl * 144 + kh * 64 + c * 16) = o; } \
        LDS_WAIT(); asm volatile("" ::: "memory"); \
        _Pragma("unroll") for (int g = 0; g < 4; ++g) { const u32x4 o = *(const LAS u32x4*)(sc_ + (8 * g + rr) * 144 + cc * 16); *(u32x4*)((d).dst + (size_t)(8 * g) * (d).K) = o; } \
        LDS_WAIT(); asm volatile("" ::: "memory"); } while (0)
template <bool EXPERT> __device__ __forceinline__ void conv_run(Ctx& C, int lfix, int i0, int i1, int stride) {
    const int lane = C.lane, rr = lane >> 3, cc = lane & 7, nl = lane & 31, kh = lane >> 5;
    LAS unsigned char* sc_ = C.lds + C.wave * 16384;
#define TR_MK(i) (EXPERT ? tr_mk(C, lfix, I_PRO + (i), lane) : tr_mk(C, (i) / I_PRO, (i) % I_PRO, lane))
    float vA[32], vB[32]; TrDesc dA, dB;
    int it = i0;
    if (it >= i1) return;
    dA = TR_MK(it); TR_LOAD(vA, dA);
    for (;;) {
        const int itB = it + stride; const bool hB = itB < i1;
        dB = TR_MK(hB ? itB : it); TR_LOAD(vB, dB);
        TR_STORE(vA, dA);
        if (!hB) break;
        it = itB + stride; const bool hA = it < i1;
        dA = TR_MK(hA ? it : itB); TR_LOAD(vA, dA);
        TR_STORE(vB, dB);
        if (!hA) break;
    }
#undef TR_MK
}
#undef TR_LOAD
#undef TR_STORE
__device__ __forceinline__ void phase_prologue(Ctx& C) {
    LAS float* scr = (LAS float*)(C.lds + C.wave * 16384);
    const int gw = C.bid * 8 + C.wave, NGW = C.G * 8, lane = C.lane;
    for (int it = C.bid + C.G * C.wave; it < NLAYER * I_SLOW; it += NGW) {
        const int l = it / I_SLOW, r = it % I_SLOW;
        if (r < I_FOLD) fold_item(C.in[IN_WOUT] + (size_t)l * DM * DM, C.in[IN_WPOOL] + (size_t)l * 4 * 128 * 128, C.in[IN_PSCALE] + l * 512, (bf16_t*)(C.ws + WS_WOUT) + (size_t)l * DM * DM, scr, r / 64, (r / 32) & 1, r % 32, lane);
        else { const int q = r - I_FOLD; FWr f{C.in[IN_WRG] + (size_t)l * DM * 4, C.in[IN_WRE] + (size_t)l * DM * 32}; tr_item(f, DM, (bf16_t*)(C.ws + WS_WR) + (size_t)l * 96 * DM, scr, q / 3, q % 3, lane); }
    }
    conv_run<false>(C, 0, gw, NLAYER * I_PRO, NGW);
    if (C.bid == 0 && C.wave == 0) {
        for (int l = 0; l < NLAYER; ++l) { const int i = C.lane;
            const float s1 = wave_sum(C.in[IN_LQ1][l * 64 + i] * C.in[IN_LK1][l * 64 + i]), s2 = wave_sum(C.in[IN_LQ2][l * 64 + i] * C.in[IN_LK2][l * 64 + i]);
            if (i == 0) ((float*)(C.ws + WS_LAM))[l] = __expf(s1) - __expf(s2) + lam_init_of(l); } }
    float* cosT = (float*)(C.ws + WS_COS); float* sinT = (float*)(C.ws + WS_SIN); const int* pos = (const int*)C.in[IN_POS];
    for (int i = C.bid * 512 + C.tid; i < T * 32; i += C.G * 512) {
        const int tok = i >> 5, fi = i & 31;
        double inv = 1.0; for (int q = 0; q < fi; ++q) inv *= 0.74989420933245582;
        const double rev = (double)pos[tok] * inv * 0.15915494309189535;
        const float fr = (float)(rev - __builtin_floor(rev));
        cosT[i] = __builtin_amdgcn_cosf(fr); sinT[i] = __builtin_amdgcn_sinf(fr);
    }
}

__device__ __forceinline__ void load_starts(Ctx& C, int l) {
    const unsigned* cur = (const unsigned*)(C.ws + WS_CTL) + CW_CUR + l * 32 * 64;
    if (C.tid < NEXP) C.misc[MI_LCNT + C.tid] = (int)__hip_atomic_load(cur + C.tid * 64, __ATOMIC_RELAXED, __HIP_MEMORY_SCOPE_AGENT);
    __syncthreads();
    if (C.tid == 0) { int s = 0, tp = 0;
        for (int e = 0; e < NEXP; ++e) { C.misc[MI_ST + e] = s; C.misc[MI_TP + e] = tp; const int c = C.misc[MI_LCNT + e]; s += c; tp += (c + 255) >> 8; }
        C.misc[MI_ST + NEXP] = s; C.misc[MI_TP + NEXP] = tp; }
    __syncthreads();
}
template <int MODE> __device__ __forceinline__ void phase_norm(Ctx& C, const float* src, float* dsth, const float* g, bf16_t* hn, float* outf) {
    const int gw = C.bid * 8 + C.wave, NGW = C.G * 8, lane = C.lane;
    const bf16_t* YB = (const bf16_t*)(C.ws + WS_PROJ);
    const int* toke = (const int*)(C.ws + WS_TOKE); const int* tokp = (const int*)(C.ws + WS_TOKP);
    int en0 = 0, en1 = 0, pn0 = 0, pn1 = 0;
    if (MODE >= 1 && gw < T) { en0 = toke[2 * gw]; en1 = toke[2 * gw + 1]; pn0 = tokp[2 * gw]; pn1 = tokp[2 * gw + 1]; }
    for (int m = gw; m < T; m += NGW) {
        const f32x4* xr = (const f32x4*)(src + (size_t)m * DM) + lane;
        f32x4 v[8];
#pragma unroll
        for (int j = 0; j < 8; ++j) v[j] = xr[64 * j];
        if (MODE >= 1) {
            const int r0 = C.misc[MI_ST + en0] + pn0, r1 = C.misc[MI_ST + en1] + pn1;
            { const int mn = (m + NGW < T) ? m + NGW : m; en0 = toke[2 * mn]; en1 = toke[2 * mn + 1]; pn0 = tokp[2 * mn]; pn1 = tokp[2 * mn + 1]; }
            const u32x2* y0 = (const u32x2*)(YB + (size_t)r0 * DM) + lane; const u32x2* y1 = (const u32x2*)(YB + (size_t)r1 * DM) + lane;
#pragma unroll
            for (int j = 0; j < 8; ++j) { const u32x2 a = y0[64 * j], b = y1[64 * j];
                v[j][0] += bf2f(a.x & 0xffffu) + bf2f(b.x & 0xffffu); v[j][1] += bf2f(a.x >> 16) + bf2f(b.x >> 16);
                v[j][2] += bf2f(a.y & 0xffffu) + bf2f(b.y & 0xffffu); v[j][3] += bf2f(a.y >> 16) + bf2f(b.y >> 16); }
        }
        if (MODE == 1) { f32x4* hr = (f32x4*)(dsth + (size_t)m * DM) + lane;
#pragma unroll
            for (int j = 0; j < 8; ++j) hr[64 * j] = v[j]; }
        float s = 0.f;
#pragma unroll
        for (int j = 0; j < 8; ++j) s += (v[j][0] * v[j][0] + v[j][1] * v[j][1]) + (v[j][2] * v[j][2] + v[j][3] * v[j][3]);
        const float rs = 1.0f / sqrtf(wave_sum(s) * (1.f / DM) + 1e-6f);
        const f32x4* gr = (const f32x4*)g + lane;
        if (MODE == 2) { f32x4* o = (f32x4*)(outf + (size_t)m * DM) + lane;
#pragma unroll
            for (int j = 0; j < 8; ++j) o[64 * j] = v[j] * rs * gr[64 * j]; }
        else { u32x2* o = (u32x2*)(hn + (size_t)m * DM) + lane;
#pragma unroll
            for (int j = 0; j < 8; ++j) { const f32x4 w = v[j] * rs * gr[64 * j]; u32x2 p; p.x = cvtpk(w[0], w[1]); p.y = cvtpk(w[2], w[3]); o[64 * j] = p; } }
    }
}

__device__ __forceinline__ int crow(int r, int hi) { return (r & 3) + 8 * (r >> 2) + 4 * hi; }
typedef short v4i16_t __attribute__((ext_vector_type(4)));
__device__ __forceinline__ s16x4 vtr(lds_cptr p) { return __builtin_bit_cast(s16x4, __builtin_amdgcn_ds_read_tr16_b64_v4i16((LAS v4i16_t*)p)); }
__device__ __forceinline__ float max3f(float a, float b, float c) { float r; asm("v_max3_f32 %0, %1, %2, %3" : "=v"(r) : "v"(a), "v"(b), "v"(c)); return r; }
__device__ __forceinline__ float swapmax(float v) { auto rr = __builtin_amdgcn_permlane32_swap(__float_as_uint(v), __float_as_uint(v), false, false); return fmaxf(__uint_as_float(rr[0]), __uint_as_float(rr[1])); }
__device__ __forceinline__ float swapsum(float v) { auto rr = __builtin_amdgcn_permlane32_swap(__float_as_uint(v), __float_as_uint(v), false, false); return __uint_as_float(rr[0]) + __uint_as_float(rr[1]); }

template <int NDH, int MASK>
__device__ __forceinline__ void attn_tile(f32x16 (&o)[NDH], float& m, float& l, const bf16x8 (&qr)[4], lds_cptr Kslot, lds_cptr Vslot, LAS float* wsf, int kbase, int qrow, int lane) {
    const int r32 = lane & 31, hi = lane >> 5;
    const lds_cptr kp = Kslot + hi * 1024 + r32 * 16;
    f32x16 p0 = {}, p1 = {};
#pragma unroll
    for (int d0 = 0; d0 < 4; ++d0) {
        const bf16x8 b0 = *(const LAS bf16x8*)(kp + d0 * 2048), b1 = *(const LAS bf16x8*)(kp + d0 * 2048 + 512);
        p0 = __builtin_amdgcn_mfma_f32_32x32x16_bf16(b0, qr[d0], p0, 0, 0, 0);
        p1 = __builtin_amdgcn_mfma_f32_32x32x16_bf16(b1, qr[d0], p1, 0, 0, 0);
    }
    __builtin_amdgcn_sched_barrier(0);
    if (MASK) {
#pragma unroll
        for (int r = 0; r < 16; ++r) {
            const int k0 = kbase + crow(r, hi), k1 = k0 + 32;
            bool v0 = k0 <= qrow, v1 = k1 <= qrow;
            if (MASK == 2) { v0 = v0 && (qrow - k0 < 128); v1 = v1 && (qrow - k1 < 128); }
            p0[r] = v0 ? p0[r] : -__builtin_inff(); p1[r] = v1 ? p1[r] : -__builtin_inff();
        }
    }
    float mx = fmaxf(p0[0], p1[0]);
#pragma unroll
    for (int r = 1; r < 16; ++r) mx = fmaxf(mx, fmaxf(p0[r], p1[r]));
    mx = swapmax(mx);
    const float mn = fmaxf(m, mx);
    const float alpha = __builtin_amdgcn_exp2f(m - mn);
    m = mn;
    float s = 0.f;
#pragma unroll
    for (int r = 0; r < 16; ++r) { p0[r] = __builtin_amdgcn_exp2f(p0[r] - mn); p1[r] = __builtin_amdgcn_exp2f(p1[r] - mn); s += p0[r] + p1[r]; }
    l = l * alpha + s;
    if (__any(alpha != 1.0f)) {
        if (hi == 0) wsf[r32] = alpha;
#pragma unroll
        for (int r = 0; r < 16; ++r) { const float a = wsf[crow(r, hi)];
#pragma unroll
            for (int dh = 0; dh < NDH; ++dh) o[dh][r] *= a; }
    }
    __builtin_amdgcn_sched_barrier(0);
    u32x4 pw[4];
    pw[0] = (u32x4){cvtpk(p0[0], p0[1]), cvtpk(p0[2], p0[3]), cvtpk(p0[4], p0[5]), cvtpk(p0[6], p0[7])};
    pw[1] = (u32x4){cvtpk(p0[8], p0[9]), cvtpk(p0[10], p0[11]), cvtpk(p0[12], p0[13]), cvtpk(p0[14], p0[15])};
    pw[2] = (u32x4){cvtpk(p1[0], p1[1]), cvtpk(p1[2], p1[3]), cvtpk(p1[4], p1[5]), cvtpk(p1[6], p1[7])};
    pw[3] = (u32x4){cvtpk(p1[8], p1[9]), cvtpk(p1[10], p1[11]), cvtpk(p1[12], p1[13]), cvtpk(p1[14], p1[15])};
    __builtin_amdgcn_sched_barrier(0);
    const lds_cptr vp = Vslot + ((lane >> 4) & 1) * 32 + (lane & 3) * 8 + (4 * hi + ((lane & 15) >> 2)) * 64;
#pragma unroll
    for (int dh = 0; dh < NDH; ++dh)
#pragma unroll
        for (int ks = 0; ks < 4; ++ks) {
            const s16x4 lo = vtr(vp + dh * 4096 + ks * 1024), hh = vtr(vp + dh * 4096 + ks * 1024 + 512);
            const bf16x8 vb = (bf16x8){lo[0], lo[1], lo[2], lo[3], hh[0], hh[1], hh[2], hh[3]};
            o[dh] = __builtin_amdgcn_mfma_f32_32x32x16_bf16(__builtin_bit_cast(bf16x8, pw[ks]), vb, o[dh], 0, 0, 0);
            if (ks == 3) __builtin_amdgcn_sched_barrier(0);
        }
}

#define DBAR() asm volatile("s_waitcnt lgkmcnt(0)\n\ts_barrier" ::: "memory")
#define VMWAIT0() asm volatile("s_waitcnt vmcnt(0)" ::: "memory")
__device__ __forceinline__ void glds16(const void* gsrc, unsigned lds_dst) { unsigned keep;
    asm volatile("s_mov_b32 %0, m0\n\ts_mov_b32 m0, %2\n\ts_nop 0\n\tglobal_load_lds_dwordx4 %1, off\n\ts_mov_b32 m0, %0" : "=&s"(keep) : "v"(gsrc), "s"(lds_dst) : "memory"); }
template <int ABL = 0> __device__ __forceinline__ void diff_unit(Ctx& C, int b, int h, int qb, float lam) {
    const int lane = C.lane, wid = C.wave, r32 = lane & 31, hi = lane >> 5, c = wid >> 2, wq = wid & 3;
    const int q0w = qb * 128 + wq * 32, qrow = q0w + r32;
    const char* Pb = (const char*)(C.ws + WS_PROJ) + (size_t)b * SEQ * INC * 2;
    bf16x8 qr[4];
    { const unsigned qo = (unsigned)(((q0w + r32) * INC + C_QC + (2 * h + c) * 64 + hi * 8) * 2);
#pragma unroll
      for (int d0 = 0; d0 < 4; ++d0) qr[d0] = *(const bf16x8*)(Pb + (qo + d0 * 32)); }
    const int NT = 2 * (qb + 1);
    LAS unsigned char* L = C.lds; LAS float* wsf = (LAS float*)(L + LDS_WSF + wid * 256);
    const unsigned kofs = (unsigned)((lane * INC + C_KC + (2 * h) * 64 + wid * 8) * 2);
    const unsigned vofs0 = (unsigned)(((16 * (wid & 3) + (lane >> 2)) * INC + C_VC + h * 128 + (wid >> 2) * 32 + (lane & 3) * 8) * 2);
    const unsigned vofs1 = vofs0 + 64 * 2;
    const int kfo = c * 8192 + hi * 1024 + r32 * 16;
    const int vfo = 16384 + ((lane >> 4) & 1) * 32 + (lane & 3) * 8 + (4 * hi + ((lane & 15) >> 2)) * 64;
    const unsigned ldsw = (unsigned)(uintptr_t)(unsigned char*)L + (unsigned)wid * 1024u;
#define DIFF_DMA(t, bo) do { const char* Pt_ = Pb + (size_t)(t) * (64 * INC * 2); const unsigned d_ = (unsigned)__builtin_amdgcn_readfirstlane(ldsw + (bo)); \
        glds16(Pt_ + kofs, d_); glds16(Pt_ + (kofs + 128), d_ + 8192u); glds16(Pt_ + vofs0, d_ + 16384u); glds16(Pt_ + vofs1, d_ + 24576u); } while (0)
#define DIFF_KF(bo) do { _Pragma("unroll") for (int d0 = 0; d0 < 4; ++d0) { kf[2 * d0] = *(const LAS bf16x8*)(L + (bo) + kfo + d0 * 2048); kf[2 * d0 + 1] = *(const LAS bf16x8*)(L + (bo) + kfo + d0 * 2048 + 512); } } while (0)
#define DIFF_VF(lo_, hi_, bo, dh) do { if ((ABL & 32) && t > 0) break; _Pragma("unroll") for (int ks = 0; ks < 4; ++ks) { lo_[ks] = vtr((lds_cptr)(L + (bo) + vfo + (dh) * 4096 + ks * 1024)); hi_[ks] = vtr((lds_cptr)(L + (bo) + vfo + (dh) * 4096 + ks * 1024 + 512)); } } while (0)
#define DIFF_PV(dh, lo_, hi_) do { _Pragma("unroll") for (int ks = 0; ks < 4; ++ks) { if (ABL & 8) { o[dh][ks] += __builtin_bit_cast(float, (int)lo_[ks][0] | ((int)hi_[ks][1] << 16)) + __builtin_bit_cast(float, pw[ks].x); continue; }  const bf16x8 vb_ = (bf16x8){lo_[ks][0], lo_[ks][1], lo_[ks][2], lo_[ks][3], hi_[ks][0], hi_[ks][1], hi_[ks][2], hi_[ks][3]}; \
        o[dh] = __builtin_amdgcn_mfma_f32_32x32x16_bf16(__builtin_bit_cast(bf16x8, pw[ks]), vb_, o[dh], 0, 0, 0); } } while (0)
    DIFF_DMA(0, 0); DIFF_DMA(1, 32768); if (NT > 2) DIFF_DMA(2, 65536); VMWAIT0();
    DBAR();
    bf16x8 kf[8]; DIFF_KF(0);
    f32x16 o[4]; o[0] = f32x16{}; o[1] = f32x16{}; o[2] = f32x16{}; o[3] = f32x16{};
    float m = 0.f, lsum = 0.f;
    u32x4 pw[4]; s16x4 va_lo[4], va_hi[4], vb_lo[4], vb_hi[4];
    f32x16 negm = f32x16{};
    pw[0] = pw[1] = pw[2] = pw[3] = (u32x4){0u, 0u, 0u, 0u};
    if (c == 1) DBAR();
    int s0 = 0, s1 = 32768, s2 = 65536, s3 = 98304;
#if PROBE >= 201 && PROBE <= 219
    unsigned long long tacc_ = 0, tcnt_ = 0, ts0_, ts1_, ts2_, ts3_, ts4_, tsa_ = 0, tsb_ = 0, tsc_ = 0;
#define STAMP(v) do { v = __builtin_amdgcn_s_memtime(); asm volatile("s_waitcnt lgkmcnt(0)" ::: "memory"); } while (0)
#else
#define STAMP(v) do {} while (0)
#endif
#pragma unroll 1
    for (int t = 0; t < NT; ++t) {
        STAMP(ts0_);
        const int kbase = 64 * t; const bool act = kbase <= q0w + 31;
        if (act) {
            f32x16 p0, p1;
            __builtin_amdgcn_s_setprio(2);
#pragma unroll
            for (int d0 = 0; d0 < 4; ++d0) { if (ABL & 2) { p0[d0] += __builtin_bit_cast(float, (int)kf[2 * d0][0]); p1[d0] += __builtin_bit_cast(float, (int)kf[2 * d0 + 1][1]); }
                else { p0 = __builtin_amdgcn_mfma_f32_32x32x16_bf16(kf[2 * d0], qr[d0], d0 == 0 ? negm : p0, 0, 0, 0); p1 = __builtin_amdgcn_mfma_f32_32x32x16_bf16(kf[2 * d0 + 1], qr[d0], d0 == 0 ? negm : p1, 0, 0, 0); } }
            __builtin_amdgcn_s_setprio(1);
            DIFF_VF(va_lo, va_hi, s0, 0); DIFF_VF(vb_lo, vb_hi, s0, 1);
            asm volatile("s_nop 15\n\ts_nop 7" : "+v"(p0), "+v"(p1));
            if (kbase + 63 > q0w) {
                const int dq = qrow - kbase - 4 * hi;
#pragma unroll
                for (int r = 0; r < 16; ++r) { const int cr = (r & 3) + 8 * (r >> 2); p0[r] = (cr <= dq) ? p0[r] : -__builtin_inff(); p1[r] = (cr + 32 <= dq) ? p1[r] : -__builtin_inff(); }
            }
            if (!(ABL & 4)) {
            float mxa = max3f(p0[0], p0[1], p0[2]), mxb = max3f(p0[3], p0[4], p0[5]), mxc = max3f(p1[0], p1[1], p1[2]), mxd = max3f(p1[3], p1[4], p1[5]);
            mxa = max3f(mxa, p0[6], p0[7]); mxb = max3f(mxb, p0[8], p0[9]); mxc = max3f(mxc, p1[6], p1[7]); mxd = max3f(mxd, p1[8], p1[9]);
            mxa = max3f(mxa, p0[10], p0[11]); mxb = max3f(mxb, p0[12], p0[13]); mxc = max3f(mxc, p1[10], p1[11]); mxd = max3f(mxd, p1[12], p1[13]);
            mxa = max3f(mxa, p0[14], p0[15]); mxc = max3f(mxc, p1[14], p1[15]);
            float mx = max3f(mxa, mxb, fmaxf(mxc, mxd));
            mx = swapmax(mx);
            const bool any_grow = __any(mx > 8.0f) || (t == 0);
            if (any_grow) {
                const float dl = (t == 0) ? mx : fmaxf(mx, 0.f);
                m += dl;
#pragma unroll
                for (int r = 0; r < 16; ++r) { p0[r] -= dl; p1[r] -= dl; negm[r] = -m; }
                const float alpha = __builtin_amdgcn_exp2f(-dl);
                lsum *= alpha;
                if (hi == 0) wsf[r32] = alpha;
#pragma unroll
                for (int r = 0; r < 16; ++r) { const float a = wsf[crow(r, hi)];
#pragma unroll
                    for (int dh = 0; dh < 4; ++dh) o[dh][r] *= a; }
            }
            float sa = 0.f, sb = 0.f, sc = 0.f, sd = 0.f;
#pragma unroll
            for (int r = 0; r < 16; r += 2) { p0[r] = __builtin_amdgcn_exp2f(p0[r]); p0[r + 1] = __builtin_amdgcn_exp2f(p0[r + 1]); p1[r] = __builtin_amdgcn_exp2f(p1[r]); p1[r + 1] = __builtin_amdgcn_exp2f(p1[r + 1]);
                sa += p0[r]; sb += p0[r + 1]; sc += p1[r]; sd += p1[r + 1]; }
            lsum += (sa + sb) + (sc + sd);
            }
            pw[0] = (u32x4){cvtpk(p0[0], p0[1]), cvtpk(p0[2], p0[3]), cvtpk(p0[4], p0[5]), cvtpk(p0[6], p0[7])};
            pw[1] = (u32x4){cvtpk(p0[8], p0[9]), cvtpk(p0[10], p0[11]), cvtpk(p0[12], p0[13]), cvtpk(p0[14], p0[15])};
            pw[2] = (u32x4){cvtpk(p1[0], p1[1]), cvtpk(p1[2], p1[3]), cvtpk(p1[4], p1[5]), cvtpk(p1[6], p1[7])};
            pw[3] = (u32x4){cvtpk(p1[8], p1[9]), cvtpk(p1[10], p1[11]), cvtpk(p1[12], p1[13]), cvtpk(p1[14], p1[15])};
        }
        __builtin_amdgcn_s_setprio(0);
        STAMP(ts1_);
        if (c == 0) { if (t + 2 < NT) asm volatile("s_waitcnt vmcnt(4)" ::: "memory"); else VMWAIT0(); }
        DBAR();
        STAMP(ts2_);
        if (!(ABL & 1)) if (t + 3 < NT) DIFF_DMA(t + 3, s3);
        if (act) {
            DIFF_PV(0, va_lo, va_hi);
            DIFF_VF(va_lo, va_hi, s0, 2);
            DIFF_PV(1, vb_lo, vb_hi);
            DIFF_VF(vb_lo, vb_hi, s0, 3);
            DIFF_PV(2, va_lo, va_hi);
            DIFF_PV(3, vb_lo, vb_hi);
        }
        if (!(ABL & 16) || t == 0) if (t + 1 < NT && kbase + 64 <= q0w + 31) DIFF_KF(s1);
        STAMP(ts3_);
        if (c == 1) { if (t + 3 < NT) asm volatile("s_waitcnt vmcnt(4)" ::: "memory"); else VMWAIT0(); }
        DBAR();
        { const int tmp = s0; s0 = s1; s1 = s2; s2 = s3; s3 = tmp; }
#if PROBE >= 201 && PROBE <= 219
        STAMP(ts4_);
        if (t + 4 < NT) { tcnt_ += 1;
            tacc_ += (PROBE == 201) ? (ts1_ - ts0_) : (PROBE == 202) ? (ts2_ - ts1_) : (PROBE == 203) ? (ts3_ - ts2_) : (PROBE == 204) ? (ts4_ - ts3_) : (ts4_ - ts0_); }
#endif
    }
#if PROBE >= 201 && PROBE <= 219
    if (wid == 0 && lane == 0 && qb == 63 && b == 0 && h == 0 && tcnt_ > 0) *(float*)(C.ws + WS_SGATE + 140 * 1024) = (float)tacc_ / (float)tcnt_;
#endif
    if (c == 0) DBAR();
#undef DIFF_DMA
#undef DIFF_KF
#undef DIFF_VF
#undef DIFF_PV
    lsum = swapsum(lsum);
    if (hi == 0) wsf[r32] = lsum;
    LAS float* X = (LAS float*)L + wq * 4096 + lane;
    if (c == 1) {
#pragma unroll
        for (int r = 0; r < 16; ++r) { const float rl = 1.0f / wsf[crow(r, hi)];
#pragma unroll
            for (int dh = 0; dh < 4; ++dh) X[(dh * 16 + r) * 64] = o[dh][r] * rl; }
    }
    __syncthreads();
    if (c == 0) {
        char* Cb = (char*)(C.ws + (ABL ? WS_XSS : WS_CAT)) + (size_t)b * SEQ * DM * 2;
        const unsigned co = (unsigned)(((q0w + 4 * hi) * DM + 1280 + h * 128 + r32) * 2);
#pragma unroll
        for (int r = 0; r < 16; ++r) {
            const float rl = 1.0f / wsf[crow(r, hi)];
            float s = 0.f;
#pragma unroll
            for (int dh = 0; dh < 4; ++dh) { const float d = o[dh][r] * rl - lam * X[(dh * 16 + r) * 64]; o[dh][r] = d; s += d * d; }
#pragma unroll
            for (int off = 1; off < 32; off <<= 1) s += __shfl_xor(s, off);
            const float rn = 1.0f / sqrtf(s * (1.f / 128.f) + 1e-5f);
            const unsigned ro = co + (unsigned)(((r & 3) + 8 * (r >> 2)) * DM * 2);
#pragma unroll
            for (int dh = 0; dh < 4; ++dh) *(bf16_t*)(Cb + (ro + dh * 64)) = (bf16_t)f2bf(o[dh][r] * rn);
        }
    }
    __syncthreads();
}

__device__ __forceinline__ void swa_task(Ctx& C, int l, int b, int q0, int head, f32x16 (&o)[2], float (&ssq)[16]) {
    const int lane = C.lane, wid = C.wave, r32 = lane & 31, hi = lane >> 5;
    const char* Pb = (const char*)(C.ws + WS_PROJ) + (size_t)b * SEQ * INC * 2;
    LAS unsigned char* Lw = C.lds + wid * 16384; LAS float* wsf = (LAS float*)(C.lds + LDS_WSF + wid * 256);
    const int kvh = head / 3;
    bf16x8 qr[4];
    { const unsigned qo = (unsigned)(((q0 + r32) * INC + C_QA + head * 64 + hi * 8) * 2);
#pragma unroll
      for (int d0 = 0; d0 < 4; ++d0) qr[d0] = *(const bf16x8*)(Pb + (qo + d0 * 32)); }
    o[0] = f32x16{}; o[1] = f32x16{};
    float m = C.in[IN_SINKS][l * 12 + head] * LOG2E, lsum = (hi == 0) ? 1.f : 0.f;
    const int tlo = (q0 >= 127 ? q0 - 127 : 0) >> 6, thi = (q0 + 31) >> 6;
    const unsigned kofs = (unsigned)((lane * INC + C_KA + kvh * 64) * 2);
    const unsigned vofs = (unsigned)(((lane >> 2) * INC + C_VA + kvh * 64 + (lane & 3) * 8) * 2);
    const unsigned ldsw = (unsigned)(uintptr_t)(unsigned char*)Lw;
    for (int t = tlo; t <= thi; ++t) {
        const char* Pt = Pb + (size_t)t * (64 * INC * 2);
        asm volatile("s_waitcnt lgkmcnt(0)" ::: "memory");
#pragma unroll
        for (int c8 = 0; c8 < 8; ++c8) glds16(Pt + (kofs + c8 * 16), (unsigned)__builtin_amdgcn_readfirstlane(ldsw + c8 * 1024));
#pragma unroll
        for (int i = 0; i < 8; ++i) glds16(Pt + (vofs + (16 * (i & 3) * INC + (i >> 2) * 32) * 2), (unsigned)__builtin_amdgcn_readfirstlane(ldsw + 8192 + i * 1024));
        VMWAIT0();
        attn_tile<2, 2>(o, m, lsum, qr, (lds_cptr)Lw, (lds_cptr)(Lw + 8192), wsf, 64 * t, q0 + r32, lane);
    }
    lsum = swapsum(lsum);
    if (hi == 0) wsf[r32] = lsum;
#pragma unroll
    for (int r = 0; r < 16; ++r) { const float rl = 1.0f / wsf[crow(r, hi)]; o[0][r] *= rl; o[1][r] *= rl; float s = o[0][r] * o[0][r] + o[1][r] * o[1][r];
#pragma unroll
        for (int off = 1; off < 32; off <<= 1) s += __shfl_xor(s, off);
        ssq[r] = s; }
}
__device__ __forceinline__ void swa_store(Ctx& C, int b, int q0, int head, const f32x16 (&o)[2]) {
    const int lane = C.lane, r32 = lane & 31, hi = lane >> 5;
    char* Cb = (char*)(C.ws + WS_CAT) + (size_t)b * SEQ * DM * 2; const LAS float* tot = (const LAS float*)(C.misc + MI_SSQ) + 12 * 32;
    const unsigned co = (unsigned)(((q0 + 4 * hi) * DM + head * 64 + r32) * 2);
#pragma unroll
    for (int r = 0; r < 16; ++r) { const int qq = (r & 3) + 8 * (r >> 2); const float rn = tot[qq + 4 * hi];
        const unsigned ro = co + (unsigned)(qq * DM * 2);
        *(bf16_t*)(Cb + ro) = (bf16_t)f2bf(o[0][r] * rn); *(bf16_t*)(Cb + (ro + 64)) = (bf16_t)f2bf(o[1][r] * rn); }
}
__device__ __forceinline__ void swa_unit(Ctx& C, int l, int b, int jb) {
    const int lane = C.lane, wid = C.wave, r32 = lane & 31, hi = lane >> 5;
    const int q0 = jb * 32;
    LAS float* ssqL = (LAS float*)(C.misc + MI_SSQ);
    f32x16 oa[2], ob[2]; float sa[16], sb[16];
    swa_task(C, l, b, q0, wid, oa, sa);
    if (r32 == 0) {
#pragma unroll
        for (int r = 0; r < 16; ++r) ssqL[wid * 32 + crow(r, hi)] = sa[r]; }
    if (wid < 4) {
        swa_task(C, l, b, q0, 8 + wid, ob, sb);
        if (r32 == 0) {
#pragma unroll
            for (int r = 0; r < 16; ++r) ssqL[(8 + wid) * 32 + crow(r, hi)] = sb[r]; }
    }
    __syncthreads();
    if (C.tid < 32) { float s = 0.f;
#pragma unroll
        for (int hh = 0; hh < 12; ++hh) s += ssqL[hh * 32 + C.tid];
        ssqL[12 * 32 + C.tid] = 1.0f / sqrtf(s * (1.f / 768.f) + 1e-6f); }
    __syncthreads();
    swa_store(C, b, q0, wid, oa);
    if (wid < 4) swa_store(C, b, q0, 8 + wid, ob);
    __syncthreads();
}

__device__ __forceinline__ void pool_unit(Ctx& C, int b, int blk) {
    const int tid = C.tid, s0 = blk * 32;
    const char* Pb = (const char*)(C.ws + WS_PROJ) + (size_t)b * SEQ * INC * 2 + C_UB * 2;
    LAS unsigned char* L = C.lds;
    const int r0 = s0 >= 15 ? s0 - 15 : 0, nrows = s0 + 32 - r0;
    for (int i = tid; i < nrows * 64; i += 512) { const int rr = i >> 6, ch = i & 63;
        *(LAS u32x4*)(L + rr * 1040 + ch * 16) = *(const u32x4*)(Pb + (size_t)(r0 + rr) * (INC * 2) + ch * 16); }
    __syncthreads();
    const int cg8 = tid & 63, ts = tid >> 6, w = 2 << (cg8 >> 4);
    char* Cb = (char*)(C.ws + WS_CAT) + (size_t)b * SEQ * DM * 2 + (768 + 8 * cg8) * 2;
#pragma unroll 1
    for (int i = 0; i < 4; ++i) {
        const int s = s0 + ts * 4 + i, lo = (s - w + 1) > 0 ? (s - w + 1) : 0;
        float acc[8];
#pragma unroll
        for (int j = 0; j < 8; ++j) acc[j] = 0.f;
        u32x4 self = {0, 0, 0, 0};
        for (int sp = lo; sp <= s; ++sp) { const u32x4 v = *(const LAS u32x4*)(L + (sp - r0) * 1040 + cg8 * 16); self = v;
            acc[0] += bf2f(v.x & 0xffffu); acc[1] += bf2f(v.x >> 16); acc[2] += bf2f(v.y & 0xffffu); acc[3] += bf2f(v.y >> 16);
            acc[4] += bf2f(v.z & 0xffffu); acc[5] += bf2f(v.z >> 16); acc[6] += bf2f(v.w & 0xffffu); acc[7] += bf2f(v.w >> 16); }
        const float rc = 1.0f / (float)(s - lo + 1);
        u32x4 ov;
        ov.x = pk2(acc[0] * rc - bf2f(self.x & 0xffffu), acc[1] * rc - bf2f(self.x >> 16)); ov.y = pk2(acc[2] * rc - bf2f(self.y & 0xffffu), acc[3] * rc - bf2f(self.y >> 16));
        ov.z = pk2(acc[4] * rc - bf2f(self.z & 0xffffu), acc[5] * rc - bf2f(self.z >> 16)); ov.w = pk2(acc[6] * rc - bf2f(self.w & 0xffffu), acc[7] * rc - bf2f(self.w >> 16));
        *(u32x4*)(Cb + (size_t)s * (DM * 2)) = ov;
    }
    __syncthreads();
}

#ifndef MIXSELDEF
#define MIXSELDEF 15
#endif
#ifndef MIXSEL
#define MIXSEL 7
#endif
constexpr int NU_DIFF = 2 * 6 * 64, NU_SWA = 2 * 256, NU_POOL = 2 * 256, NU_CONV = 512, CONV_PER = I_EXP / NU_CONV;
constexpr int NU_MIX = NU_DIFF + NU_CONV + NU_SWA + NU_POOL;
static_assert(I_EXP % NU_CONV == 0 && NU_DIFF * 2 == NU_CONV * 3, "queue interleave: 3 attention units : 2 conversion units");
__device__ __forceinline__ void conv_unit(Ctx& C, int l, int j) {
    conv_run<true>(C, l, j * CONV_PER + C.wave, (j + 1) * CONV_PER, 8);
    asm volatile("s_waitcnt vmcnt(0) lgkmcnt(0)" ::: "memory");
    __syncthreads();
}
template <int ABL = 0> __device__ __forceinline__ void phase_mixers(Ctx& C, int l, int qslot = -1, int sel = MIXSELDEF) {
    const float lam = ((const float*)(C.ws + WS_LAM))[l];
    unsigned* qctr = (unsigned*)(C.ws + WS_CTL) + CW_QCTR + 64 * (qslot < 0 ? l : qslot);
    int unext = 0;
    if (C.tid == 0) unext = (int)__hip_atomic_fetch_add(qctr, 1u, __ATOMIC_RELAXED, __HIP_MEMORY_SCOPE_AGENT);
    for (;;) {
        if (C.tid == 0) { C.misc[0] = unext; unext = (int)__hip_atomic_fetch_add(qctr, 1u, __ATOMIC_RELAXED, __HIP_MEMORY_SCOPE_AGENT); }
        __syncthreads();
        const int u = C.misc[0];
        __syncthreads();
        if (u >= NU_MIX) break;
        { int l_ = C.lane; asm volatile("" : "+v"(l_)); C.lane = l_; C.tid = C.wave * 64 + l_; }
        if (u < NU_DIFF + NU_CONV) { const int grp = u / 5, k5 = u % 5;
            if (k5 < 3) { if (sel & 1) { const int ud = grp * 3 + k5, qb = 63 - ud / 12, bh = ud % 12; diff_unit<ABL>(C, bh / 6, bh % 6, qb, lam); } }
            else { if (sel & 8) conv_unit(C, l, grp * 2 + (k5 - 3)); } }
        else if (u < NU_DIFF + NU_CONV + NU_SWA) { if (sel & 2) { const int v = u - NU_DIFF - NU_CONV; swa_unit(C, l, v >> 8, v & 255); } }
        else { if (sel & 4) { const int v = u - NU_DIFF - NU_CONV - NU_SWA; pool_unit(C, v >> 8, v & 255); } }
    }
}

constexpr int XT_PITCH = 4112;
__device__ __forceinline__ void phase_router(Ctx& C, int l) {
    const int lane = C.lane, wid = C.wave, tid = C.tid;
    const float* h = C.out; const float* g = C.in[IN_FNORM] + l * DM;
    bf16_t* XS = (bf16_t*)(C.ws + WS_HN); const bf16_t* WR = (const bf16_t*)(C.ws + WS_WR) + (size_t)l * 96 * DM;
    unsigned* cur = (unsigned*)(C.ws + WS_CTL) + CW_CUR + l * 32 * 64;
    int* toke = (int*)(C.ws + WS_TOKE); float* tokg = (float*)(C.ws + WS_TOKG); int* tokp = (int*)(C.ws + WS_TOKP);
    int* rowtok = (int*)(C.ws + WS_ROWTOK); float* rowgate = (float*)(C.ws + WS_ROWGATE);
    LAS unsigned char* L = C.lds;
    for (int unit = C.bid; unit < T / 32; unit += C.G) {
        const int tok0 = unit * 32;
        {
            f32x4 v[4][8];
#pragma unroll
            for (int rr = 0; rr < 4; ++rr) { const f32x4* xr = (const f32x4*)(h + ((size_t)tok0 + wid * 4 + rr) * DM) + lane;
#pragma unroll
                for (int j = 0; j < 8; ++j) v[rr][j] = xr[64 * j]; }
            const f32x4* gr = (const f32x4*)g + lane;
#pragma unroll
            for (int rr = 0; rr < 4; ++rr) {
                const int row = wid * 4 + rr; const size_t m = (size_t)tok0 + row; float s = 0.f;
#pragma unroll
                for (int j = 0; j < 8; ++j) s += (v[rr][j][0] * v[rr][j][0] + v[rr][j][1] * v[rr][j][1]) + (v[rr][j][2] * v[rr][j][2] + v[rr][j][3] * v[rr][j][3]);
                const float rs = 1.0f / sqrtf(wave_sum(s) * (1.f / DM) + 1e-6f);
                u32x2* o = (u32x2*)(XS + m * DM) + lane;
#pragma unroll
                for (int j = 0; j < 8; ++j) { const f32x4 w = v[rr][j] * rs * gr[64 * j]; u32x2 p; p.x = cvtpk(w[0], w[1]); p.y = cvtpk(w[2], w[3]); o[64 * j] = p;
                    *(LAS u32x2*)(L + row * XT_PITCH + (4 * lane + 256 * j) * 2) = p; }
            }
        }
        if (tid < 32) C.misc[MI_LCNT + tid] = 0;
        __syncthreads();
        f32x4 acc[2][3];
#pragma unroll
        for (int rt = 0; rt < 2; ++rt)
#pragma unroll
            for (int ct = 0; ct < 3; ++ct) acc[rt][ct] = (f32x4){0.f, 0.f, 0.f, 0.f};
#pragma unroll 4
        for (int ks = 0; ks < 8; ++ks) {
            const int kk = 256 * wid + 32 * ks + 8 * (lane >> 4);
            bf16x8 a[2];
#pragma unroll
            for (int rt = 0; rt < 2; ++rt) a[rt] = *(const LAS bf16x8*)(L + (16 * rt + (lane & 15)) * XT_PITCH + kk * 2);
#pragma unroll
            for (int ct = 0; ct < 3; ++ct)
#pragma unroll
                for (int hl = 0; hl < 2; ++hl) {
                    const bf16x8 bb = *(const bf16x8*)(WR + (size_t)(hl * 48 + 16 * ct + (lane & 15)) * DM + kk);
#pragma unroll
                    for (int rt = 0; rt < 2; ++rt) acc[rt][ct] = __builtin_amdgcn_mfma_f32_16x16x32_bf16(a[rt], bb, acc[rt][ct], 0, 0, 0);
                }
        }
        __syncthreads();
        LAS float* RED = (LAS float*)L;
#pragma unroll
        for (int rt = 0; rt < 2; ++rt)
#pragma unroll
            for (int ct = 0; ct < 3; ++ct)
#pragma unroll
                for (int q = 0; q < 4; ++q) RED[(wid * 32 + 16 * rt + 4 * (lane >> 4) + q) * 48 + 16 * ct + (lane & 15)] = acc[rt][ct][q];
        __syncthreads();
        LAS float* LG = RED + 8 * 32 * 48;
        for (int i = tid; i < 32 * 48; i += 512) { float sacc = 0.f;
#pragma unroll
            for (int w8 = 0; w8 < 8; ++w8) sacc += RED[w8 * 32 * 48 + i];
            LG[i] = sacc; }
        __syncthreads();
        int e0 = 0, e1 = 0, rk0 = 0, rk1 = 0; float g0 = 0.f, g1 = 0.f;
        if (tid < 32) {
            const LAS float* lg = LG + tid * 48;
            const float* brg = C.in[IN_BRG] + l * 4; const float* bre = C.in[IN_BRE] + l * 32;
            float gl[4]; int gsel = 0; float gm = -__builtin_inff();
#pragma unroll
            for (int j = 0; j < 4; ++j) { gl[j] = lg[j] + brg[j]; if (gl[j] > gm) { gm = gl[j]; gsel = j; } }
            float gs = 0.f;
#pragma unroll
            for (int j = 0; j < 4; ++j) gs += __expf(gl[j] - gm);
            const float pgsel = 1.0f / gs;
            float le[8];
#pragma unroll
            for (int j = 0; j < 8; ++j) le[j] = lg[4 + gsel * 8 + j] + bre[gsel * 8 + j];
            int i0 = 0; float m0 = le[0];
#pragma unroll
            for (int j = 1; j < 8; ++j) if (le[j] > m0) { m0 = le[j]; i0 = j; }
            int i1 = -1; float m1 = -__builtin_inff();
#pragma unroll
            for (int j = 0; j < 8; ++j) if (j != i0 && le[j] > m1) { m1 = le[j]; i1 = j; }
            const float p1 = __expf(m1 - m0), den = 1.0f / (1.0f + p1);
            g0 = pgsel * den; g1 = pgsel * p1 * den;
            e0 = gsel * 8 + i0; e1 = gsel * 8 + i1;
            rk0 = __hip_atomic_fetch_add((LAS int*)(C.misc + MI_LCNT) + e0, 1, __ATOMIC_RELAXED, __HIP_MEMORY_SCOPE_WORKGROUP);
            rk1 = __hip_atomic_fetch_add((LAS int*)(C.misc + MI_LCNT) + e1, 1, __ATOMIC_RELAXED, __HIP_MEMORY_SCOPE_WORKGROUP);
        }
        __syncthreads();
        if (tid < 32) { const int c = C.misc[MI_LCNT + tid]; C.misc[MI_LBASE + tid] = c ? (int)__hip_atomic_fetch_add(cur + tid * 64, (unsigned)c, __ATOMIC_RELAXED, __HIP_MEMORY_SCOPE_AGENT) : 0; }
        __syncthreads();
        if (tid < 32) {
            const int t = tok0 + tid; const int p0 = C.misc[MI_LBASE + e0] + rk0, p1 = C.misc[MI_LBASE + e1] + rk1;
            toke[2 * t] = e0; toke[2 * t + 1] = e1; tokg[2 * t] = g0; tokg[2 * t + 1] = g1; tokp[2 * t] = p0; tokp[2 * t + 1] = p1;
            rowtok[e0 * T + p0] = t; rowtok[e1 * T + p1] = t; rowgate[e0 * T + p0] = g0; rowgate[e1 * T + p1] = g1;
        }
        __syncthreads();
    }
}

__device__ __forceinline__ void phase_gather(Ctx& C, int l) {
    load_starts(C, l);
    const int gw = C.bid * 8 + C.wave, NGW = C.G * 8, lane = C.lane;
    const bf16_t* XS = (const bf16_t*)(C.ws + WS_HN); bf16_t* XSS = (bf16_t*)(C.ws + WS_XSS);
    const int* rowtok = (const int*)(C.ws + WS_ROWTOK); const float* rowgate = (const float*)(C.ws + WS_ROWGATE); float* sgate = (float*)(C.ws + WS_SGATE);
    for (int ci = gw; ci < NASSIGN; ci += NGW) {
        int e = 0;
        while (e < 31 && C.misc[MI_ST + e + 1] <= ci) ++e;
        const int pos = ci - C.misc[MI_ST + e]; const int tok = rowtok[e * T + pos];
        const u32x4* s = (const u32x4*)(XS + (size_t)tok * DM) + lane; u32x4* d = (u32x4*)(XSS + (size_t)ci * DM) + lane;
        const u32x4 a0 = s[0], a1 = s[64], a2 = s[128], a3 = s[192];
        d[0] = a0; d[64] = a1; d[128] = a2; d[192] = a3;
        if (lane == 0) sgate[ci] = rowgate[e * T + pos];
    }
}

#define XB_TMO      128
#define XB_XCNT(j)  (256  + 64 * (j))
#define XB_XSUB(j)  (1280 + 64 * (j))
#define XB_XGEN(j)  (2304 + 64 * (j))
#define XB_TOP      3328
#define XB_TOPGEN   3392
#define XCD_BAR_WORDS 3456
#define XB_SPIN_CAP (1u << 18)

__device__ __forceinline__ unsigned xb_ld(unsigned* p)              { return __hip_atomic_load(p, __ATOMIC_RELAXED, __HIP_MEMORY_SCOPE_AGENT); }
__device__ __forceinline__ unsigned xb_add(unsigned* p, unsigned v) { return __hip_atomic_fetch_add(p, v, __ATOMIC_RELAXED, __HIP_MEMORY_SCOPE_AGENT); }
__device__ __forceinline__ unsigned xb_xcc_id() { return (unsigned)__builtin_amdgcn_s_getreg((3 << 11) | 20) & 0xFu; }
#define XB_SPIN(cond, bar) do { unsigned _sp = 0; while (cond) { __builtin_amdgcn_s_sleep(1); \
    if ((++_sp & 255u) == 0u) { if (xb_ld(&(bar)[XB_TMO])) break; if (_sp > XB_SPIN_CAP) { atomicAdd(&(bar)[XB_TMO], 1u); break; } } } } while (0)

__device__ __forceinline__ int lane_id_v() { int l; asm volatile("v_mbcnt_lo_u32_b32 %0, -1, 0\n\tv_mbcnt_hi_u32_b32 %0, -1, %0" : "=v"(l)); return l; }
struct XcdBarrier {
    int wv;
    unsigned* bar; unsigned x;
    volatile LAS unsigned* st;
};

__device__ __forceinline__ XcdBarrier xcd_barrier_post(unsigned* bar, volatile LAS unsigned* st) {
    XcdBarrier b; b.bar = bar; b.x = xb_xcc_id(); b.st = st;
    if (threadIdx.x == 0) (void)xb_add(&bar[XB_XCNT(b.x)], 1u);
    return b;
}
__device__ __forceinline__ void xcd_barrier_complete(unsigned* bar, unsigned x, unsigned& nloc, unsigned& nx) {
    const unsigned G = gridDim.x * gridDim.y * gridDim.z;
    unsigned sum, cnt, mine, sp = 0u;
    for (;;) {
        sum = 0u; cnt = 0u; mine = 0u;
#pragma unroll 1
        for (unsigned j = 0; j < 16; ++j) { const unsigned c = xb_ld(&bar[XB_XCNT(j)]); sum += c; cnt += (c > 0u) ? 1u : 0u; mine = (j == x) ? c : mine; }
        if (sum == G) break;
        __builtin_amdgcn_s_sleep(1);
        if ((++sp & 255u) == 0u) { if (xb_ld(&bar[XB_TMO])) break; if (sp > XB_SPIN_CAP) { atomicAdd(&bar[XB_TMO], 1u); break; } }
    }
    nloc = mine > 0u ? mine : 1u; nx = cnt > 0u ? cnt : 1u;
}

__device__ __forceinline__ void xcd_barrier(const XcdBarrier& b) {
    asm volatile("s_waitcnt vmcnt(0)" ::: "memory");
    __syncthreads();
    if (b.wv == 0 && lane_id_v() == 0) {
        unsigned* bar = b.bar; unsigned bx = b.x;
        asm volatile("" : "+s"(bar), "+s"(bx));
        __builtin_amdgcn_s_waitcnt(0);
        unsigned nloc = b.st[0], nx = b.st[1];
        if (nloc == 0u) { xcd_barrier_complete(bar, bx, nloc, nx); b.st[0] = nloc; b.st[1] = nx; }
        const unsigned old = xb_add(&bar[XB_XSUB(bx)], 1u);
        const unsigned gen = old / nloc;
        if (old + 1u == (gen + 1u) * nloc) {
            __builtin_amdgcn_fence(__ATOMIC_RELEASE, "agent");
            asm volatile("s_waitcnt vmcnt(0)" ::: "memory");
            const unsigned og = xb_add(&bar[XB_TOP], 1u);
            const unsigned tg = og / nx;
            if (og + 1u == (tg + 1u) * nx) xb_add(&bar[XB_TOPGEN], 1u);
            else XB_SPIN(xb_ld(&bar[XB_TOPGEN]) == tg, bar);
            __builtin_amdgcn_fence(__ATOMIC_ACQUIRE, "agent");
            xb_add(&bar[XB_XGEN(bx)], 1u);
            asm volatile("s_waitcnt vmcnt(0)" ::: "memory");
        } else {
            XB_SPIN(xb_ld(&bar[XB_XGEN(bx)]) == gen, bar);
            __builtin_amdgcn_fence(__ATOMIC_ACQUIRE, "agent");
            asm volatile("s_waitcnt vmcnt(0)" ::: "memory");
        }
    }
    __syncthreads();
}


#ifndef PHASE_MASK
#define PHASE_MASK 0x3ff
#endif
#define HAS(k) (((PHASE_MASK) >> (k)) & 1)
struct Args { const float* in[23]; float* out; unsigned char* ws; int ph_lo, ph_hi; };
constexpr int N_PHASES = 18;

__global__ void __launch_bounds__(512, 2) mega_fwd(Args args) {
    extern __shared__ __attribute__((aligned(16))) unsigned char lds_raw[];
    cg::grid_group grid = cg::this_grid();
    Ctx C;
    C.lds = (LAS unsigned char*)lds_raw; C.misc = (volatile LAS int*)(C.lds + LDS_MISC);
    const int wv0 = __builtin_amdgcn_readfirstlane((int)threadIdx.x >> 6);
    C.tid = threadIdx.x; C.lane = C.tid & 63; C.wave = wv0; C.G = gridDim.x; C.bid = blockIdx.x;
    const int lo = args.ph_lo, hi = args.ph_hi;
    if (threadIdx.x < 64) ((volatile LAS int*)(C.lds + LDS_MISC))[threadIdx.x] = 0;
    __syncthreads();
    XcdBarrier xbar = xcd_barrier_post((unsigned*)(args.ws + WS_CTL) + CW_BAR, (volatile LAS unsigned*)(C.lds + LDS_MISC) + 8);
    xbar.wv = wv0;
    typedef const Args __attribute__((address_space(4)))* KArgP;
#define CTX_REFRESH() do { KArgP ka_ = (KArgP)__builtin_amdgcn_kernarg_segment_ptr(); asm volatile("" : "+s"(ka_)); \
        _Pragma("unroll") for (int i_ = 0; i_ < 23; ++i_) C.in[i_] = ka_->in[i_]; C.out = ka_->out; C.ws = ka_->ws; \
        int w_ = wv0; asm volatile("" : "+s"(w_)); int l_ = lane_id_v(); asm volatile("" : "+v"(l_)); C.wave = w_; C.lane = l_; C.tid = w_ * 64 + l_; } while (0)
#if MK_PER_PHASE
#define IN(k) (lo <= (k) && (k) < hi)
#else
#define IN(k) true
#endif
#define XBAR() do { xbar.bar = (unsigned*)(C.ws + WS_CTL) + CW_BAR; xcd_barrier(xbar); } while (0)
#define SEAM(k) do { if (IN(k) && IN((k) + 1)) XBAR(); } while (0)
#define HN ((bf16_t*)(C.ws + WS_HN))
#define PROJ ((bf16_t*)(C.ws + WS_PROJ))
#define CAT ((bf16_t*)(C.ws + WS_CAT))
#define XSS ((bf16_t*)(C.ws + WS_XSS))
#define ACT ((bf16_t*)(C.ws + WS_ACT))
#define YB ((bf16_t*)(C.ws + WS_PROJ))

#if PROBE >= 300 && PROBE < 400
    unsigned long long ptacc_ = 0, pt0_ = __builtin_amdgcn_s_memrealtime();
#define PH_END(id) do { const unsigned long long n_ = __builtin_amdgcn_s_memrealtime(); if ((PROBE - 300) == (id)) ptacc_ += n_ - pt0_; pt0_ = n_; } while (0)
#else
#define PH_END(id) do {} while (0)
#endif
    if (lo == 0x7fffffff) grid.sync();
    if (HAS(0) && IN(0)) { CTX_REFRESH(); phase_prologue(C); phase_norm<0>(C, C.in[IN_X], nullptr, C.in[IN_ANORM], HN, nullptr); } SEAM(0); PH_END(0);
    if (PROBE == 1) { CTX_REFRESH(); phase_prologue(C); XBAR(); }
    for (int l = 0; l < NLAYER; ++l) {
        const int p0 = 1 + 8 * l;
        if (HAS(1) && IN(p0 + 0)) { CTX_REFRESH();
            if (l > 0) { load_starts(C, l - 1); phase_norm<1>(C, C.out, C.out, C.in[IN_ANORM] + l * DM, HN, nullptr); }
        } if (l > 0) SEAM(p0 + 0); PH_END(p0 + 0);
        if (PROBE == 8 && l == 0) { CTX_REFRESH(); phase_norm<0>(C, C.in[IN_X], nullptr, C.in[IN_ANORM], HN, nullptr); XBAR(); }
        if (HAS(2) && IN(p0 + 1)) { CTX_REFRESH();
            pg8::Gemm g{HN, (const bf16_t*)(C.ws + WS_WIN) + (size_t)l * INC * DM, T, INC, DM}; pg8::StaticOrder S; S.init(T, INC, C.G, C.bid);
            EpiProj E{PROJ, (const float*)(C.ws + WS_COS), (const float*)(C.ws + WS_SIN)};
            pg8::gemm_phase<EpiProj, pg8::StaticOrder, true, true>(C.lds, g, S, E, C.tid);
        } SEAM(p0 + 1); PH_END(p0 + 1);
        if (PROBE == 2 && l == 0) { CTX_REFRESH();
            pg8::Gemm g{HN, (const bf16_t*)(C.ws + WS_WIN) + (size_t)l * INC * DM, T, INC, DM}; pg8::StaticOrder S; S.init(T, INC, C.G, C.bid);
            EpiProj E{PROJ, (const float*)(C.ws + WS_COS), (const float*)(C.ws + WS_SIN)};
            pg8::gemm_phase<EpiProj, pg8::StaticOrder, true, true>(C.lds, g, S, E, C.tid); XBAR(); }
        if (HAS(3) && IN(p0 + 2)) { CTX_REFRESH(); phase_mixers(C, l); } SEAM(p0 + 2); PH_END(p0 + 2);
        if (PROBE >= 30 && PROBE <= 37 && l == 0) { CTX_REFRESH(); phase_mixers(C, l, 2, PROBE - 30); XBAR(); }
#if PROBE >= 100 && PROBE < 200
        if (l == 0) { CTX_REFRESH(); phase_mixers<128 | (PROBE - 100)>(C, l, 2, 1); XBAR(); }
#endif
        if (HAS(4) && IN(p0 + 3)) { CTX_REFRESH();
            pg8::Gemm g{CAT, (const bf16_t*)(C.ws + WS_WOUT) + (size_t)l * DM * DM, T, DM, DM}; pg8::StaticOrder S; S.init(T, DM, C.G, C.bid);
            EpiResid E{l == 0 ? C.in[IN_X] : C.out, C.out};
            pg8::gemm_phase<EpiResid, pg8::StaticOrder, true, true>(C.lds, g, S, E, C.tid);
        } SEAM(p0 + 3); PH_END(p0 + 3);
        if (PROBE == 4 && l == 0) { CTX_REFRESH();
            pg8::Gemm g{CAT, (const bf16_t*)(C.ws + WS_WOUT) + (size_t)l * DM * DM, T, DM, DM}; pg8::StaticOrder S; S.init(T, DM, C.G, C.bid);
            EpiResid E{C.in[IN_X], C.out};
            pg8::gemm_phase<EpiResid, pg8::StaticOrder, true, true>(C.lds, g, S, E, C.tid); XBAR(); }
        if (HAS(5) && IN(p0 + 4)) { CTX_REFRESH(); phase_router(C, l); } SEAM(p0 + 4); PH_END(p0 + 4);
        if (HAS(7) && IN(p0 + 6)) { CTX_REFRESH();
            load_starts(C, l);
            pg8::Gemm g{HN, (const bf16_t*)(C.ws + WS_WGU) + (size_t)l * NEXP * 1024 * DM, T, 1024, DM};
            pg8::MoeOrder S{(const LAS int*)(C.lds + LDS_MISC) + MI_ST, (const LAS int*)(C.lds + LDS_MISC) + MI_TP, 4, 1024, C.G, C.bid};
            LAS int* tk = (LAS int*)(C.lds + LDS_MISC + 4096);
            { const int* rowtok = (const int*)(C.ws + WS_ROWTOK);
#pragma unroll 1
              for (int i = 0; i < 6; ++i) { Unit u; if (!S.next(i, u)) break; if (C.tid < 256) tk[i * 256 + C.tid] = (C.tid < u.valid) ? rowtok[u.e * T + u.pm * 256 + C.tid] : 0; }
              __syncthreads(); }
            EpiGU E{ACT};
            pg8::gemm_phase<EpiGU, pg8::MoeOrder, true, true, true>(C.lds, g, S, E, C.tid, (const LAS int*)tk);
        } SEAM(p0 + 6); PH_END(p0 + 6);
        if (HAS(8) && IN(p0 + 7)) { CTX_REFRESH();
            load_starts(C, l);
            pg8::Gemm g{ACT, (const bf16_t*)(C.ws + WS_WDN) + (size_t)l * NEXP * DM * DFF, NASSIGN, DM, DFF};
            pg8::MoeOrder S{(const LAS int*)(C.lds + LDS_MISC) + MI_ST, (const LAS int*)(C.lds + LDS_MISC) + MI_TP, 8, DM, C.G, C.bid};
            EpiDown E{YB, (const float*)(C.ws + WS_ROWGATE)};
            pg8::gemm_phase<EpiDown, pg8::MoeOrder, true, true>(C.lds, g, S, E, C.tid);
        } SEAM(p0 + 7); PH_END(p0 + 7);
        if (PROBE == 7 && l == 0) { CTX_REFRESH();
            load_starts(C, l);
            pg8::Gemm g{ACT, (const bf16_t*)(C.ws + WS_WDN) + (size_t)l * NEXP * DM * DFF, NASSIGN, DM, DFF};
            pg8::MoeOrder S{(const LAS int*)(C.lds + LDS_MISC) + MI_ST, (const LAS int*)(C.lds + LDS_MISC) + MI_TP, 8, DM, C.G, C.bid};
            EpiDown E{YB, (const float*)(C.ws + WS_ROWGATE)};
            pg8::gemm_phase<EpiDown, pg8::MoeOrder, true, true>(C.lds, g, S, E, C.tid); XBAR(); }
    }
    if (HAS(9) && IN(17)) { CTX_REFRESH(); load_starts(C, NLAYER - 1); phase_norm<2>(C, C.out, nullptr, C.in[IN_FINAL], nullptr, C.out); }
#if PROBE >= 300 && PROBE < 400
    PH_END(17);
    if (C.bid == 0 && C.wave == 0 && C.lane == 0) { const unsigned long long t0_ = __builtin_amdgcn_s_memrealtime(); while (__builtin_amdgcn_s_memrealtime() - t0_ < ptacc_) __builtin_amdgcn_s_sleep(8); }
#endif
#if PROBE >= 201 && PROBE <= 219
    if (C.bid == 0 && C.tid == 0) { const float v_ = *(volatile float*)(C.ws + WS_SGATE + 140 * 1024); const unsigned long long t0_ = __builtin_amdgcn_s_memrealtime(), dt_ = (unsigned long long)(v_ * 10.f);
        while (__builtin_amdgcn_s_memrealtime() - t0_ < dt_) __builtin_amdgcn_s_sleep(8); }
#endif
#undef IN
#undef SEAM
#undef HN
#undef PROJ
#undef CAT
#undef XSS
#undef ACT
#undef YB
}

extern "C" void kernel_launch(void* const* d_in, const int* in_sizes, int n_in, void* d_out, int out_size, void* d_ws, size_t ws_size, hipStream_t stream) {
    static int grid = 0;
    if (grid == 0) {
        if (n_in != 23 || in_sizes[0] != T * DM || out_size != T * DM || ws_size < WS_END) { fprintf(stderr, "kernel_launch: unexpected shapes (n_in %d, in0 %d, out %d, ws %zu < %zu)\n", n_in, n_in > 0 ? in_sizes[0] : -1, out_size, ws_size, (size_t)WS_END); grid = -1; return; }
        int dev = 0, cus = 0, per_cu = 0;
        hipGetDevice(&dev); hipDeviceGetAttribute(&cus, hipDeviceAttributeMultiprocessorCount, dev);
        if (hipFuncSetAttribute((const void*)mega_fwd, hipFuncAttributeMaxDynamicSharedMemorySize, LDS_BYTES) != hipSuccess) { fprintf(stderr, "kernel_launch: hipFuncSetAttribute failed\n"); grid = -1; return; }
        if (hipOccupancyMaxActiveBlocksPerMultiprocessor(&per_cu, (const void*)mega_fwd, 512, LDS_BYTES) != hipSuccess || per_cu < 1) { fprintf(stderr, "kernel_launch: occupancy query says %d blocks per CU\n", per_cu); per_cu = 1; }
        (void)hipGetLastError();
        grid = cus * 1;
        fprintf(stderr, "kernel_launch: %d CUs, occupancy %d/CU, grid %d\n", cus, per_cu, grid);
    }
    if (grid < 0) return;
    hipMemsetAsync((char*)d_ws + WS_CTL, 0, CTL_ZERO_BYTES, stream);
    Args a{};
    for (int i = 0; i < 23; ++i) a.in[i] = (const float*)d_in[i];
    a.out = (float*)d_out; a.ws = (unsigned char*)d_ws;
#if MK_PER_PHASE
    for (int p = 0; p < N_PHASES; ++p) {
        a.ph_lo = p; a.ph_hi = p + 1; void* kargs[] = {&a};
        hipError_t e = hipLaunchCooperativeKernel((const void*)mega_fwd, dim3(grid), dim3(512), kargs, LDS_BYTES, stream);
        if (e != hipSuccess) { fprintf(stderr, "launch of phase %d failed: %s\n", p, hipGetErrorString(e)); break; }
    }
#else
    a.ph_lo = 0; a.ph_hi = N_PHASES; void* kargs[] = {&a};
    hipError_t e = hipLaunchCooperativeKernel((const void*)mega_fwd, dim3(grid), dim3(512), kargs, LDS_BYTES, stream);
    if (e != hipSuccess) fprintf(stderr, "cooperative launch failed: %s (grid %d)\n", hipGetErrorString(e), grid);
#endif
}
```

```cpp
#include <hip/hip_runtime.h>
#include <hip/hip_cooperative_groups.h>
#include <cstdio>
#include <cstdint>
namespace cg = cooperative_groups;
#ifndef PROBE
#define PROBE 0
#endif
#ifndef MK_PER_PHASE
#define MK_PER_PHASE 0
#endif

namespace pg8 {
#define PG8_LAS __attribute__((address_space(3)))
typedef unsigned short bf16_t;
typedef short bf16x8 __attribute__((ext_vector_type(8)));
typedef float f32x4 __attribute__((ext_vector_type(4)));
typedef unsigned u32x4 __attribute__((ext_vector_type(4)));
constexpr int BM = 256, BK = 64, HALF = 128, HTB = HALF * BK * 2  , STAGE_BYTES = 8 * HTB, NXCD = 8, WGM = 8;

__host__ __device__ __forceinline__ int lds_byte(int r, int c) { const int st = (r >> 4) * 2 + (c >> 5), rr = r & 15, cc = c & 31, ob = rr * 64 + cc * 2; return st * 1024 + (ob ^ (((ob >> 9) & 1) << 5)); }
__host__ __device__ __forceinline__ void stage_rc(int b, int& R, int& C) { const int st = b / 1024, sb = b % 1024, swz = sb ^ (((sb >> 9) & 1) << 5); R = (st >> 1) * 16 + swz / 64; C = (st & 1) * 32 + (swz % 64) / 2; }
__host__ __device__ __forceinline__ int perm32(int rho) { const int n = rho >> 4, i = rho & 15; return 8 * (i >> 2) + 4 * n + (i & 3); }

struct Unit { int am, bn, pm, pn, e, valid; };
struct Gemm { const bf16_t* A; const bf16_t* Bt; int M, N, K; };

struct StaticOrder {
    int nM, nN, nwg, G, c;
    __device__ void init(int M, int N, int G_, int c_) { nM = M / BM; nN = N / BM; nwg = nM * nN; G = G_; c = c_; }
    __device__ bool next(int i, Unit& u) const {
        const long L = (long)i * G + c; if (L >= nwg) return false;
        int wgid = (int)L; { const int q = nwg / NXCD, r = nwg % NXCD, xcd = wgid % NXCD, off = wgid / NXCD; wgid = (xcd < r ? xcd * (q + 1) : r * (q + 1) + (xcd - r) * q) + off; }
        const int nig = WGM * nN, gid = wgid / nig, fm = gid * WGM, gsz = (nM - fm) < WGM ? (nM - fm) : WGM;
        u.pm = fm + ((wgid % nig) % gsz); u.pn = (wgid % nig) / gsz; u.am = u.pm * BM; u.bn = u.pn * BM; u.e = 0; u.valid = BM; return true;
    }
    __device__ __forceinline__ void a_ready(const Unit&) const {}
    __device__ __forceinline__ void done(const Unit&) const {}
};
struct MoeOrder {
    const PG8_LAS int* ST;
    const PG8_LAS int* TP;
    int NP, NB, G, c;
    __device__ bool next(int i, Unit& u) const {
#define RFL(x) __builtin_amdgcn_readfirstlane(x)
        const int U = RFL(TP[32]) * NP, CH = (U + NXCD - 1) / NXCD;
        const int x = c % NXCD, j = c / NXCD + (G / NXCD) * i;
        if (j >= CH) return false;
        const int ui = x * CH + j; if (ui >= U) return false;
        const int t = ui / NP, pn = ui % NP;
        int e = 0;
        while (e < 31 && RFL(TP[e + 1]) <= t) ++e;
        const int tpe = RFL(TP[e]), ste = RFL(ST[e]), ste1 = RFL(ST[e + 1]);
        const int mt = t - tpe, cnt = ste1 - ste;
        u.e = e; u.pm = mt; u.pn = pn; u.am = ste + mt * BM; u.bn = e * NB + pn * BM; u.valid = (cnt - mt * BM) < BM ? (cnt - mt * BM) : BM; return true;
#undef RFL
    }
    __device__ __forceinline__ void a_ready(const Unit&) const {}
    __device__ __forceinline__ void done(const Unit&) const {}
};

__device__ __forceinline__ unsigned cvt_pk_bf16(float lo, float hi) { unsigned r; asm volatile("v_cvt_pk_bf16_f32 %0, %1, %2" : "=v"(r) : "v"(lo), "v"(hi)); return r; }

template <class Epi, class Sched, bool ALIGN_EPI = false, bool SP2 = false, bool GATHER = false>
__device__ __forceinline__ void gemm_phase(PG8_LAS unsigned char* lds, const Gemm g, const Sched& S, const Epi& E, const int tid, const PG8_LAS int* tk = nullptr) {
    static_assert(SP2 || !GATHER, "gather needs the SP2 loop");
    const int wid = __builtin_amdgcn_readfirstlane(tid >> 6), lane = tid & 63, wr = wid >> 2, wc = wid & 3, fr = lane & 15, fq = lane >> 4;
    const int K = g.K, nt = K / BK;
    unsigned voffA[2], voffB[2]; int gR[2]; unsigned gC[2];
    { int R, C; stage_rc(tid * 16, R, C); const int Rb = Epi::PERM ? ((R & ~31) + perm32(R & 31)) : R;
      voffA[0] = (unsigned)(R * K + C) * 2u; voffB[0] = (unsigned)(Rb * K + C) * 2u; gR[0] = R; gC[0] = (unsigned)C * 2u;
      voffA[1] = voffA[0] + (unsigned)(64 * K * 2); voffB[1] = voffB[0] + (unsigned)(64 * K * 2); gR[1] = R + 64; gC[1] = gC[0]; }
    const size_t kstep = (size_t)(BK * 2);
    const size_t hstep = (size_t)HALF * K * 2;
    const size_t rowb = (size_t)K * 2;
    const unsigned ldsw = (unsigned)wid * 1024u;
    const int aoff = lds_byte(wr * 64 + fr, fq * 8), boff = lds_byte(wc * 32 + fr, fq * 8);
#define PG8_SA(b, h) (((b) * 2 + (h)) * HTB)
#define PG8_SB(b, h) ((4 + (b) * 2 + (h)) * HTB)
#define PG8_STAGE(bufoff, gbase, voff) do { _Pragma("unroll") for (int _i = 0; _i < 2; ++_i) \
        __builtin_amdgcn_global_load_lds((const unsigned*)((const char*)(gbase) + (size_t)_i * (64 * rowb) + (voff)[0]), (PG8_LAS unsigned*)(lds + (bufoff) + ldsw + _i * 8192), 16, 0, 0); } while (0)
#define PG8_STAGE2(bufoff, gbase, voff) do { _Pragma("unroll") for (int _i = 0; _i < 2; ++_i) \
        __builtin_amdgcn_global_load_lds((const unsigned*)((const char*)(gbase) + (voff)[_i]), (PG8_LAS unsigned*)(lds + (bufoff) + ldsw + _i * 8192), 16, 0, 0); } while (0)
#define PG8_STAGE_A(bufoff, h, ptr, kb, nx) do { if constexpr (GATHER) { unsigned go_[2]; const int ub_ = ((nx) ? ui + 1 : ui) * 256 + (h) * 128 + gR[0]; \
        go_[0] = (unsigned)tk[ub_] * (unsigned)(K * 2) + gC[0]; go_[1] = (unsigned)tk[ub_ + 64] * (unsigned)(K * 2) + gC[0]; \
        PG8_STAGE2(bufoff, (const char*)g.A + (kb), go_); } else { PG8_STAGE(bufoff, ptr, voffA); } } while (0)
#define PG8_LDA(dst, b, h) do { _Pragma("unroll") for (int m = 0; m < 4; ++m) _Pragma("unroll") for (int k = 0; k < 2; ++k) dst[m][k] = *(const PG8_LAS bf16x8*)(lds + PG8_SA(b, h) + aoff + m * 2048 + k * 1024); } while (0)
#define PG8_LDB(dst, b, h) do { _Pragma("unroll") for (int n = 0; n < 2; ++n) _Pragma("unroll") for (int k = 0; k < 2; ++k) dst[n][k] = *(const PG8_LAS bf16x8*)(lds + PG8_SB(b, h) + boff + n * 2048 + k * 1024); } while (0)
#define PG8_MMA(ai, bj, At, Bt) do { __builtin_amdgcn_s_setprio(1); _Pragma("unroll") for (int m = 0; m < 4; ++m) _Pragma("unroll") for (int n = 0; n < 2; ++n) _Pragma("unroll") for (int k = 0; k < 2; ++k) \
        acc[ai][bj][m][n] = __builtin_amdgcn_mfma_f32_16x16x32_bf16(Bt[n][k], At[m][k], acc[ai][bj][m][n], 0, 0, 0); __builtin_amdgcn_s_setprio(0); } while (0)
#define PG8_WAIT_V(n) asm volatile("s_waitcnt vmcnt(" #n ")" ::: "memory")
#define PG8_WAIT_L(n) asm volatile("s_waitcnt lgkmcnt(" #n ")" ::: "memory")
#define PG8_BAR __builtin_amdgcn_s_barrier()
#define PG8_SCHED __builtin_amdgcn_sched_barrier(0)
    Unit cur, nxt; int ui = 0;
    if (!S.next(0, cur)) return;
    f32x4 acc[2][2][4][2];
#pragma unroll
    for (int a = 0; a < 2; ++a)
#pragma unroll
        for (int b = 0; b < 2; ++b)
#pragma unroll
            for (int m = 0; m < 4; ++m)
#pragma unroll
                for (int n = 0; n < 2; ++n) acc[a][b][m][n] = (f32x4){0.f, 0.f, 0.f, 0.f};
    bf16x8 At[4][2], B0[2][2], B1[2][2];
    const char* cA = (const char*)g.A + (size_t)cur.am * rowb; const char* cB = (const char*)g.Bt + (size_t)cur.bn * rowb;
    S.a_ready(cur);
    if constexpr (SP2) {
        PG8_STAGE(PG8_SB(0, 0), cB, voffB); PG8_STAGE(PG8_SB(0, 1), cB + hstep, voffB); PG8_STAGE_A(PG8_SA(0, 0), 0, cA, 0, false); PG8_STAGE_A(PG8_SA(0, 1), 1, cA + hstep, 0, false);
        if (wr == 1) PG8_BAR;
        PG8_WAIT_V(2); PG8_BAR;
        PG8_STAGE(PG8_SB(1, 0), cB + kstep, voffB); PG8_STAGE_A(PG8_SA(1, 0), 0, cA + kstep, kstep, false); PG8_STAGE(PG8_SB(1, 1), cB + hstep + kstep, voffB);
        PG8_WAIT_V(6); PG8_BAR;
    } else {
        PG8_STAGE(PG8_SB(0, 0), cB, voffB); PG8_STAGE(PG8_SA(0, 0), cA, voffA); PG8_STAGE(PG8_SB(0, 1), cB + hstep, voffB); PG8_STAGE(PG8_SA(0, 1), cA + hstep, voffA);
        if (wr == 1) PG8_BAR;
        PG8_WAIT_V(4); PG8_BAR;
        PG8_STAGE(PG8_SB(1, 0), cB + kstep, voffB); PG8_STAGE(PG8_SA(1, 0), cA + kstep, voffA); PG8_STAGE(PG8_SB(1, 1), cB + hstep + kstep, voffB);
        PG8_WAIT_V(6); PG8_BAR;
    }
    for (;;) {
        const bool has_next = S.next(ui + 1, nxt);
        const char* nA = has_next ? (const char*)g.A + (size_t)nxt.am * rowb : cA; const char* nB = has_next ? (const char*)g.Bt + (size_t)nxt.bn * rowb : cB;
        for (int t = 0; t < nt; t += 2) {
            const bool last = (t == nt - 2);
            const char* a1 = cA + (size_t)(t + 1) * kstep;
            const char* a2 = last ? nA : cA + (size_t)(t + 2) * kstep; const char* b2 = last ? nB : cB + (size_t)(t + 2) * kstep;
            const char* a3 = a2 + kstep; const char* b3 = b2 + kstep;
            const size_t gk2 = last ? 0 : (size_t)(t + 2) * kstep; const bool gnx = last && has_next;
            if (last && has_next) S.a_ready(nxt);
            if constexpr (SP2) {
            PG8_LDB(B0, 0, 0); PG8_LDB(B1, 0, 1); PG8_SCHED; PG8_LDA(At, 0, 0); PG8_STAGE_A(PG8_SA(1, 1), 1, a1 + hstep, (size_t)(t + 1) * kstep, false);
            PG8_WAIT_V(8); PG8_WAIT_L(0); PG8_BAR; PG8_MMA(0, 0, At, B0); PG8_MMA(0, 1, At, B1); PG8_BAR; PG8_SCHED;
            PG8_LDA(At, 0, 1); PG8_STAGE(PG8_SB(0, 0), b2, voffB); PG8_STAGE(PG8_SB(0, 1), b2 + hstep, voffB); PG8_STAGE_A(PG8_SA(0, 0), 0, a2, gk2, gnx);
            PG8_WAIT_V(8); PG8_WAIT_L(0); PG8_BAR; PG8_MMA(1, 0, At, B0); PG8_MMA(1, 1, At, B1); PG8_BAR; PG8_SCHED;
            PG8_LDB(B0, 1, 0); PG8_LDB(B1, 1, 1); PG8_SCHED; PG8_LDA(At, 1, 0); PG8_STAGE_A(PG8_SA(0, 1), 1, a2 + hstep, gk2, gnx);
            PG8_WAIT_V(8); PG8_WAIT_L(0); PG8_BAR; PG8_MMA(0, 0, At, B0); PG8_MMA(0, 1, At, B1); PG8_BAR; PG8_SCHED;
            PG8_LDA(At, 1, 1); PG8_STAGE(PG8_SB(1, 0), b3, voffB); PG8_STAGE(PG8_SB(1, 1), b3 + hstep, voffB); PG8_STAGE_A(PG8_SA(1, 0), 0, a3, gk2 + kstep, gnx);
            PG8_WAIT_V(8); PG8_WAIT_L(0); PG8_BAR; PG8_MMA(1, 0, At, B0); PG8_MMA(1, 1, At, B1); PG8_BAR; PG8_SCHED;
            } else {
            PG8_LDB(B0, 0, 0); PG8_SCHED; PG8_LDA(At, 0, 0); PG8_STAGE(PG8_SA(1, 1), a1 + hstep, voffA);
            PG8_WAIT_L(8); PG8_BAR; PG8_WAIT_L(0); PG8_MMA(0, 0, At, B0); PG8_BAR; PG8_SCHED;
            PG8_LDB(B1, 0, 1); PG8_STAGE(PG8_SB(0, 0), b2, voffB);
            PG8_BAR; PG8_WAIT_L(0); PG8_MMA(0, 1, At, B1); PG8_BAR;
            PG8_LDA(At, 0, 1); PG8_STAGE(PG8_SA(0, 0), a2, voffA);
            PG8_BAR; PG8_WAIT_L(0); PG8_MMA(1, 0, At, B0); PG8_BAR; PG8_SCHED;
            PG8_STAGE(PG8_SB(0, 1), b2 + hstep, voffB);
            PG8_WAIT_V(6); PG8_BAR; PG8_MMA(1, 1, At, B1); PG8_BAR;
            PG8_LDB(B0, 1, 0); PG8_SCHED; PG8_LDA(At, 1, 0); PG8_STAGE(PG8_SA(0, 1), a2 + hstep, voffA);
            PG8_WAIT_L(8); PG8_BAR; PG8_WAIT_L(0); PG8_MMA(0, 0, At, B0); PG8_BAR; PG8_SCHED;
            PG8_LDB(B1, 1, 1); PG8_STAGE(PG8_SB(1, 0), b3, voffB);
            PG8_BAR; PG8_WAIT_L(0); PG8_MMA(0, 1, At, B1); PG8_BAR;
            PG8_LDA(At, 1, 1); PG8_STAGE(PG8_SA(1, 0), a3, voffA);
            PG8_BAR; PG8_WAIT_L(0); PG8_MMA(1, 0, At, B0); PG8_BAR; PG8_SCHED;
            PG8_STAGE(PG8_SB(1, 1), b3 + hstep, voffB);
            PG8_WAIT_V(6); PG8_BAR; PG8_MMA(1, 1, At, B1); PG8_BAR;
            }
        }
        if constexpr (ALIGN_EPI) { if (wr == 0) PG8_BAR; }
        if constexpr (!Epi::AFTER_DRAIN) { E(acc, cur, wr, wc, fr, fq); S.done(cur); }
        if (!has_next) break;
#pragma unroll
        for (int a = 0; a < 2; ++a)
#pragma unroll
            for (int b = 0; b < 2; ++b)
#pragma unroll
                for (int m = 0; m < 4; ++m)
#pragma unroll
                    for (int n = 0; n < 2; ++n) acc[a][b][m][n] = (f32x4){0.f, 0.f, 0.f, 0.f};
        cur = nxt; cA = nA; cB = nB; ++ui;
        if constexpr (ALIGN_EPI) { if (wr == 1) PG8_BAR; }
    }
    PG8_WAIT_V(0);
    if constexpr (!ALIGN_EPI) { if (wr == 0) PG8_BAR; }
    PG8_BAR;
    if constexpr (Epi::AFTER_DRAIN) { E.fused(acc, cur, wr, wc, fr, fq, lds, wid, lane); S.done(cur); }
#undef PG8_SA
#undef PG8_SB
#undef PG8_STAGE
#undef PG8_STAGE2
#undef PG8_STAGE_A
#undef PG8_LDA
#undef PG8_LDB
#undef PG8_MMA
#undef PG8_WAIT_V
#undef PG8_WAIT_L
#undef PG8_BAR
#undef PG8_SCHED
}
}

#define LAS __attribute__((address_space(3)))
typedef unsigned short bf16_t;
typedef short bf16x8 __attribute__((ext_vector_type(8)));
typedef float f32x4 __attribute__((ext_vector_type(4)));
typedef float f32x16 __attribute__((ext_vector_type(16)));
typedef unsigned u32x4 __attribute__((ext_vector_type(4)));
typedef unsigned u32x2 __attribute__((ext_vector_type(2)));
typedef short s16x4 __attribute__((ext_vector_type(4)));
typedef LAS const char* lds_cptr;
using pg8::Unit;

constexpr int T = 16384, SEQ = 8192, DM = 2048, INC = 4096, NEXP = 32, DFF = 512, NASSIGN = 2 * T, NLAYER = 2;
constexpr float LOG2E = 1.4426950408889634f;
constexpr float C2 = 0.125f * LOG2E;
constexpr int C_QA = 0, C_KA = 768, C_VA = 1024, C_UB = 1280, C_QC = 1792, C_KC = 2560, C_VC = 3328;

constexpr size_t MiB = 1u << 20;
constexpr size_t WS_CTL = 0, CTL_ZERO_BYTES = 1 * MiB;
constexpr size_t WS_COS = 2 * MiB, WS_SIN = 4 * MiB;
constexpr size_t WS_TOKE = 6 * MiB, WS_TOKG = 6 * MiB + 256 * 1024, WS_TOKP = 6 * MiB + 512 * 1024, WS_SGATE = 6 * MiB + 768 * 1024;
constexpr size_t WS_ROWTOK = 8 * MiB, WS_ROWGATE = 10 * MiB;
constexpr size_t WS_LAM = 6 * MiB + 1000 * 1024;
constexpr size_t WS_WR = 12 * MiB;
constexpr size_t WS_WIN = 16 * MiB, WS_WOUT = 48 * MiB, WS_WGU = 64 * MiB, WS_WDN = 320 * MiB;
constexpr size_t WS_HN = 448 * MiB, WS_PROJ = 512 * MiB, WS_CAT = 642 * MiB, WS_XSS = 706 * MiB, WS_ACT = 835 * MiB, WS_END = 868 * MiB;
constexpr int CW_QCTR = 0;
constexpr int CW_CUR = 1024;
constexpr int CW_BAR = 8192;

constexpr int LDS_WSF = 135168, LDS_MISC = 137216, LDS_BYTES = 147456;
constexpr int MI_ST = 16, MI_TP = 64, MI_LCNT = 128, MI_LBASE = 160, MI_SSQ = 256;

#define LDS_WAIT() asm volatile("s_waitcnt lgkmcnt(0)" ::: "memory")
__device__ __forceinline__ unsigned f2bf(float f) { unsigned u = __builtin_bit_cast(unsigned, f); return (u + 0x7fffu + ((u >> 16) & 1u)) >> 16; }
__device__ __forceinline__ unsigned pk2(float lo, float hi) { return f2bf(lo) | (f2bf(hi) << 16); }
__device__ __forceinline__ float bf2f(unsigned b) { return __builtin_bit_cast(float, b << 16); }
typedef float f32x2_t __attribute__((ext_vector_type(2))); typedef __bf16 bf16x2_t __attribute__((ext_vector_type(2)));
__device__ __forceinline__ unsigned cvtpk(float lo, float hi) { f32x2_t v = {lo, hi}; bf16x2_t b = __builtin_convertvector(v, bf16x2_t); return __builtin_bit_cast(unsigned, b); }
__device__ __forceinline__ float wave_sum(float v) {
#pragma unroll
    for (int o = 1; o < 64; o <<= 1) v += __shfl_xor(v, o);
    return v;
}

struct Ctx {
    const float* in[23]; float* out; unsigned char* ws;
    LAS unsigned char* lds; volatile LAS int* misc;
    int tid, lane, wave, G, bid;
};
#define IN_X 0
#define IN_POS 1
#define IN_ANORM 2
#define IN_WIN 3
#define IN_SINKS 4
#define IN_BNA 5
#define IN_WPOOL 6
#define IN_PSCALE 7
#define IN_LQ1 8
#define IN_LK1 9
#define IN_LQ2 10
#define IN_LK2 11
#define IN_SUBLN 12
#define IN_WOUT 13
#define IN_FNORM 14
#define IN_WRG 15
#define IN_BRG 16
#define IN_WRE 17
#define IN_BRE 18
#define IN_WG 19
#define IN_WU 20
#define IN_WD 21
#define IN_FINAL 22

struct EpiProj {
    static constexpr bool PERM = true, AFTER_DRAIN = false;
    bf16_t* O; const float* cosT; const float* sinT;
    __device__ __forceinline__ void operator()(const f32x4 (&acc)[2][2][4][2], const Unit& u, int wr, int wc, int fr, int fq) const {
        const int pn = u.pn;
        const bool rope = (0x1F8Fu >> pn) & 1u;
        const float sc = ((0x0387u >> pn) & 1u) ? C2 : 1.f;
        const int row0 = u.pm * 256 + wr * 64 + fr, col0 = pn * 256 + wc * 32 + 8 * fq, fi = 16 * (wc & 1) + 4 * fq;
#pragma unroll
        for (int ai = 0; ai < 2; ++ai)
#pragma unroll
            for (int m = 0; m < 4; ++m) {
                const int row = row0 + ai * 128 + m * 16;
                f32x4 cs = {1.f, 1.f, 1.f, 1.f}, sn = {0.f, 0.f, 0.f, 0.f};
                if (rope) { cs = *(const f32x4*)(cosT + (size_t)row * 32 + fi); sn = *(const f32x4*)(sinT + (size_t)row * 32 + fi); }
                bf16_t* rowp = O + (size_t)row * INC + col0;
#pragma unroll
                for (int bj = 0; bj < 2; ++bj) {
                    const f32x4 v0 = acc[ai][bj][m][0], v1 = acc[ai][bj][m][1];
                    const f32x4 o0 = (v0 * cs - v1 * sn) * sc, o1 = (v1 * cs + v0 * sn) * sc;
                    u32x4 w; w.x = cvtpk(o0[0], o0[1]); w.y = cvtpk(o0[2], o0[3]); w.z = cvtpk(o1[0], o1[1]); w.w = cvtpk(o1[2], o1[3]);
                    *(u32x4*)(rowp + bj * 128) = w;
                }
            }
    }
};
struct EpiResid {
    static constexpr bool PERM = false, AFTER_DRAIN = false;
    const float* src; float* dst;
    __device__ __forceinline__ void operator()(const f32x4 (&acc)[2][2][4][2], const Unit& u, int wr, int wc, int fr, int fq) const {
        const int row0 = u.pm * 256 + wr * 64 + fr, col0 = u.pn * 256 + wc * 32 + 4 * fq;
#pragma unroll
        for (int ai = 0; ai < 2; ++ai)
#pragma unroll
            for (int m = 0; m < 4; ++m) {
                const size_t off = (size_t)(row0 + ai * 128 + m * 16) * DM + col0;
#pragma unroll
                for (int bj = 0; bj < 2; ++bj)
#pragma unroll
                    for (int n = 0; n < 2; ++n) { const f32x4 s = *(const f32x4*)(src + off + bj * 128 + n * 16); *(f32x4*)(dst + off + bj * 128 + n * 16) = s + acc[ai][bj][m][n]; }
            }
    }
};
struct EpiGU {
    static constexpr bool PERM = true, AFTER_DRAIN = false;
    bf16_t* ACT;
    __device__ __forceinline__ void operator()(const f32x4 (&acc)[2][2][4][2], const Unit& u, int wr, int wc, int fr, int fq) const {
        const int col0 = u.pn * 128 + wc * 32 + 8 * fq;
#pragma unroll
        for (int ai = 0; ai < 2; ++ai)
#pragma unroll
            for (int m = 0; m < 4; ++m) {
                const int r = ai * 128 + wr * 64 + m * 16 + fr;
                if (r < u.valid) {
                    float a[8];
#pragma unroll
                    for (int n = 0; n < 2; ++n)
#pragma unroll
                        for (int j = 0; j < 4; ++j) { const float g = acc[ai][0][m][n][j], up = acc[ai][1][m][n][j]; a[n * 4 + j] = g * __builtin_amdgcn_rcpf(1.f + __builtin_amdgcn_exp2f(-g * LOG2E)) * up; }
                    u32x4 w; w.x = cvtpk(a[0], a[1]); w.y = cvtpk(a[2], a[3]); w.z = cvtpk(a[4], a[5]); w.w = cvtpk(a[6], a[7]);
                    *(u32x4*)(ACT + (size_t)(u.am + r) * DFF + col0) = w;
                }
            }
    }
};
struct EpiDown {
    static constexpr bool PERM = true, AFTER_DRAIN = false;
    bf16_t* YB; const float* sgate;
    __device__ __forceinline__ void operator()(const f32x4 (&acc)[2][2][4][2], const Unit& u, int wr, int wc, int fr, int fq) const {
        const int col0 = u.pn * 256 + wc * 32 + 8 * fq;
#pragma unroll
        for (int ai = 0; ai < 2; ++ai)
#pragma unroll
            for (int m = 0; m < 4; ++m) {
                const int r = ai * 128 + wr * 64 + m * 16 + fr;
                if (r < u.valid) {
                    const float gt = sgate[u.e * T + u.pm * 256 + r];
                    bf16_t* rowp = YB + (size_t)(u.am + r) * DM + col0;
#pragma unroll
                    for (int bj = 0; bj < 2; ++bj) {
                        const f32x4 v0 = acc[ai][bj][m][0] * gt, v1 = acc[ai][bj][m][1] * gt;
                        u32x4 w; w.x = cvtpk(v0[0], v0[1]); w.y = cvtpk(v0[2], v0[3]); w.z = cvtpk(v1[0], v1[1]); w.w = cvtpk(v1[2], v1[3]);
                        *(u32x4*)(rowp + bj * 128) = w;
                    }
                }
            }
    }
};

template <class F> __device__ __forceinline__ void tr_item(const F& f, int K, bf16_t* WT, LAS float* scr, int kb, int nb, int lane) {
    const int k0 = 64 * kb, n0 = 32 * nb;
#pragma unroll 8
    for (int i = 0; i < 32; ++i) { const int kk = 2 * i + (lane >> 5); scr[kk * 33 + (lane & 31)] = f(k0 + kk, n0 + (lane & 31)); }
    LDS_WAIT(); asm volatile("" ::: "memory");
    const int c = lane & 7;
#pragma unroll
    for (int j = 0; j < 4; ++j) { const int n = (lane >> 3) + 8 * j; const LAS float* s = scr + (8 * c) * 33 + n;
        u32x4 o; o.x = pk2(s[0 * 33], s[1 * 33]); o.y = pk2(s[2 * 33], s[3 * 33]); o.z = pk2(s[4 * 33], s[5 * 33]); o.w = pk2(s[6 * 33], s[7 * 33]);
        *(u32x4*)(WT + (size_t)(n0 + n) * K + k0 + 8 * c) = o; }
    LDS_WAIT(); asm volatile("" ::: "memory");
}
__device__ __forceinline__ float lam_init_of(int l) { return l == 0 ? 0.2f : (0.8f - 0.6f * 0.74081822068171788f); }

struct FWin { const float* w;
    __device__ __forceinline__ float operator()(int k, int n) const {
        const int pn = n >> 8; int col = n;
        if ((pn <= 3) || (pn >= 7 && pn <= 12)) { const int cw = n & 63; col = (n & ~63) + 32 * ((cw >> 2) & 1) + 4 * (cw >> 3) + (cw & 3); }
        return w[(size_t)k * INC + col]; } };
struct FWgu { const float* w;
    __device__ __forceinline__ float operator()(int k, int n) const {
        const int col = 128 * (n >> 8) + (n & 127);
        return w[(size_t)k * DFF + col]; } };
struct FWdn { const float* w;
    __device__ __forceinline__ float operator()(int k, int n) const { return w[(size_t)k * DM + n]; } };
struct FWr { const float* wrg; const float* wre;
    __device__ __forceinline__ float operator()(int k, int n) const {
        const int hl = n >= 48, j = hl ? n - 48 : n;
        const bool isg = j < 4, ise = j >= 4 && j < 36;
        const float* base = isg ? wrg + j : wre + (ise ? j - 4 : 0); const int stride = isg ? 4 : 32;
        const float v = (isg || ise) ? base[(size_t)k * stride] : 0.f * base[(size_t)k * stride];
        const float hi = bf2f(f2bf(v)); return hl ? v - hi : v; } };

__device__ __forceinline__ void fold_item(const float* wout, const float* wpool, const float* pscale, bf16_t* WT, LAS float* scr, int g, int kbh, int nb, int lane) {
    const int n = 64 * nb + lane;
    const float* wp = wpool + ((size_t)g * 128 + 64 * kbh) * 128; const float* ps = pscale + g * 128; const float* wo = wout + (size_t)(768 + g * 128) * DM + n;
#pragma unroll 1
    for (int ih = 0; ih < 2; ++ih) {
        { const f32x4* src = (const f32x4*)(wp + (size_t)(32 * ih) * 128) + lane; f32x4 t[16];
#pragma unroll
          for (int q = 0; q < 16; ++q) t[q] = src[q * 64];
#pragma unroll
          for (int q = 0; q < 16; ++q) *(LAS f32x4*)(scr + (q * 64 + lane) * 4) = t[q]; }
        LDS_WAIT(); asm volatile("" ::: "memory");
        float acc[32];
#pragma unroll
        for (int i = 0; i < 32; ++i) acc[i] = 0.f;
#pragma unroll 1
        for (int jb = 0; jb < 16; ++jb) {
            float bv[8];
            { const float* wj = wo + (size_t)(jb * 8) * DM; const float* pj = ps + jb * 8;
#pragma unroll
              for (int jj = 0; jj < 8; ++jj) bv[jj] = wj[(size_t)jj * DM] * pj[jj]; }
#pragma unroll
            for (int ic = 0; ic < 8; ++ic) {
#pragma unroll
                for (int i = 4 * ic; i < 4 * ic + 4; ++i) { const LAS float* ar = scr + i * 128 + jb * 8; const f32x4 a0 = *(const LAS f32x4*)ar, a1 = *(const LAS f32x4*)(ar + 4);
                    acc[i] = fmaf(a0[0], bv[0], acc[i]); acc[i] = fmaf(a0[1], bv[1], acc[i]); acc[i] = fmaf(a0[2], bv[2], acc[i]); acc[i] = fmaf(a0[3], bv[3], acc[i]);
                    acc[i] = fmaf(a1[0], bv[4], acc[i]); acc[i] = fmaf(a1[1], bv[5], acc[i]); acc[i] = fmaf(a1[2], bv[6], acc[i]); acc[i] = fmaf(a1[3], bv[7], acc[i]); }
                __builtin_amdgcn_sched_barrier(0);
            }
        }
        u32x4* dst = (u32x4*)(WT + (size_t)n * DM + 768 + g * 128 + 64 * kbh + 32 * ih);
#pragma unroll
        for (int c = 0; c < 4; ++c) { u32x4 o; o.x = cvtpk(acc[8 * c], acc[8 * c + 1]); o.y = cvtpk(acc[8 * c + 2], acc[8 * c + 3]); o.z = cvtpk(acc[8 * c + 4], acc[8 * c + 5]); o.w = cvtpk(acc[8 * c + 6], acc[8 * c + 7]); dst[c] = o; }
        LDS_WAIT(); asm volatile("" ::: "memory");
    }
}
constexpr int I_FOLD = 4 * 2 * 32, I_WR = 32 * 3, I_SLOW = I_FOLD + I_WR;
constexpr int I_WIN = 32 * 128, I_WOUT = 24 * 64, I_WGU1 = 32 * 32, I_WDN1 = 8 * 64;
constexpr int I_FAST = I_WIN + I_WOUT + NEXP * I_WGU1 + NEXP * I_WDN1;
struct TrDesc { const float* src; const float* sptr; bf16_t* dst; float smul; int N, K; unsigned coloff; };
constexpr int I_PRO = I_WOUT + I_WIN;
constexpr int I_EXP = NEXP * I_WGU1 + NEXP * I_WDN1;
#define BLK2D(q, NBLK, kq_, nb_) do { const int g_ = (q) >> 3, r8_ = (q) & 7; nb_ = (g_ % ((NBLK) / 2)) * 2 + (r8_ & 1); kq_ = (g_ / ((NBLK) / 2)) * 4 + (r8_ >> 1); } while (0)
__device__ __forceinline__ TrDesc tr_mk(Ctx& C, int l, int r, int lane) {
    const int rr = lane >> 3, cc = lane & 7, nl = lane & 31, kh = lane >> 5;
    TrDesc d; d.sptr = nullptr; d.smul = 1.f;
    int kb, nb, n;
    if (r < I_WOUT) { int kq; BLK2D(r, 64, kq, nb); kb = kq < 12 ? kq : kq + 8; n = 32 * nb + nl;
        d.src = C.in[IN_WOUT] + (size_t)l * DM * DM; d.N = DM; d.K = DM; d.coloff = (unsigned)n * 4u; d.dst = (bf16_t*)(C.ws + WS_WOUT) + (size_t)l * DM * DM;
        if (kb < 12) d.sptr = C.in[IN_BNA] + l * 768 + 64 * kb + 32 * kh; else { d.sptr = C.in[IN_SUBLN] + l * 128 + ((64 * kb - 1280) & 127) + 32 * kh; d.smul = 1.f - lam_init_of(l); } }
    else if ((r -= I_WOUT) < I_WIN) { BLK2D(r, 128, kb, nb); n = 32 * nb + nl; const int pn = n >> 8; int col = n;
        if ((pn <= 3) || (pn >= 7 && pn <= 12)) { const int cw = n & 63; col = (n & ~63) + 32 * ((cw >> 2) & 1) + 4 * (cw >> 3) + (cw & 3); }
        d.src = C.in[IN_WIN] + (size_t)l * DM * INC; d.N = INC; d.K = DM; d.coloff = (unsigned)col * 4u; d.dst = (bf16_t*)(C.ws + WS_WIN) + (size_t)l * INC * DM; }
    else if ((r -= I_WIN) < NEXP * I_WGU1) { const int e = r / I_WGU1, q = r % I_WGU1; BLK2D(q, 32, kb, nb); n = 32 * nb + nl; const size_t eo = ((size_t)l * NEXP + e) * DM * DFF;
        d.src = ((nb & 4) ? C.in[IN_WU] : C.in[IN_WG]) + eo; d.N = DFF; d.K = DM; d.coloff = (unsigned)(128 * (n >> 8) + (n & 127)) * 4u; d.dst = (bf16_t*)(C.ws + WS_WGU) + ((size_t)l * NEXP + e) * 1024 * DM; }
    else { r -= NEXP * I_WGU1; const int e = r / I_WDN1, q = r % I_WDN1; BLK2D(q, 64, kb, nb); n = 32 * nb + nl;
        d.src = C.in[IN_WD] + ((size_t)l * NEXP + e) * DFF * DM; d.N = DM; d.K = DFF; d.coloff = (unsigned)n * 4u; d.dst = (bf16_t*)(C.ws + WS_WDN) + ((size_t)l * NEXP + e) * DM * DFF; }
    d.src += (size_t)(64 * kb + 32 * kh) * d.N;
    d.dst += (size_t)(32 * nb + rr) * d.K + 64 * kb + 8 * cc;
    return d;
}
#undef BLK2D
#define TR_LOAD(v, d) do { const char* rp_ = (const char*)(d).src + (d).coloff; const size_t rs_ = (size_t)(d).N * 4; _Pragma("unroll") for (int j = 0; j < 32; ++j) v[j] = __builtin_nontemporal_load((const float*)(rp_ + j * rs_)); } while (0)
#define TR_STORE(v, d) do { if (!EXPERT) if ((d).sptr) { _Pragma("unroll") for (int j = 0; j < 32; ++j) v[j] *= (d).sptr[j] * (d).smul; }     \
        _Pragma("unroll") for (int c = 0; c < 4; ++c) { u32x4 o; o.x = cvtpk(v[8 * c], v[8 * c + 1]); o.y = cvtpk(v[8 * c + 2], v[8 * c + 3]); o.z = cvtpk(v[8 * c + 4], v[8 * c + 5]); o.w = cvtpk(v[8 * c + 6], v[8 * c + 7]); \
            *(LAS u32x4*)(sc_ + nl * 144 + kh * 64 + c * 16) = o; } \
        LDS_WAIT(); asm volatile("" ::: "memory"); \
        _Pragma("unroll") for (int g = 0; g < 4; ++g) { const u32x4 o = *(const LAS u32x4*)(sc_ + (8 * g + rr) * 144 + cc * 16); *(u32x4*)((d).dst + (size_t)(8 * g) * (d).K) = o; } \
        LDS_WAIT(); asm volatile("" ::: "memory"); } while (0)
template <bool EXPERT> __device__ __forceinline__ void conv_run(Ctx& C, int lfix, int i0, int i1, int stride) {
    const int lane = C.lane, rr = lane >> 3, cc = lane & 7, nl = lane & 31, kh = lane >> 5;
    LAS unsigned char* sc_ = C.lds + C.wave * 16384;
#define TR_MK(i) (EXPERT ? tr_mk(C, lfix, I_PRO + (i), lane) : tr_mk(C, (i) / I_PRO, (i) % I_PRO, lane))
    float vA[32], vB[32]; TrDesc dA, dB;
    int it = i0;
    if (it >= i1) return;
    dA = TR_MK(it); TR_LOAD(vA, dA);
    for (;;) {
        const int itB = it + stride; const bool hB = itB < i1;
        dB = TR_MK(hB ? itB : it); TR_LOAD(vB, dB);
        TR_STORE(vA, dA);
        if (!hB) break;
        it = itB + stride; const bool hA = it < i1;
        dA = TR_MK(hA ? it : itB); TR_LOAD(vA, dA);
        TR_STORE(vB, dB);
        if (!hA) break;
    }
#undef TR_MK
}
#undef TR_LOAD
#undef TR_STORE
__device__ __forceinline__ void phase_prologue(Ctx& C) {
    LAS float* scr = (LAS float*)(C.lds + C.wave * 16384);
    const int gw = C.bid * 8 + C.wave, NGW = C.G * 8, lane = C.lane;
    for (int it = C.bid + C.G * C.wave; it < NLAYER * I_SLOW; it += NGW) {
        const int l = it / I_SLOW, r = it % I_SLOW;
        if (r < I_FOLD) fold_item(C.in[IN_WOUT] + (size_t)l * DM * DM, C.in[IN_WPOOL] + (size_t)l * 4 * 128 * 128, C.in[IN_PSCALE] + l * 512, (bf16_t*)(C.ws + WS_WOUT) + (size_t)l * DM * DM, scr, r / 64, (r / 32) & 1, r % 32, lane);
        else { const int q = r - I_FOLD; FWr f{C.in[IN_WRG] + (size_t)l * DM * 4, C.in[IN_WRE] + (size_t)l * DM * 32}; tr_item(f, DM, (bf16_t*)(C.ws + WS_WR) + (size_t)l * 96 * DM, scr, q / 3, q % 3, lane); }
    }
    conv_run<false>(C, 0, gw, NLAYER * I_PRO, NGW);
    if (C.bid == 0 && C.wave == 0) {
        for (int l = 0; l < NLAYER; ++l) { const int i = C.lane;
            const float s1 = wave_sum(C.in[IN_LQ1][l * 64 + i] * C.in[IN_LK1][l * 64 + i]), s2 = wave_sum(C.in[IN_LQ2][l * 64 + i] * C.in[IN_LK2][l * 64 + i]);
            if (i == 0) ((float*)(C.ws + WS_LAM))[l] = __expf(s1) - __expf(s2) + lam_init_of(l); } }
    float* cosT = (float*)(C.ws + WS_COS); float* sinT = (float*)(C.ws + WS_SIN); const int* pos = (const int*)C.in[IN_POS];
    for (int i = C.bid * 512 + C.tid; i < T * 32; i += C.G * 512) {
        const int tok = i >> 5, fi = i & 31;
        double inv = 1.0; for (int q = 0; q < fi; ++q) inv *= 0.74989420933245582;
        const double rev = (double)pos[tok] * inv * 0.15915494309189535;
        const float fr = (float)(rev - __builtin_floor(rev));
        cosT[i] = __builtin_amdgcn_cosf(fr); sinT[i] = __builtin_amdgcn_sinf(fr);
    }
}

__device__ __forceinline__ void load_starts(Ctx& C, int l) {
    const unsigned* cur = (const unsigned*)(C.ws + WS_CTL) + CW_CUR + l * 32 * 64;
    if (C.tid < NEXP) C.misc[MI_LCNT + C.tid] = (int)__hip_atomic_load(cur + C.tid * 64, __ATOMIC_RELAXED, __HIP_MEMORY_SCOPE_AGENT);
    __syncthreads();
    if (C.tid == 0) { int s = 0, tp = 0;
        for (int e = 0; e < NEXP; ++e) { C.misc[MI_ST + e] = s; C.misc[MI_TP + e] = tp; const int c = C.misc[MI_LCNT + e]; s += c; tp += (c + 255) >> 8; }
        C.misc[MI_ST + NEXP] = s; C.misc[MI_TP + NEXP] = tp; }
    __syncthreads();
}
template <int MODE> __device__ __forceinline__ void phase_norm(Ctx& C, const float* src, float* dsth, const float* g, bf16_t* hn, float* outf) {
    const int gw = C.bid * 8 + C.wave, NGW = C.G * 8, lane = C.lane;
    const bf16_t* YB = (const bf16_t*)(C.ws + WS_PROJ);
    const int* toke = (const int*)(C.ws + WS_TOKE); const int* tokp = (const int*)(C.ws + WS_TOKP);
    int en0 = 0, en1 = 0, pn0 = 0, pn1 = 0;
    if (MODE >= 1 && gw < T) { en0 = toke[2 * gw]; en1 = toke[2 * gw + 1]; pn0 = tokp[2 * gw]; pn1 = tokp[2 * gw + 1]; }
    for (int m = gw; m < T; m += NGW) {
        const f32x4* xr = (const f32x4*)(src + (size_t)m * DM) + lane;
        f32x4 v[8];
#pragma unroll
        for (int j = 0; j < 8; ++j) v[j] = xr[64 * j];
        if (MODE >= 1) {
            const int r0 = C.misc[MI_ST + en0] + pn0, r1 = C.misc[MI_ST + en1] + pn1;
            { const int mn = (m + NGW < T) ? m + NGW : m; en0 = toke[2 * mn]; en1 = toke[2 * mn + 1]; pn0 = tokp[2 * mn]; pn1 = tokp[2 * mn + 1]; }
            const u32x2* y0 = (const u32x2*)(YB + (size_t)r0 * DM) + lane; const u32x2* y1 = (const u32x2*)(YB + (size_t)r1 * DM) + lane;
#pragma unroll
            for (int j = 0; j < 8; ++j) { const u32x2 a = y0[64 * j], b = y1[64 * j];
                v[j][0] += bf2f(a.x & 0xffffu) + bf2f(b.x & 0xffffu); v[j][1] += bf2f(a.x >> 16) + bf2f(b.x >> 16);
                v[j][2] += bf2f(a.y & 0xffffu) + bf2f(b.y & 0xffffu); v[j][3] += bf2f(a.y >> 16) + bf2f(b.y >> 16); }
        }
        if (MODE == 1) { f32x4* hr = (f32x4*)(dsth + (size_t)m * DM) + lane;
#pragma unroll
            for (int j = 0; j < 8; ++j) hr[64 * j] = v[j]; }
        float s = 0.f;
#pragma unroll
        for (int j = 0; j < 8; ++j) s += (v[j][0] * v[j][0] + v[j][1] * v[j][1]) + (v[j][2] * v[j][2] + v[j][3] * v[j][3]);
        const float rs = 1.0f / sqrtf(wave_sum(s) * (1.f / DM) + 1e-6f);
        const f32x4* gr = (const f32x4*)g + lane;
        if (MODE == 2) { f32x4* o = (f32x4*)(outf + (size_t)m * DM) + lane;
#pragma unroll
            for (int j = 0; j < 8; ++j) o[64 * j] = v[j] * rs * gr[64 * j]; }
        else { u32x2* o = (u32x2*)(hn + (size_t)m * DM) + lane;
#pragma unroll
            for (int j = 0; j < 8; ++j) { const f32x4 w = v[j] * rs * gr[64 * j]; u32x2 p; p.x = cvtpk(w[0], w[1]); p.y = cvtpk(w[2], w[3]); o[64 * j] = p; } }
    }
}

__device__ __forceinline__ int crow(int r, int hi) { return (r & 3) + 8 * (r >> 2) + 4 * hi; }
typedef short v4i16_t __attribute__((ext_vector_type(4)));
__device__ __forceinline__ s16x4 vtr(lds_cptr p) { return __builtin_bit_cast(s16x4, __builtin_amdgcn_ds_read_tr16_b64_v4i16((LAS v4i16_t*)p)); }
__device__ __forceinline__ float max3f(float a, float b, float c) { float r; asm("v_max3_f32 %0, %1, %2, %3" : "=v"(r) : "v"(a), "v"(b), "v"(c)); return r; }
__device__ __forceinline__ float swapmax(float v) { auto rr = __builtin_amdgcn_permlane32_swap(__float_as_uint(v), __float_as_uint(v), false, false); return fmaxf(__uint_as_float(rr[0]), __uint_as_float(rr[1])); }
__device__ __forceinline__ float swapsum(float v) { auto rr = __builtin_amdgcn_permlane32_swap(__float_as_uint(v), __float_as_uint(v), false, false); return __uint_as_float(rr[0]) + __uint_as_float(rr[1]); }

template <int NDH, int MASK>
__device__ __forceinline__ void attn_tile(f32x16 (&o)[NDH], float& m, float& l, const bf16x8 (&qr)[4], lds_cptr Kslot, lds_cptr Vslot, LAS float* wsf, int kbase, int qrow, int lane) {
    const int r32 = lane & 31, hi = lane >> 5;
    const lds_cptr kp = Kslot + hi * 1024 + r32 * 16;
    f32x16 p0 = {}, p1 = {};
#pragma unroll
    for (int d0 = 0; d0 < 4; ++d0) {
        const bf16x8 b0 = *(const LAS bf16x8*)(kp + d0 * 2048), b1 = *(const LAS bf16x8*)(kp + d0 * 2048 + 512);
        p0 = __builtin_amdgcn_mfma_f32_32x32x16_bf16(b0, qr[d0], p0, 0, 0, 0);
        p1 = __builtin_amdgcn_mfma_f32_32x32x16_bf16(b1, qr[d0], p1, 0, 0, 0);
    }
    __builtin_amdgcn_sched_barrier(0);
    if (MASK) {
#pragma unroll
        for (int r = 0; r < 16; ++r) {
            const int k0 = kbase + crow(r, hi), k1 = k0 + 32;
            bool v0 = k0 <= qrow, v1 = k1 <= qrow;
            if (MASK == 2) { v0 = v0 && (qrow - k0 < 128); v1 = v1 && (qrow - k1 < 128); }
            p0[r] = v0 ? p0[r] : -__builtin_inff(); p1[r] = v1 ? p1[r] : -__builtin_inff();
        }
    }
    float mx = fmaxf(p0[0], p1[0]);
#pragma unroll
    for (int r = 1; r < 16; ++r) mx = fmaxf(mx, fmaxf(p0[r], p1[r]));
    mx = swapmax(mx);
    const float mn = fmaxf(m, mx);
    const float alpha = __builtin_amdgcn_exp2f(m - mn);
    m = mn;
    float s = 0.f;
#pragma unroll
    for (int r = 0; r < 16; ++r) { p0[r] = __builtin_amdgcn_exp2f(p0[r] - mn); p1[r] = __builtin_amdgcn_exp2f(p1[r] - mn); s += p0[r] + p1[r]; }
    l = l * alpha + s;
    if (__any(alpha != 1.0f)) {
        if (hi == 0) wsf[r32] = alpha;
#pragma unroll
        for (int r = 0; r < 16; ++r) { const float a = wsf[crow(r, hi)];
#pragma unroll
            for (int dh = 0; dh < NDH; ++dh) o[dh][r] *= a; }
    }
    __builtin_amdgcn_sched_barrier(0);
    u32x4 pw[4];
    pw[0] = (u32x4){cvtpk(p0[0], p0[1]), cvtpk(p0[2], p0[3]), cvtpk(p0[4], p0[5]), cvtpk(p0[6], p0[7])};
    pw[1] = (u32x4){cvtpk(p0[8], p0[9]), cvtpk(p0[10], p0[11]), cvtpk(p0[12], p0[13]), cvtpk(p0[14], p0[15])};
    pw[2] = (u32x4){cvtpk(p1[0], p1[1]), cvtpk(p1[2], p1[3]), cvtpk(p1[4], p1[5]), cvtpk(p1[6], p1[7])};
    pw[3] = (u32x4){cvtpk(p1[8], p1[9]), cvtpk(p1[10], p1[11]), cvtpk(p1[12], p1[13]), cvtpk(p1[14], p1[15])};
    __builtin_amdgcn_sched_barrier(0);
    const lds_cptr vp = Vslot + ((lane >> 4) & 1) * 32 + (lane & 3) * 8 + (4 * hi + ((lane & 15) >> 2)) * 64;
#pragma unroll
    for (int dh = 0; dh < NDH; ++dh)
#pragma unroll
        for (int ks = 0; ks < 4; ++ks) {
            const s16x4 lo = vtr(vp + dh * 4096 + ks * 1024), hh = vtr(vp + dh * 4096 + ks * 1024 + 512);
            const bf16x8 vb = (bf16x8){lo[0], lo[1], lo[2], lo[3], hh[0], hh[1], hh[2], hh[3]};
            o[dh] = __builtin_amdgcn_mfma_f32_32x32x16_bf16(__builtin_bit_cast(bf16x8, pw[ks]), vb, o[dh], 0, 0, 0);
            if (ks == 3) __builtin_amdgcn_sched_barrier(0);
        }
}

#define DBAR() asm volatile("s_waitcnt lgkmcnt(0)\n\ts_barrier" ::: "memory")
#define VMWAIT0() asm volatile("s_waitcnt vmcnt(0)" ::: "memory")
__device__ __forceinline__ void glds16(const void* gsrc, unsigned lds_dst) { unsigned keep;
    asm volatile("s_mov_b32 %0, m0\n\ts_mov_b32 m0, %2\n\ts_nop 0\n\tglobal_load_lds_dwordx4 %1, off\n\ts_mov_b32 m0, %0" : "=&s"(keep) : "v"(gsrc), "s"(lds_dst) : "memory"); }
template <int ABL = 0> __device__ __forceinline__ void diff_unit(Ctx& C, int b, int h, int qb, float lam) {
    const int lane = C.lane, wid = C.wave, r32 = lane & 31, hi = lane >> 5, c = wid >> 2, wq = wid & 3;
    const int q0w = qb * 128 + wq * 32, qrow = q0w + r32;
    const char* Pb = (const char*)(C.ws + WS_PROJ) + (size_t)b * SEQ * INC * 2;
    bf16x8 qr[4];
    { const unsigned qo = (unsigned)(((q0w + r32) * INC + C_QC + (2 * h + c) * 64 + hi * 8) * 2);
#pragma unroll
      for (int d0 = 0; d0 < 4; ++d0) qr[d0] = *(const bf16x8*)(Pb + (qo + d0 * 32)); }
    const int NT = 2 * (qb + 1);
    LAS unsigned char* L = C.lds; LAS float* wsf = (LAS float*)(L + LDS_WSF + wid * 256);
    const unsigned kofs = (unsigned)((lane * INC + C_KC + (2 * h) * 64 + wid * 8) * 2);
    const unsigned vofs0 = (unsigned)(((16 * (wid & 3) + (lane >> 2)) * INC + C_VC + h * 128 + (wid >> 2) * 32 + (lane & 3) * 8) * 2);
    const unsigned vofs1 = vofs0 + 64 * 2;
    const int kfo = c * 8192 + hi * 1024 + r32 * 16;
    const int vfo = 16384 + ((lane >> 4) & 1) * 32 + (lane & 3) * 8 + (4 * hi + ((lane & 15) >> 2)) * 64;
    const unsigned ldsw = (unsigned)(uintptr_t)(unsigned char*)L + (unsigned)wid * 1024u;
#define DIFF_DMA(t, bo) do { const char* Pt_ = Pb + (size_t)(t) * (64 * INC * 2); const unsigned d_ = (unsigned)__builtin_amdgcn_readfirstlane(ldsw + (bo)); \
        glds16(Pt_ + kofs, d_); glds16(Pt_ + (kofs + 128), d_ + 8192u); glds16(Pt_ + vofs0, d_ + 16384u); glds16(Pt_ + vofs1, d_ + 24576u); } while (0)
#define DIFF_KF(bo) do { _Pragma("unroll") for (int d0 = 0; d0 < 4; ++d0) { kf[2 * d0] = *(const LAS bf16x8*)(L + (bo) + kfo + d0 * 2048); kf[2 * d0 + 1] = *(const LAS bf16x8*)(L + (bo) + kfo + d0 * 2048 + 512); } } while (0)
#define DIFF_VF(lo_, hi_, bo, dh) do { if ((ABL & 32) && t > 0) break; _Pragma("unroll") for (int ks = 0; ks < 4; ++ks) { lo_[ks] = vtr((lds_cptr)(L + (bo) + vfo + (dh) * 4096 + ks * 1024)); hi_[ks] = vtr((lds_cptr)(L + (bo) + vfo + (dh) * 4096 + ks * 1024 + 512)); } } while (0)
#define DIFF_PV(dh, lo_, hi_) do { _Pragma("unroll") for (int ks = 0; ks < 4; ++ks) { if (ABL & 8) { o[dh][ks] += __builtin_bit_cast(float, (int)lo_[ks][0] | ((int)hi_[ks][1] << 16)) + __builtin_bit_cast(float, pw[ks].x); continue; }  const bf16x8 vb_ = (bf16x8){lo_[ks][0], lo_[ks][1], lo_[ks][2], lo_[ks][3], hi_[ks][0], hi_[ks][1], hi_[ks][2], hi_[ks][3]}; \
        o[dh] = __builtin_amdgcn_mfma_f32_32x32x16_bf16(__builtin_bit_cast(bf16x8, pw[ks]), vb_, o[dh], 0, 0, 0); } } while (0)
    DIFF_DMA(0, 0); DIFF_DMA(1, 32768); if (NT > 2) DIFF_DMA(2, 65536); VMWAIT0();
    DBAR();
    bf16x8 kf[8]; DIFF_KF(0);
    f32x16 o[4]; o[0] = f32x16{}; o[1] = f32x16{}; o[2] = f32x16{}; o[3] = f32x16{};
    float m = 0.f, lsum = 0.f;
    u32x4 pw[4]; s16x4 va_lo[4], va_hi[4], vb_lo[4], vb_hi[4];
    f32x16 negm = f32x16{};
    pw[0] = pw[1] = pw[2] = pw[3] = (u32x4){0u, 0u, 0u, 0u};
    if (c == 1) DBAR();
    int s0 = 0, s1 = 32768, s2 = 65536, s3 = 98304;
#if PROBE >= 201 && PROBE <= 219
    unsigned long long tacc_ = 0, tcnt_ = 0, ts0_, ts1_, ts2_, ts3_, ts4_, tsa_ = 0, tsb_ = 0, tsc_ = 0;
#define STAMP(v) do { v = __builtin_amdgcn_s_memtime(); asm volatile("s_waitcnt lgkmcnt(0)" ::: "memory"); } while (0)
#else
#define STAMP(v) do {} while (0)
#endif
#pragma unroll 1
    for (int t = 0; t < NT; ++t) {
        STAMP(ts0_);
        const int kbase = 64 * t; const bool act = kbase <= q0w + 31;
        if (act) {
            f32x16 p0, p1;
            __builtin_amdgcn_s_setprio(2);
#pragma unroll
            for (int d0 = 0; d0 < 4; ++d0) { if (ABL & 2) { p0[d0] += __builtin_bit_cast(float, (int)kf[2 * d0][0]); p1[d0] += __builtin_bit_cast(float, (int)kf[2 * d0 + 1][1]); }
                else { p0 = __builtin_amdgcn_mfma_f32_32x32x16_bf16(kf[2 * d0], qr[d0], d0 == 0 ? negm : p0, 0, 0, 0); p1 = __builtin_amdgcn_mfma_f32_32x32x16_bf16(kf[2 * d0 + 1], qr[d0], d0 == 0 ? negm : p1, 0, 0, 0); } }
            __builtin_amdgcn_s_setprio(1);
            DIFF_VF(va_lo, va_hi, s0, 0); DIFF_VF(vb_lo, vb_hi, s0, 1);
            asm volatile("s_nop 15\n\ts_nop 7" : "+v"(p0), "+v"(p1));
            if (kbase + 63 > q0w) {
                const int dq = qrow - kbase - 4 * hi;
#pragma unroll
                for (int r = 0; r < 16; ++r) { const int cr = (r & 3) + 8 * (r >> 2); p0[r] = (cr <= dq) ? p0[r] : -__builtin_inff(); p1[r] = (cr + 32 <= dq) ? p1[r] : -__builtin_inff(); }
            }
            if (!(ABL & 4)) {
            float mxa = max3f(p0[0], p0[1], p0[2]), mxb = max3f(p0[3], p0[4], p0[5]), mxc = max3f(p1[0], p1[1], p1[2]), mxd = max3f(p1[3], p1[4], p1[5]);
            mxa = max3f(mxa, p0[6], p0[7]); mxb = max3f(mxb, p0[8], p0[9]); mxc = max3f(mxc, p1[6], p1[7]); mxd = max3f(mxd, p1[8], p1[9]);
            mxa = max3f(mxa, p0[10], p0[11]); mxb = max3f(mxb, p0[12], p0[13]); mxc = max3f(mxc, p1[10], p1[11]); mxd = max3f(mxd, p1[12], p1[13]);
            mxa = max3f(mxa, p0[14], p0[15]); mxc = max3f(mxc, p1[14], p1[15]);
            float mx = max3f(mxa, mxb, fmaxf(mxc, mxd));
            mx = swapmax(mx);
            const bool any_grow = __any(mx > 8.0f) || (t == 0);
            if (any_grow) {
                const float dl = (t == 0) ? mx : fmaxf(mx, 0.f);
                m += dl;
#pragma unroll
                for (int r = 0; r < 16; ++r) { p0[r] -= dl; p1[r] -= dl; negm[r] = -m; }
                const float alpha = __builtin_amdgcn_exp2f(-dl);
                lsum *= alpha;
                if (hi == 0) wsf[r32] = alpha;
#pragma unroll
                for (int r = 0; r < 16; ++r) { const float a = wsf[crow(r, hi)];
#pragma unroll
                    for (int dh = 0; dh < 4; ++dh) o[dh][r] *= a; }
            }
            float sa = 0.f, sb = 0.f, sc = 0.f, sd = 0.f;
#pragma unroll
            for (int r = 0; r < 16; r += 2) { p0[r] = __builtin_amdgcn_exp2f(p0[r]); p0[r + 1] = __builtin_amdgcn_exp2f(p0[r + 1]); p1[r] = __builtin_amdgcn_exp2f(p1[r]); p1[r + 1] = __builtin_amdgcn_exp2f(p1[r + 1]);
                sa += p0[r]; sb += p0[r + 1]; sc += p1[r]; sd += p1[r + 1]; }
            lsum += (sa + sb) + (sc + sd);
            }
            pw[0] = (u32x4){cvtpk(p0[0], p0[1]), cvtpk(p0[2], p0[3]), cvtpk(p0[4], p0[5]), cvtpk(p0[6], p0[7])};
            pw[1] = (u32x4){cvtpk(p0[8], p0[9]), cvtpk(p0[10], p0[11]), cvtpk(p0[12], p0[13]), cvtpk(p0[14], p0[15])};
            pw[2] = (u32x4){cvtpk(p1[0], p1[1]), cvtpk(p1[2], p1[3]), cvtpk(p1[4], p1[5]), cvtpk(p1[6], p1[7])};
            pw[3] = (u32x4){cvtpk(p1[8], p1[9]), cvtpk(p1[10], p1[11]), cvtpk(p1[12], p1[13]), cvtpk(p1[14], p1[15])};
        }
        __builtin_amdgcn_s_setprio(0);
        STAMP(ts1_);
        if (c == 0) { if (t + 2 < NT) asm volatile("s_waitcnt vmcnt(4)" ::: "memory"); else VMWAIT0(); }
        DBAR();
        STAMP(ts2_);
        if (!(ABL & 1)) if (t + 3 < NT) DIFF_DMA(t + 3, s3);
        if (act) {
            DIFF_PV(0, va_lo, va_hi);
            DIFF_VF(va_lo, va_hi, s0, 2);
            DIFF_PV(1, vb_lo, vb_hi);
            DIFF_VF(vb_lo, vb_hi, s0, 3);
            DIFF_PV(2, va_lo, va_hi);
            DIFF_PV(3, vb_lo, vb_hi);
        }
        if (!(ABL & 16) || t == 0) if (t + 1 < NT && kbase + 64 <= q0w + 31) DIFF_KF(s1);
        STAMP(ts3_);
        if (c == 1) { if (t + 3 < NT) asm volatile("s_waitcnt vmcnt(4)" ::: "memory"); else VMWAIT0(); }
        DBAR();
        { const int tmp = s0; s0 = s1; s1 = s2; s2 = s3; s3 = tmp; }
#if PROBE >= 201 && PROBE <= 219
        STAMP(ts4_);
        if (t + 4 < NT) { tcnt_ += 1;
            tacc_ += (PROBE == 201) ? (ts1_ - ts0_) : (PROBE == 202) ? (ts2_ - ts1_) : (PROBE == 203) ? (ts3_ - ts2_) : (PROBE == 204) ? (ts4_ - ts3_) : (ts4_ - ts0_); }
#endif
    }
#if PROBE >= 201 && PROBE <= 219
    if (wid == 0 && lane == 0 && qb == 63 && b == 0 && h == 0 && tcnt_ > 0) *(float*)(C.ws + WS_SGATE + 140 * 1024) = (float)tacc_ / (float)tcnt_;
#endif
    if (c == 0) DBAR();
#undef DIFF_DMA
#undef DIFF_KF
#undef DIFF_VF
#undef DIFF_PV
    lsum = swapsum(lsum);
    if (hi == 0) wsf[r32] = lsum;
    LAS float* X = (LAS float*)L + wq * 4096 + lane;
    if (c == 1) {
#pragma unroll
        for (int r = 0; r < 16; ++r) { const float rl = 1.0f / wsf[crow(r, hi)];
#pragma unroll
            for (int dh = 0; dh < 4; ++dh) X[(dh * 16 + r) * 64] = o[dh][r] * rl; }
    }
    __syncthreads();
    if (c == 0) {
        char* Cb = (char*)(C.ws + (ABL ? WS_XSS : WS_CAT)) + (size_t)b * SEQ * DM * 2;
        const unsigned co = (unsigned)(((q0w + 4 * hi) * DM + 1280 + h * 128 + r32) * 2);
#pragma unroll
        for (int r = 0; r < 16; ++r) {
            const float rl = 1.0f / wsf[crow(r, hi)];
            float s = 0.f;
#pragma unroll
            for (int dh = 0; dh < 4; ++dh) { const float d = o[dh][r] * rl - lam * X[(dh * 16 + r) * 64]; o[dh][r] = d; s += d * d; }
#pragma unroll
            for (int off = 1; off < 32; off <<= 1) s += __shfl_xor(s, off);
            const float rn = 1.0f / sqrtf(s * (1.f / 128.f) + 1e-5f);
            const unsigned ro = co + (unsigned)(((r & 3) + 8 * (r >> 2)) * DM * 2);
#pragma unroll
            for (int dh = 0; dh < 4; ++dh) *(bf16_t*)(Cb + (ro + dh * 64)) = (bf16_t)f2bf(o[dh][r] * rn);
        }
    }
    __syncthreads();
}

__device__ __forceinline__ void swa_task(Ctx& C, int l, int b, int q0, int head, f32x16 (&o)[2], float (&ssq)[16]) {
    const int lane = C.lane, wid = C.wave, r32 = lane & 31, hi = lane >> 5;
    const char* Pb = (const char*)(C.ws + WS_PROJ) + (size_t)b * SEQ * INC * 2;
    LAS unsigned char* Lw = C.lds + wid * 16384; LAS float* wsf = (LAS float*)(C.lds + LDS_WSF + wid * 256);
    const int kvh = head / 3;
    bf16x8 qr[4];
    { const unsigned qo = (unsigned)(((q0 + r32) * INC + C_QA + head * 64 + hi * 8) * 2);
#pragma unroll
      for (int d0 = 0; d0 < 4; ++d0) qr[d0] = *(const bf16x8*)(Pb + (qo + d0 * 32)); }
    o[0] = f32x16{}; o[1] = f32x16{};
    float m = C.in[IN_SINKS][l * 12 + head] * LOG2E, lsum = (hi == 0) ? 1.f : 0.f;
    const int tlo = (q0 >= 127 ? q0 - 127 : 0) >> 6, thi = (q0 + 31) >> 6;
    const unsigned kofs = (unsigned)((lane * INC + C_KA + kvh * 64) * 2);
    const unsigned vofs = (unsigned)(((lane >> 2) * INC + C_VA + kvh * 64 + (lane & 3) * 8) * 2);
    const unsigned ldsw = (unsigned)(uintptr_t)(unsigned char*)Lw;
    for (int t = tlo; t <= thi; ++t) {
        const char* Pt = Pb + (size_t)t * (64 * INC * 2);
        asm volatile("s_waitcnt lgkmcnt(0)" ::: "memory");
#pragma unroll
        for (int c8 = 0; c8 < 8; ++c8) glds16(Pt + (kofs + c8 * 16), (unsigned)__builtin_amdgcn_readfirstlane(ldsw + c8 * 1024));
#pragma unroll
        for (int i = 0; i < 8; ++i) glds16(Pt + (vofs + (16 * (i & 3) * INC + (i >> 2) * 32) * 2), (unsigned)__builtin_amdgcn_readfirstlane(ldsw + 8192 + i * 1024));
        VMWAIT0();
        attn_tile<2, 2>(o, m, lsum, qr, (lds_cptr)Lw, (lds_cptr)(Lw + 8192), wsf, 64 * t, q0 + r32, lane);
    }
    lsum = swapsum(lsum);
    if (hi == 0) wsf[r32] = lsum;
#pragma unroll
    for (int r = 0; r < 16; ++r) { const float rl = 1.0f / wsf[crow(r, hi)]; o[0][r] *= rl; o[1][r] *= rl; float s = o[0][r] * o[0][r] + o[1][r] * o[1][r];
#pragma unroll
        for (int off = 1; off < 32; off <<= 1) s += __shfl_xor(s, off);
        ssq[r] = s; }
}
__device__ __forceinline__ void swa_store(Ctx& C, int b, int q0, int head, const f32x16 (&o)[2]) {
    const int lane = C.lane, r32 = lane & 31, hi = lane >> 5;
    char* Cb = (char*)(C.ws + WS_CAT) + (size_t)b * SEQ * DM * 2; const LAS float* tot = (const LAS float*)(C.misc + MI_SSQ) + 12 * 32;
    const unsigned co = (unsigned)(((q0 + 4 * hi) * DM + head * 64 + r32) * 2);
#pragma unroll
    for (int r = 0; r < 16; ++r) { const int qq = (r & 3) + 8 * (r >> 2); const float rn = tot[qq + 4 * hi];
        const unsigned ro = co + (unsigned)(qq * DM * 2);
        *(bf16_t*)(Cb + ro) = (bf16_t)f2bf(o[0][r] * rn); *(bf16_t*)(Cb + (ro + 64)) = (bf16_t)f2bf(o[1][r] * rn); }
}
__device__ __forceinline__ void swa_unit(Ctx& C, int l, int b, int jb) {
    const int lane = C.lane, wid = C.wave, r32 = lane & 31, hi = lane >> 5;
    const int q0 = jb * 32;
    LAS float* ssqL = (LAS float*)(C.misc + MI_SSQ);
    f32x16 oa[2], ob[2]; float sa[16], sb[16];
    swa_task(C, l, b, q0, wid, oa, sa);
    if (r32 == 0) {
#pragma unroll
        for (int r = 0; r < 16; ++r) ssqL[wid * 32 + crow(r, hi)] = sa[r]; }
    if (wid < 4) {
        swa_task(C, l, b, q0, 8 + wid, ob, sb);
        if (r32 == 0) {
#pragma unroll
            for (int r = 0; r < 16; ++r) ssqL[(8 + wid) * 32 + crow(r, hi)] = sb[r]; }
    }
    __syncthreads();
    if (C.tid < 32) { float s = 0.f;
#pragma unroll
        for (int hh = 0; hh < 12; ++hh) s += ssqL[hh * 32 + C.tid];
        ssqL[12 * 32 + C.tid] = 1.0f / sqrtf(s * (1.f / 768.f) + 1e-6f); }
    __syncthreads();
    swa_store(C, b, q0, wid, oa);
    if (wid < 4) swa_store(C, b, q0, 8 + wid, ob);
    __syncthreads();
}

__device__ __forceinline__ void pool_unit(Ctx& C, int b, int blk) {
    const int tid = C.tid, s0 = blk * 32;
    const char* Pb = (const char*)(C.ws + WS_PROJ) + (size_t)b * SEQ * INC * 2 + C_UB * 2;
    LAS unsigned char* L = C.lds;
    const int r0 = s0 >= 15 ? s0 - 15 : 0, nrows = s0 + 32 - r0;
    for (int i = tid; i < nrows * 64; i += 512) { const int rr = i >> 6, ch = i & 63;
        *(LAS u32x4*)(L + rr * 1040 + ch * 16) = *(const u32x4*)(Pb + (size_t)(r0 + rr) * (INC * 2) + ch * 16); }
    __syncthreads();
    const int cg8 = tid & 63, ts = tid >> 6, w = 2 << (cg8 >> 4);
    char* Cb = (char*)(C.ws + WS_CAT) + (size_t)b * SEQ * DM * 2 + (768 + 8 * cg8) * 2;
#pragma unroll 1
    for (int i = 0; i < 4; ++i) {
        const int s = s0 + ts * 4 + i, lo = (s - w + 1) > 0 ? (s - w + 1) : 0;
        float acc[8];
#pragma unroll
        for (int j = 0; j < 8; ++j) acc[j] = 0.f;
        u32x4 self = {0, 0, 0, 0};
        for (int sp = lo; sp <= s; ++sp) { const u32x4 v = *(const LAS u32x4*)(L + (sp - r0) * 1040 + cg8 * 16); self = v;
            acc[0] += bf2f(v.x & 0xffffu); acc[1] += bf2f(v.x >> 16); acc[2] += bf2f(v.y & 0xffffu); acc[3] += bf2f(v.y >> 16);
            acc[4] += bf2f(v.z & 0xffffu); acc[5] += bf2f(v.z >> 16); acc[6] += bf2f(v.w & 0xffffu); acc[7] += bf2f(v.w >> 16); }
        const float rc = 1.0f / (float)(s - lo + 1);
        u32x4 ov;
        ov.x = pk2(acc[0] * rc - bf2f(self.x & 0xffffu), acc[1] * rc - bf2f(self.x >> 16)); ov.y = pk2(acc[2] * rc - bf2f(self.y & 0xffffu), acc[3] * rc - bf2f(self.y >> 16));
        ov.z = pk2(acc[4] * rc - bf2f(self.z & 0xffffu), acc[5] * rc - bf2f(self.z >> 16)); ov.w = pk2(acc[6] * rc - bf2f(self.w & 0xffffu), acc[7] * rc - bf2f(self.w >> 16));
        *(u32x4*)(Cb + (size_t)s * (DM * 2)) = ov;
    }
    __syncthreads();
}

#ifndef MIXSELDEF
#define MIXSELDEF 15
#endif
#ifndef MIXSEL
#define MIXSEL 7
#endif
constexpr int NU_DIFF = 2 * 6 * 64, NU_SWA = 2 * 256, NU_POOL = 2 * 256, NU_CONV = 512, CONV_PER = I_EXP / NU_CONV;
constexpr int NU_MIX = NU_DIFF + NU_CONV + NU_SWA + NU_POOL;
static_assert(I_EXP % NU_CONV == 0 && NU_DIFF * 2 == NU_CONV * 3, "queue interleave: 3 attention units : 2 conversion units");
__device__ __forceinline__ void conv_unit(Ctx& C, int l, int j) {
    conv_run<true>(C, l, j * CONV_PER + C.wave, (j + 1) * CONV_PER, 8);
    asm volatile("s_waitcnt vmcnt(0) lgkmcnt(0)" ::: "memory");
    __syncthreads();
}
constexpr int CW_QX = 4096;
constexpr int LQ_DC = 160, LQ_SWA = 64, LQ_POOL = 64, LQ = LQ_DC + LQ_SWA + LQ_POOL;
static_assert(NU_DIFF == 8 * 96 && NU_CONV == 8 * 64 && NU_SWA == 8 * LQ_SWA && NU_POOL == 8 * LQ_POOL, "per-XCD split");
template <int ABL = 0> __device__ __forceinline__ void phase_mixers(Ctx& C, int l, int qslot = -1, int sel = MIXSELDEF) {
    const float lam = ((const float*)(C.ws + WS_LAM))[l];
    unsigned* qbase = (unsigned*)(C.ws + WS_CTL) + CW_QX + 64 * 8 * (qslot < 0 ? l : qslot);
    int qy = (int)((unsigned)__builtin_amdgcn_s_getreg((3 << 11) | 20) & 7u), tries = 0, idx = 0;
    if (C.tid == 0) idx = (int)__hip_atomic_fetch_add(qbase + 64 * qy, 1u, __ATOMIC_RELAXED, __HIP_MEMORY_SCOPE_AGENT);
    for (;;) {
        if (C.tid == 0) {
            while (idx >= LQ && tries < 7) { qy = (qy + 1) & 7; ++tries; idx = (int)__hip_atomic_fetch_add(qbase + 64 * qy, 1u, __ATOMIC_RELAXED, __HIP_MEMORY_SCOPE_AGENT); }
            C.misc[0] = (idx >= LQ) ? -1 : ((qy << 16) | idx);
            if (idx < LQ) idx = (int)__hip_atomic_fetch_add(qbase + 64 * qy, 1u, __ATOMIC_RELAXED, __HIP_MEMORY_SCOPE_AGENT);
        }
        __syncthreads();
        const int uu = C.misc[0];
        __syncthreads();
        if (uu < 0) break;
        const int x = uu >> 16, i = uu & 0xffff;
        { int l_ = C.lane; asm volatile("" : "+v"(l_)); C.lane = l_; C.tid = C.wave * 64 + l_; }
        if (i < LQ_DC) { const int grp = i / 5, k5 = i % 5;
            if (k5 < 3) { if (sel & 1) {
                    const int bh = (k5 < 2) ? x : 8 + (x >> 1), qb = (k5 < 2) ? 63 - 2 * grp - k5 : 63 - 2 * grp - (x & 1);
                    diff_unit<ABL>(C, bh / 6, bh % 6, qb, lam); } }
            else { if (sel & 8) conv_unit(C, l, x * 64 + grp * 2 + (k5 - 3)); } }
        else if (i < LQ_DC + LQ_SWA) { if (sel & 2) { const int v = x * LQ_SWA + (i - LQ_DC); swa_unit(C, l, v >> 8, v & 255); } }
        else { if (sel & 4) { const int v = x * LQ_POOL + (i - LQ_DC - LQ_SWA); pool_unit(C, v >> 8, v & 255); } }
    }
}

constexpr int XT_PITCH = 4112;
__device__ __forceinline__ void phase_router(Ctx& C, int l) {
    const int lane = C.lane, wid = C.wave, tid = C.tid;
    const float* h = C.out; const float* g = C.in[IN_FNORM] + l * DM;
    bf16_t* XS = (bf16_t*)(C.ws + WS_HN); const bf16_t* WR = (const bf16_t*)(C.ws + WS_WR) + (size_t)l * 96 * DM;
    unsigned* cur = (unsigned*)(C.ws + WS_CTL) + CW_CUR + l * 32 * 64;
    int* toke = (int*)(C.ws + WS_TOKE); float* tokg = (float*)(C.ws + WS_TOKG); int* tokp = (int*)(C.ws + WS_TOKP);
    int* rowtok = (int*)(C.ws + WS_ROWTOK); float* rowgate = (float*)(C.ws + WS_ROWGATE);
    LAS unsigned char* L = C.lds;
    for (int unit = C.bid; unit < T / 32; unit += C.G) {
        const int tok0 = unit * 32;
        {
            f32x4 v[4][8];
#pragma unroll
            for (int rr = 0; rr < 4; ++rr) { const f32x4* xr = (const f32x4*)(h + ((size_t)tok0 + wid * 4 + rr) * DM) + lane;
#pragma unroll
                for (int j = 0; j < 8; ++j) v[rr][j] = xr[64 * j]; }
            const f32x4* gr = (const f32x4*)g + lane;
#pragma unroll
            for (int rr = 0; rr < 4; ++rr) {
                const int row = wid * 4 + rr; const size_t m = (size_t)tok0 + row; float s = 0.f;
#pragma unroll
                for (int j = 0; j < 8; ++j) s += (v[rr][j][0] * v[rr][j][0] + v[rr][j][1] * v[rr][j][1]) + (v[rr][j][2] * v[rr][j][2] + v[rr][j][3] * v[rr][j][3]);
                const float rs = 1.0f / sqrtf(wave_sum(s) * (1.f / DM) + 1e-6f);
                u32x2* o = (u32x2*)(XS + m * DM) + lane;
#pragma unroll
                for (int j = 0; j < 8; ++j) { const f32x4 w = v[rr][j] * rs * gr[64 * j]; u32x2 p; p.x = cvtpk(w[0], w[1]); p.y = cvtpk(w[2], w[3]); o[64 * j] = p;
                    *(LAS u32x2*)(L + row * XT_PITCH + (4 * lane + 256 * j) * 2) = p; }
            }
        }
        if (tid < 32) C.misc[MI_LCNT + tid] = 0;
        __syncthreads();
        f32x4 acc[2][3];
#pragma unroll
        for (int rt = 0; rt < 2; ++rt)
#pragma unroll
            for (int ct = 0; ct < 3; ++ct) acc[rt][ct] = (f32x4){0.f, 0.f, 0.f, 0.f};
#pragma unroll 4
        for (int ks = 0; ks < 8; ++ks) {
            const int kk = 256 * wid + 32 * ks + 8 * (lane >> 4);
            bf16x8 a[2];
#pragma unroll
            for (int rt = 0; rt < 2; ++rt) a[rt] = *(const LAS bf16x8*)(L + (16 * rt + (lane & 15)) * XT_PITCH + kk * 2);
#pragma unroll
            for (int ct = 0; ct < 3; ++ct)
#pragma unroll
                for (int hl = 0; hl < 2; ++hl) {
                    const bf16x8 bb = *(const bf16x8*)(WR + (size_t)(hl * 48 + 16 * ct + (lane & 15)) * DM + kk);
#pragma unroll
                    for (int rt = 0; rt < 2; ++rt) acc[rt][ct] = __builtin_amdgcn_mfma_f32_16x16x32_bf16(a[rt], bb, acc[rt][ct], 0, 0, 0);
                }
        }
        __syncthreads();
        LAS float* RED = (LAS float*)L;
#pragma unroll
        for (int rt = 0; rt < 2; ++rt)
#pragma unroll
            for (int ct = 0; ct < 3; ++ct)
#pragma unroll
                for (int q = 0; q < 4; ++q) RED[(wid * 32 + 16 * rt + 4 * (lane >> 4) + q) * 48 + 16 * ct + (lane & 15)] = acc[rt][ct][q];
        __syncthreads();
        LAS float* LG = RED + 8 * 32 * 48;
        for (int i = tid; i < 32 * 48; i += 512) { float sacc = 0.f;
#pragma unroll
            for (int w8 = 0; w8 < 8; ++w8) sacc += RED[w8 * 32 * 48 + i];
            LG[i] = sacc; }
        __syncthreads();
        int e0 = 0, e1 = 0, rk0 = 0, rk1 = 0; float g0 = 0.f, g1 = 0.f;
        if (tid < 32) {
            const LAS float* lg = LG + tid * 48;
            const float* brg = C.in[IN_BRG] + l * 4; const float* bre = C.in[IN_BRE] + l * 32;
            float gl[4]; int gsel = 0; float gm = -__builtin_inff();
#pragma unroll
            for (int j = 0; j < 4; ++j) { gl[j] = lg[j] + brg[j]; if (gl[j] > gm) { gm = gl[j]; gsel = j; } }
            float gs = 0.f;
#pragma unroll
            for (int j = 0; j < 4; ++j) gs += __expf(gl[j] - gm);
            const float pgsel = 1.0f / gs;
            float le[8];
#pragma unroll
            for (int j = 0; j < 8; ++j) le[j] = lg[4 + gsel * 8 + j] + bre[gsel * 8 + j];
            int i0 = 0; float m0 = le[0];
#pragma unroll
            for (int j = 1; j < 8; ++j) if (le[j] > m0) { m0 = le[j]; i0 = j; }
            int i1 = -1; float m1 = -__builtin_inff();
#pragma unroll
            for (int j = 0; j < 8; ++j) if (j != i0 && le[j] > m1) { m1 = le[j]; i1 = j; }
            const float p1 = __expf(m1 - m0), den = 1.0f / (1.0f + p1);
            g0 = pgsel * den; g1 = pgsel * p1 * den;
            e0 = gsel * 8 + i0; e1 = gsel * 8 + i1;
            rk0 = __hip_atomic_fetch_add((LAS int*)(C.misc + MI_LCNT) + e0, 1, __ATOMIC_RELAXED, __HIP_MEMORY_SCOPE_WORKGROUP);
            rk1 = __hip_atomic_fetch_add((LAS int*)(C.misc + MI_LCNT) + e1, 1, __ATOMIC_RELAXED, __HIP_MEMORY_SCOPE_WORKGROUP);
        }
        __syncthreads();
        if (tid < 32) { const int c = C.misc[MI_LCNT + tid]; C.misc[MI_LBASE + tid] = c ? (int)__hip_atomic_fetch_add(cur + tid * 64, (unsigned)c, __ATOMIC_RELAXED, __HIP_MEMORY_SCOPE_AGENT) : 0; }
        __syncthreads();
        if (tid < 32) {
            const int t = tok0 + tid; const int p0 = C.misc[MI_LBASE + e0] + rk0, p1 = C.misc[MI_LBASE + e1] + rk1;
            toke[2 * t] = e0; toke[2 * t + 1] = e1; tokg[2 * t] = g0; tokg[2 * t + 1] = g1; tokp[2 * t] = p0; tokp[2 * t + 1] = p1;
            rowtok[e0 * T + p0] = t; rowtok[e1 * T + p1] = t; rowgate[e0 * T + p0] = g0; rowgate[e1 * T + p1] = g1;
        }
        __syncthreads();
    }
}

__device__ __forceinline__ void phase_gather(Ctx& C, int l) {
    load_starts(C, l);
    const int gw = C.bid * 8 + C.wave, NGW = C.G * 8, lane = C.lane;
    const bf16_t* XS = (const bf16_t*)(C.ws + WS_HN); bf16_t* XSS = (bf16_t*)(C.ws + WS_XSS);
    const int* rowtok = (const int*)(C.ws + WS_ROWTOK); const float* rowgate = (const float*)(C.ws + WS_ROWGATE); float* sgate = (float*)(C.ws + WS_SGATE);
    for (int ci = gw; ci < NASSIGN; ci += NGW) {
        int e = 0;
        while (e < 31 && C.misc[MI_ST + e + 1] <= ci) ++e;
        const int pos = ci - C.misc[MI_ST + e]; const int tok = rowtok[e * T + pos];
        const u32x4* s = (const u32x4*)(XS + (size_t)tok * DM) + lane; u32x4* d = (u32x4*)(XSS + (size_t)ci * DM) + lane;
        const u32x4 a0 = s[0], a1 = s[64], a2 = s[128], a3 = s[192];
        d[0] = a0; d[64] = a1; d[128] = a2; d[192] = a3;
        if (lane == 0) sgate[ci] = rowgate[e * T + pos];
    }
}

#define XB_TMO      128
#define XB_XCNT(j)  (256  + 64 * (j))
#define XB_XSUB(j)  (1280 + 64 * (j))
#define XB_XGEN(j)  (2304 + 64 * (j))
#define XB_TOP      3328
#define XB_TOPGEN   3392
#define XCD_BAR_WORDS 3456
#define XB_SPIN_CAP (1u << 18)

__device__ __forceinline__ unsigned xb_ld(unsigned* p)              { return __hip_atomic_load(p, __ATOMIC_RELAXED, __HIP_MEMORY_SCOPE_AGENT); }
__device__ __forceinline__ unsigned xb_add(unsigned* p, unsigned v) { return __hip_atomic_fetch_add(p, v, __ATOMIC_RELAXED, __HIP_MEMORY_SCOPE_AGENT); }
__device__ __forceinline__ unsigned xb_xcc_id() { return (unsigned)__builtin_amdgcn_s_getreg((3 << 11) | 20) & 0xFu; }
#define XB_SPIN(cond, bar) do { unsigned _sp = 0; while (cond) { __builtin_amdgcn_s_sleep(1); \
    if ((++_sp & 255u) == 0u) { if (xb_ld(&(bar)[XB_TMO])) break; if (_sp > XB_SPIN_CAP) { atomicAdd(&(bar)[XB_TMO], 1u); break; } } } } while (0)

__device__ __forceinline__ int lane_id_v() { int l; asm volatile("v_mbcnt_lo_u32_b32 %0, -1, 0\n\tv_mbcnt_hi_u32_b32 %0, -1, %0" : "=v"(l)); return l; }
struct XcdBarrier {
    int wv;
    unsigned* bar; unsigned x;
    volatile LAS unsigned* st;
};

__device__ __forceinline__ XcdBarrier xcd_barrier_post(unsigned* bar, volatile LAS unsigned* st) {
    XcdBarrier b; b.bar = bar; b.x = xb_xcc_id(); b.st = st;
    if (threadIdx.x == 0) (void)xb_add(&bar[XB_XCNT(b.x)], 1u);
    return b;
}
__device__ __forceinline__ void xcd_barrier_complete(unsigned* bar, unsigned x, unsigned& nloc, unsigned& nx) {
    const unsigned G = gridDim.x * gridDim.y * gridDim.z;
    unsigned sum, cnt, mine, sp = 0u;
    for (;;) {
        sum = 0u; cnt = 0u; mine = 0u;
#pragma unroll 1
        for (unsigned j = 0; j < 16; ++j) { const unsigned c = xb_ld(&bar[XB_XCNT(j)]); sum += c; cnt += (c > 0u) ? 1u : 0u; mine = (j == x) ? c : mine; }
        if (sum == G) break;
        __builtin_amdgcn_s_sleep(1);
        if ((++sp & 255u) == 0u) { if (xb_ld(&bar[XB_TMO])) break; if (sp > XB_SPIN_CAP) { atomicAdd(&bar[XB_TMO], 1u); break; } }
    }
    nloc = mine > 0u ? mine : 1u; nx = cnt > 0u ? cnt : 1u;
}

__device__ __forceinline__ void xcd_barrier(const XcdBarrier& b) {
    asm volatile("s_waitcnt vmcnt(0)" ::: "memory");
    __syncthreads();
    if (b.wv == 0 && lane_id_v() == 0) {
        unsigned* bar = b.bar; unsigned bx = b.x;
        asm volatile("" : "+s"(bar), "+s"(bx));
        __builtin_amdgcn_s_waitcnt(0);
        unsigned nloc = b.st[0], nx = b.st[1];
        if (nloc == 0u) { xcd_barrier_complete(bar, bx, nloc, nx); b.st[0] = nloc; b.st[1] = nx; }
        const unsigned old = xb_add(&bar[XB_XSUB(bx)], 1u);
        const unsigned gen = old / nloc;
        if (old + 1u == (gen + 1u) * nloc) {
            __builtin_amdgcn_fence(__ATOMIC_RELEASE, "agent");
            asm volatile("s_waitcnt vmcnt(0)" ::: "memory");
            const unsigned og = xb_add(&bar[XB_TOP], 1u);
            const unsigned tg = og / nx;
            if (og + 1u == (tg + 1u) * nx) xb_add(&bar[XB_TOPGEN], 1u);
            else XB_SPIN(xb_ld(&bar[XB_TOPGEN]) == tg, bar);
            __builtin_amdgcn_fence(__ATOMIC_ACQUIRE, "agent");
            xb_add(&bar[XB_XGEN(bx)], 1u);
            asm volatile("s_waitcnt vmcnt(0)" ::: "memory");
        } else {
            XB_SPIN(xb_ld(&bar[XB_XGEN(bx)]) == gen, bar);
            __builtin_amdgcn_fence(__ATOMIC_ACQUIRE, "agent");
            asm volatile("s_waitcnt vmcnt(0)" ::: "memory");
        }
    }
    __syncthreads();
}


#ifndef PHASE_MASK
#define PHASE_MASK 0x3ff
#endif
#define HAS(k) (((PHASE_MASK) >> (k)) & 1)
struct Args { const float* in[23]; float* out; unsigned char* ws; int ph_lo, ph_hi; };
constexpr int N_PHASES = 18;

__global__ void __launch_bounds__(512, 2) mega_fwd(Args args) {
    extern __shared__ __attribute__((aligned(16))) unsigned char lds_raw[];
    cg::grid_group grid = cg::this_grid();
    Ctx C;
    C.lds = (LAS unsigned char*)lds_raw; C.misc = (volatile LAS int*)(C.lds + LDS_MISC);
    const int wv0 = __builtin_amdgcn_readfirstlane((int)threadIdx.x >> 6);
    C.tid = threadIdx.x; C.lane = C.tid & 63; C.wave = wv0; C.G = gridDim.x; C.bid = blockIdx.x;
    const int lo = args.ph_lo, hi = args.ph_hi;
    if (threadIdx.x < 64) ((volatile LAS int*)(C.lds + LDS_MISC))[threadIdx.x] = 0;
    __syncthreads();
    XcdBarrier xbar = xcd_barrier_post((unsigned*)(args.ws + WS_CTL) + CW_BAR, (volatile LAS unsigned*)(C.lds + LDS_MISC) + 8);
    xbar.wv = wv0;
    typedef const Args __attribute__((address_space(4)))* KArgP;
#define CTX_REFRESH() do { KArgP ka_ = (KArgP)__builtin_amdgcn_kernarg_segment_ptr(); asm volatile("" : "+s"(ka_)); \
        _Pragma("unroll") for (int i_ = 0; i_ < 23; ++i_) C.in[i_] = ka_->in[i_]; C.out = ka_->out; C.ws = ka_->ws; \
        int w_ = wv0; asm volatile("" : "+s"(w_)); int l_ = lane_id_v(); asm volatile("" : "+v"(l_)); C.wave = w_; C.lane = l_; C.tid = w_ * 64 + l_; } while (0)
#if MK_PER_PHASE
#define IN(k) (lo <= (k) && (k) < hi)
#else
#define IN(k) true
#endif
#define XBAR() do { xbar.bar = (unsigned*)(C.ws + WS_CTL) + CW_BAR; xcd_barrier(xbar); } while (0)
#define SEAM(k) do { if (IN(k) && IN((k) + 1)) XBAR(); } while (0)
#define HN ((bf16_t*)(C.ws + WS_HN))
#define PROJ ((bf16_t*)(C.ws + WS_PROJ))
#define CAT ((bf16_t*)(C.ws + WS_CAT))
#define XSS ((bf16_t*)(C.ws + WS_XSS))
#define ACT ((bf16_t*)(C.ws + WS_ACT))
#define YB ((bf16_t*)(C.ws + WS_PROJ))

#if PROBE >= 300 && PROBE < 400
    unsigned long long ptacc_ = 0, pt0_ = __builtin_amdgcn_s_memrealtime();
#define PH_END(id) do { const unsigned long long n_ = __builtin_amdgcn_s_memrealtime(); if ((PROBE - 300) == (id)) ptacc_ += n_ - pt0_; pt0_ = n_; } while (0)
#else
#define PH_END(id) do {} while (0)
#endif
    if (lo == 0x7fffffff) grid.sync();
    if (HAS(0) && IN(0)) { CTX_REFRESH(); phase_prologue(C); phase_norm<0>(C, C.in[IN_X], nullptr, C.in[IN_ANORM], HN, nullptr); } SEAM(0); PH_END(0);
    if (PROBE == 1) { CTX_REFRESH(); phase_prologue(C); XBAR(); }
    for (int l = 0; l < NLAYER; ++l) {
        const int p0 = 1 + 8 * l;
        if (HAS(1) && IN(p0 + 0)) { CTX_REFRESH();
            if (l > 0) { load_starts(C, l - 1); phase_norm<1>(C, C.out, C.out, C.in[IN_ANORM] + l * DM, HN, nullptr); }
        } if (l > 0) SEAM(p0 + 0); PH_END(p0 + 0);
        if (PROBE == 8 && l == 0) { CTX_REFRESH(); phase_norm<0>(C, C.in[IN_X], nullptr, C.in[IN_ANORM], HN, nullptr); XBAR(); }
        if (HAS(2) && IN(p0 + 1)) { CTX_REFRESH();
            pg8::Gemm g{HN, (const bf16_t*)(C.ws + WS_WIN) + (size_t)l * INC * DM, T, INC, DM}; pg8::StaticOrder S; S.init(T, INC, C.G, C.bid);
            EpiProj E{PROJ, (const float*)(C.ws + WS_COS), (const float*)(C.ws + WS_SIN)};
            pg8::gemm_phase<EpiProj, pg8::StaticOrder, true, true>(C.lds, g, S, E, C.tid);
        } SEAM(p0 + 1); PH_END(p0 + 1);
        if (PROBE == 2 && l == 0) { CTX_REFRESH();
            pg8::Gemm g{HN, (const bf16_t*)(C.ws + WS_WIN) + (size_t)l * INC * DM, T, INC, DM}; pg8::StaticOrder S; S.init(T, INC, C.G, C.bid);
            EpiProj E{PROJ, (const float*)(C.ws + WS_COS), (const float*)(C.ws + WS_SIN)};
            pg8::gemm_phase<EpiProj, pg8::StaticOrder, true, true>(C.lds, g, S, E, C.tid); XBAR(); }
        if (HAS(3) && IN(p0 + 2)) { CTX_REFRESH(); phase_mixers(C, l); } SEAM(p0 + 2); PH_END(p0 + 2);
        if (PROBE >= 30 && PROBE <= 37 && l == 0) { CTX_REFRESH(); phase_mixers(C, l, 2, PROBE - 30); XBAR(); }
#if PROBE >= 100 && PROBE < 200
        if (l == 0) { CTX_REFRESH(); phase_mixers<128 | (PROBE - 100)>(C, l, 2, 1); XBAR(); }
#endif
        if (HAS(4) && IN(p0 + 3)) { CTX_REFRESH();
            pg8::Gemm g{CAT, (const bf16_t*)(C.ws + WS_WOUT) + (size_t)l * DM * DM, T, DM, DM}; pg8::StaticOrder S; S.init(T, DM, C.G, C.bid);
            EpiResid E{l == 0 ? C.in[IN_X] : C.out, C.out};
            pg8::gemm_phase<EpiResid, pg8::StaticOrder, true, true>(C.lds, g, S, E, C.tid);
        } SEAM(p0 + 3); PH_END(p0 + 3);
        if (PROBE == 4 && l == 0) { CTX_REFRESH();
            pg8::Gemm g{CAT, (const bf16_t*)(C.ws + WS_WOUT) + (size_t)l * DM * DM, T, DM, DM}; pg8::StaticOrder S; S.init(T, DM, C.G, C.bid);
            EpiResid E{C.in[IN_X], C.out};
            pg8::gemm_phase<EpiResid, pg8::StaticOrder, true, true>(C.lds, g, S, E, C.tid); XBAR(); }
        if (HAS(5) && IN(p0 + 4)) { CTX_REFRESH(); phase_router(C, l); } SEAM(p0 + 4); PH_END(p0 + 4);
        if (HAS(7) && IN(p0 + 6)) { CTX_REFRESH();
            load_starts(C, l);
            pg8::Gemm g{HN, (const bf16_t*)(C.ws + WS_WGU) + (size_t)l * NEXP * 1024 * DM, T, 1024, DM};
            pg8::MoeOrder S{(const LAS int*)(C.lds + LDS_MISC) + MI_ST, (const LAS int*)(C.lds + LDS_MISC) + MI_TP, 4, 1024, C.G, C.bid};
            LAS int* tk = (LAS int*)(C.lds + LDS_MISC + 4096);
            { const int* rowtok = (const int*)(C.ws + WS_ROWTOK);
#pragma unroll 1
              for (int i = 0; i < 6; ++i) { Unit u; if (!S.next(i, u)) break; if (C.tid < 256) tk[i * 256 + C.tid] = (C.tid < u.valid) ? rowtok[u.e * T + u.pm * 256 + C.tid] : 0; }
              __syncthreads(); }
            EpiGU E{ACT};
            pg8::gemm_phase<EpiGU, pg8::MoeOrder, true, true, true>(C.lds, g, S, E, C.tid, (const LAS int*)tk);
        } SEAM(p0 + 6); PH_END(p0 + 6);
        if (HAS(8) && IN(p0 + 7)) { CTX_REFRESH();
            load_starts(C, l);
            pg8::Gemm g{ACT, (const bf16_t*)(C.ws + WS_WDN) + (size_t)l * NEXP * DM * DFF, NASSIGN, DM, DFF};
            pg8::MoeOrder S{(const LAS int*)(C.lds + LDS_MISC) + MI_ST, (const LAS int*)(C.lds + LDS_MISC) + MI_TP, 8, DM, C.G, C.bid};
            EpiDown E{YB, (const float*)(C.ws + WS_ROWGATE)};
            pg8::gemm_phase<EpiDown, pg8::MoeOrder, true, true>(C.lds, g, S, E, C.tid);
        } SEAM(p0 + 7); PH_END(p0 + 7);
        if (PROBE == 7 && l == 0) { CTX_REFRESH();
            load_starts(C, l);
            pg8::Gemm g{ACT, (const bf16_t*)(C.ws + WS_WDN) + (size_t)l * NEXP * DM * DFF, NASSIGN, DM, DFF};
            pg8::MoeOrder S{(const LAS int*)(C.lds + LDS_MISC) + MI_ST, (const LAS int*)(C.lds + LDS_MISC) + MI_TP, 8, DM, C.G, C.bid};
            EpiDown E{YB, (const float*)(C.ws + WS_ROWGATE)};
            pg8::gemm_phase<EpiDown, pg8::MoeOrder, true, true>(C.lds, g, S, E, C.tid); XBAR(); }
    }
    if (HAS(9) && IN(17)) { CTX_REFRESH(); load_starts(C, NLAYER - 1); phase_norm<2>(C, C.out, nullptr, C.in[IN_FINAL], nullptr, C.out); }
#if PROBE >= 300 && PROBE < 400
    PH_END(17);
    if (C.bid == 0 && C.wave == 0 && C.lane == 0) { const unsigned long long t0_ = __builtin_amdgcn_s_memrealtime(); while (__builtin_amdgcn_s_memrealtime() - t0_ < ptacc_) __builtin_amdgcn_s_sleep(8); }
#endif
#if PROBE >= 201 && PROBE <= 219
    if (C.bid == 0 && C.tid == 0) { const float v_ = *(volatile float*)(C.ws + WS_SGATE + 140 * 1024); const unsigned long long t0_ = __builtin_amdgcn_s_memrealtime(), dt_ = (unsigned long long)(v_ * 10.f);
        while (__builtin_amdgcn_s_memrealtime() - t0_ < dt_) __builtin_amdgcn_s_sleep(8); }
#endif
#undef IN
#undef SEAM
#undef HN
#undef PROJ
#undef CAT
#undef XSS
#undef ACT
#undef YB
}

extern "C" void kernel_launch(void* const* d_in, const int* in_sizes, int n_in, void* d_out, int out_size, void* d_ws, size_t ws_size, hipStream_t stream) {
    static int grid = 0;
    if (grid == 0) {
        if (n_in != 23 || in_sizes[0] != T * DM || out_size != T * DM || ws_size < WS_END) { fprintf(stderr, "kernel_launch: unexpected shapes (n_in %d, in0 %d, out %d, ws %zu < %zu)\n", n_in, n_in > 0 ? in_sizes[0] : -1, out_size, ws_size, (size_t)WS_END); grid = -1; return; }
        int dev = 0, cus = 0, per_cu = 0;
        hipGetDevice(&dev); hipDeviceGetAttribute(&cus, hipDeviceAttributeMultiprocessorCount, dev);
        if (hipFuncSetAttribute((const void*)mega_fwd, hipFuncAttributeMaxDynamicSharedMemorySize, LDS_BYTES) != hipSuccess) { fprintf(stderr, "kernel_launch: hipFuncSetAttribute failed\n"); grid = -1; return; }
        if (hipOccupancyMaxActiveBlocksPerMultiprocessor(&per_cu, (const void*)mega_fwd, 512, LDS_BYTES) != hipSuccess || per_cu < 1) { fprintf(stderr, "kernel_launch: occupancy query says %d blocks per CU\n", per_cu); per_cu = 1; }
        (void)hipGetLastError();
        grid = cus * 1;
        fprintf(stderr, "kernel_launch: %d CUs, occupancy %d/CU, grid %d\n", cus, per_cu, grid);
    }
    if (grid < 0) return;
    hipMemsetAsync((char*)d_ws + WS_CTL, 0, CTL_ZERO_BYTES, stream);
    Args a{};
    for (int i = 0; i < 23; ++i) a.in[i] = (const float*)d_in[i];
    a.out = (float*)d_out; a.ws = (unsigned char*)d_ws;
#if MK_PER_PHASE
    for (int p = 0; p < N_PHASES; ++p) {
        a.ph_lo = p; a.ph_hi = p + 1; void* kargs[] = {&a};
        hipError_t e = hipLaunchCooperativeKernel((const void*)mega_fwd, dim3(grid), dim3(512), kargs, LDS_BYTES, stream);
        if (e != hipSuccess) { fprintf(stderr, "launch of phase %d failed: %s\n", p, hipGetErrorString(e)); break; }
    }
#else
    a.ph_lo = 0; a.ph_hi = N_PHASES; void* kargs[] = {&a};
    hipError_t e = hipLaunchCooperativeKernel((const void*)mega_fwd, dim3(grid), dim3(512), kargs, LDS_BYTES, stream);
    if (e != hipSuccess) fprintf(stderr, "cooperative launch failed: %s (grid %d)\n", hipGetErrorString(e), grid);
#endif
}
```

```cpp
#include <hip/hip_runtime.h>
#include <hip/hip_cooperative_groups.h>
#include <cstdio>
#include <cstdint>
namespace cg = cooperative_groups;
#ifndef PROBE
#define PROBE 0
#endif
#ifndef MK_PER_PHASE
#define MK_PER_PHASE 0
#endif

namespace pg8 {
#define PG8_LAS __attribute__((address_space(3)))
typedef unsigned short bf16_t;
typedef short bf16x8 __attribute__((ext_vector_type(8)));
typedef float f32x4 __attribute__((ext_vector_type(4)));
typedef unsigned u32x4 __attribute__((ext_vector_type(4)));
constexpr int BM = 256, BK = 64, HALF = 128, HTB = HALF * BK * 2  , STAGE_BYTES = 8 * HTB, NXCD = 8, WGM = 8;

__host__ __device__ __forceinline__ int lds_byte(int r, int c) { const int st = (r >> 4) * 2 + (c >> 5), rr = r & 15, cc = c & 31, ob = rr * 64 + cc * 2; return st * 1024 + (ob ^ (((ob >> 9) & 1) << 5)); }
__host__ __device__ __forceinline__ void stage_rc(int b, int& R, int& C) { const int st = b / 1024, sb = b % 1024, swz = sb ^ (((sb >> 9) & 1) << 5); R = (st >> 1) * 16 + swz / 64; C = (st & 1) * 32 + (swz % 64) / 2; }
__host__ __device__ __forceinline__ int perm32(int rho) { const int n = rho >> 4, i = rho & 15; return 8 * (i >> 2) + 4 * n + (i & 3); }

struct Unit { int am, bn, pm, pn, e, valid; };
struct Gemm { const bf16_t* A; const bf16_t* Bt; int M, N, K; };

struct StaticOrder {
    int nM, nN, nwg, G, c;
    __device__ void init(int M, int N, int G_, int c_) { nM = M / BM; nN = N / BM; nwg = nM * nN; G = G_; c = c_; }
    __device__ bool next(int i, Unit& u) const {
        const long L = (long)i * G + c; if (L >= nwg) return false;
        int wgid = (int)L; { const int q = nwg / NXCD, r = nwg % NXCD, xcd = wgid % NXCD, off = wgid / NXCD; wgid = (xcd < r ? xcd * (q + 1) : r * (q + 1) + (xcd - r) * q) + off; }
        const int nig = WGM * nN, gid = wgid / nig, fm = gid * WGM, gsz = (nM - fm) < WGM ? (nM - fm) : WGM;
        u.pm = fm + ((wgid % nig) % gsz); u.pn = (wgid % nig) / gsz; u.am = u.pm * BM; u.bn = u.pn * BM; u.e = 0; u.valid = BM; return true;
    }
    __device__ __forceinline__ void a_ready(const Unit&) const {}
    __device__ __forceinline__ void done(const Unit&) const {}
};
struct MoeOrder {
    const PG8_LAS int* ST;
    const PG8_LAS int* TP;
    int NP, NB, G, c;
    unsigned* ready;
    int lane, wave;
    __device__ __forceinline__ bool next(int i, Unit& u) const {
#define RFL(x) __builtin_amdgcn_readfirstlane(x)
        const int U = RFL(TP[32]) * NP, CH = (U + NXCD - 1) / NXCD;
        const int x = c % NXCD, j = c / NXCD + (G / NXCD) * i;
        if (j >= CH) return false;
        const int ui = x * CH + j; if (ui >= U) return false;
        const int t = ui / NP, pn = ui % NP;
        int e = 0;
        while (e < 31 && RFL(TP[e + 1]) <= t) ++e;
        const int tpe = RFL(TP[e]), ste = RFL(ST[e]), ste1 = RFL(ST[e + 1]);
        const int mt = t - tpe, cnt = ste1 - ste;
        u.e = e; u.pm = mt; u.pn = pn; u.am = (tpe + mt) * BM  ; u.bn = e * NB + pn * BM; u.valid = (cnt - mt * BM) < BM ? (cnt - mt * BM) : BM; return true;
    }
    __device__ __forceinline__ void a_ready(const Unit&) const {}
    __device__ __forceinline__ void done(const Unit& u) const {
        if (ready) { asm volatile("s_waitcnt vmcnt(0)\n\ts_barrier" ::: "memory");
            if (wave == 0) { __builtin_amdgcn_fence(__ATOMIC_RELEASE, "agent");
                if (lane == 0) __hip_atomic_fetch_add(ready + 16 * (RFL(TP[u.e]) + u.pm), 1u, __ATOMIC_RELAXED, __HIP_MEMORY_SCOPE_AGENT); } }
    }
};
struct MoeQueue {
    const PG8_LAS int* ST; const PG8_LAS int* TP; int NP, NB;
    unsigned* q;
    const unsigned* ready; int need;
    volatile PG8_LAS int* box;
    int tid; mutable int qy;
    __device__ __forceinline__ bool next(int, Unit& u) const {
        const int U = RFL(TP[32]) * NP, CH = (U + NXCD - 1) / NXCD;
        if (tid == 0) { int y = qy, tries = 0, got = -1;
            for (;;) { const int lim = (U - y * CH) < CH ? (U - y * CH) : CH;
                if (lim > 0) { const int idx = (int)__hip_atomic_fetch_add(q + 64 * y, 1u, __ATOMIC_RELAXED, __HIP_MEMORY_SCOPE_AGENT); if (idx < lim) { got = y * CH + idx; break; } }
                if (++tries == NXCD) break; y = (y + 1) & (NXCD - 1); }
            qy = y; box[0] = got; }
        asm volatile("s_waitcnt lgkmcnt(0)\n\ts_barrier" ::: "memory");
        const int ui = RFL(box[0]);
        asm volatile("s_waitcnt lgkmcnt(0)\n\ts_barrier" ::: "memory");
        if (ui < 0) return false;
        const int t = ui / NP, pn = ui % NP;
        int e = 0;
        while (e < 31 && RFL(TP[e + 1]) <= t) ++e;
        const int tpe = RFL(TP[e]), ste = RFL(ST[e]), ste1 = RFL(ST[e + 1]);
        const int mt = t - tpe, cnt = ste1 - ste;
        u.e = e; u.pm = mt; u.pn = pn; u.am = (tpe + mt) * BM  ; u.bn = e * NB + pn * BM; u.valid = (cnt - mt * BM) < BM ? (cnt - mt * BM) : BM; return true;
    }
    __device__ __forceinline__ void a_ready(const Unit& u) const {
        const unsigned* p = ready + 16 * (RFL(TP[u.e]) + u.pm);
        while ((int)__hip_atomic_load(p, __ATOMIC_RELAXED, __HIP_MEMORY_SCOPE_AGENT) < need) __builtin_amdgcn_s_sleep(4);
        asm volatile("" ::: "memory");
    }
    __device__ __forceinline__ void done(const Unit&) const {}
#undef RFL
};

__device__ __forceinline__ unsigned cvt_pk_bf16(float lo, float hi) { unsigned r; asm volatile("v_cvt_pk_bf16_f32 %0, %1, %2" : "=v"(r) : "v"(lo), "v"(hi)); return r; }

template <class Epi, class Sched, bool ALIGN_EPI = false, bool SP2 = false, bool GATHER = false, bool ACOH = false>
__device__ __forceinline__ void gemm_phase(PG8_LAS unsigned char* lds, const Gemm g, const Sched& S, const Epi& E, const int tid, const PG8_LAS int* tk = nullptr) {
    static_assert(SP2 || !GATHER, "gather needs the SP2 loop"); static_assert(SP2 || !ACOH, "coherent A loads are wired into the SP2 loop only");
    const int wid = __builtin_amdgcn_readfirstlane(tid >> 6), lane = tid & 63, wr = wid >> 2, wc = wid & 3, fr = lane & 15, fq = lane >> 4;
    const int K = g.K, nt = K / BK;
    unsigned voffA[2], voffB[2]; int gR[2]; unsigned gC[2];
    { int R, C; stage_rc(tid * 16, R, C); const int Rb = Epi::PERM ? ((R & ~31) + perm32(R & 31)) : R;
      voffA[0] = (unsigned)(R * K + C) * 2u; voffB[0] = (unsigned)(Rb * K + C) * 2u; gR[0] = R; gC[0] = (unsigned)C * 2u;
      voffA[1] = voffA[0] + (unsigned)(64 * K * 2); voffB[1] = voffB[0] + (unsigned)(64 * K * 2); gR[1] = R + 64; gC[1] = gC[0]; }
    const size_t kstep = (size_t)(BK * 2);
    const size_t hstep = (size_t)HALF * K * 2;
    const size_t rowb = (size_t)K * 2;
    const unsigned ldsw = (unsigned)wid * 1024u;
    const int aoff = lds_byte(wr * 64 + fr, fq * 8), boff = lds_byte(wc * 32 + fr, fq * 8);
#define PG8_SA(b, h) (((b) * 2 + (h)) * HTB)
#define PG8_SB(b, h) ((4 + (b) * 2 + (h)) * HTB)
#define PG8_STAGE(bufoff, gbase, voff) do { _Pragma("unroll") for (int _i = 0; _i < 2; ++_i) \
        __builtin_amdgcn_global_load_lds((const unsigned*)((const char*)(gbase) + (size_t)_i * (64 * rowb) + (voff)[0]), (PG8_LAS unsigned*)(lds + (bufoff) + ldsw + _i * 8192), 16, 0, 0); } while (0)
#define PG8_STAGE2(bufoff, gbase, voff) do { _Pragma("unroll") for (int _i = 0; _i < 2; ++_i) \
        __builtin_amdgcn_global_load_lds((const unsigned*)((const char*)(gbase) + (voff)[_i]), (PG8_LAS unsigned*)(lds + (bufoff) + ldsw + _i * 8192), 16, 0, 0); } while (0)
#define PG8_STAGEC(bufoff, gbase, voff) do { _Pragma("unroll") for (int _i = 0; _i < 2; ++_i) \
        __builtin_amdgcn_global_load_lds((const unsigned*)((const char*)(gbase) + (size_t)_i * (64 * rowb) + (voff)[0]), (PG8_LAS unsigned*)(lds + (bufoff) + ldsw + _i * 8192), 16, 0, 17  ); } while (0)
#define PG8_STAGE_A(bufoff, h, ptr, kb, nx) do { if constexpr (ACOH) { PG8_STAGEC(bufoff, ptr, voffA); } else if constexpr (GATHER) { unsigned go_[2]; const int ub_ = ((nx) ? ui + 1 : ui) * 256 + (h) * 128 + gR[0]; \
        go_[0] = (unsigned)tk[ub_] * (unsigned)(K * 2) + gC[0]; go_[1] = (unsigned)tk[ub_ + 64] * (unsigned)(K * 2) + gC[0]; \
        PG8_STAGE2(bufoff, (const char*)g.A + (kb), go_); } else { PG8_STAGE(bufoff, ptr, voffA); } } while (0)
#define PG8_LDA(dst, b, h) do { _Pragma("unroll") for (int m = 0; m < 4; ++m) _Pragma("unroll") for (int k = 0; k < 2; ++k) dst[m][k] = *(const PG8_LAS bf16x8*)(lds + PG8_SA(b, h) + aoff + m * 2048 + k * 1024); } while (0)
#define PG8_LDB(dst, b, h) do { _Pragma("unroll") for (int n = 0; n < 2; ++n) _Pragma("unroll") for (int k = 0; k < 2; ++k) dst[n][k] = *(const PG8_LAS bf16x8*)(lds + PG8_SB(b, h) + boff + n * 2048 + k * 1024); } while (0)
#define PG8_MMA(ai, bj, At, Bt) do { __builtin_amdgcn_s_setprio(1); _Pragma("unroll") for (int m = 0; m < 4; ++m) _Pragma("unroll") for (int n = 0; n < 2; ++n) _Pragma("unroll") for (int k = 0; k < 2; ++k) \
        acc[ai][bj][m][n] = __builtin_amdgcn_mfma_f32_16x16x32_bf16(Bt[n][k], At[m][k], acc[ai][bj][m][n], 0, 0, 0); __builtin_amdgcn_s_setprio(0); } while (0)
#define PG8_WAIT_V(n) asm volatile("s_waitcnt vmcnt(" #n ")" ::: "memory")
#define PG8_WAIT_L(n) asm volatile("s_waitcnt lgkmcnt(" #n ")" ::: "memory")
#define PG8_BAR __builtin_amdgcn_s_barrier()
#define PG8_SCHED __builtin_amdgcn_sched_barrier(0)
    Unit cur, nxt; int ui = 0;
    if (!S.next(0, cur)) return;
    f32x4 acc[2][2][4][2];
#pragma unroll
    for (int a = 0; a < 2; ++a)
#pragma unroll
        for (int b = 0; b < 2; ++b)
#pragma unroll
            for (int m = 0; m < 4; ++m)
#pragma unroll
                for (int n = 0; n < 2; ++n) acc[a][b][m][n] = (f32x4){0.f, 0.f, 0.f, 0.f};
    bf16x8 At[4][2], B0[2][2], B1[2][2];
    const char* cA = (const char*)g.A + (size_t)cur.am * rowb; const char* cB = (const char*)g.Bt + (size_t)cur.bn * rowb;
    S.a_ready(cur);
    if constexpr (SP2) {
        PG8_STAGE(PG8_SB(0, 0), cB, voffB); PG8_STAGE(PG8_SB(0, 1), cB + hstep, voffB); PG8_STAGE_A(PG8_SA(0, 0), 0, cA, 0, false); PG8_STAGE_A(PG8_SA(0, 1), 1, cA + hstep, 0, false);
        if (wr == 1) PG8_BAR;
        PG8_WAIT_V(2); PG8_BAR;
        PG8_STAGE(PG8_SB(1, 0), cB + kstep, voffB); PG8_STAGE_A(PG8_SA(1, 0), 0, cA + kstep, kstep, false); PG8_STAGE(PG8_SB(1, 1), cB + hstep + kstep, voffB);
        PG8_WAIT_V(6); PG8_BAR;
    } else {
        PG8_STAGE(PG8_SB(0, 0), cB, voffB); PG8_STAGE(PG8_SA(0, 0), cA, voffA); PG8_STAGE(PG8_SB(0, 1), cB + hstep, voffB); PG8_STAGE(PG8_SA(0, 1), cA + hstep, voffA);
        if (wr == 1) PG8_BAR;
        PG8_WAIT_V(4); PG8_BAR;
        PG8_STAGE(PG8_SB(1, 0), cB + kstep, voffB); PG8_STAGE(PG8_SA(1, 0), cA + kstep, voffA); PG8_STAGE(PG8_SB(1, 1), cB + hstep + kstep, voffB);
        PG8_WAIT_V(6); PG8_BAR;
    }
    for (;;) {
        const bool has_next = S.next(ui + 1, nxt);
        const char* nA = has_next ? (const char*)g.A + (size_t)nxt.am * rowb : cA; const char* nB = has_next ? (const char*)g.Bt + (size_t)nxt.bn * rowb : cB;
        for (int t = 0; t < nt; t += 2) {
            const bool last = (t == nt - 2);
            const char* a1 = cA + (size_t)(t + 1) * kstep;
            const char* a2 = last ? nA : cA + (size_t)(t + 2) * kstep; const char* b2 = last ? nB : cB + (size_t)(t + 2) * kstep;
            const char* a3 = a2 + kstep; const char* b3 = b2 + kstep;
            const size_t gk2 = last ? 0 : (size_t)(t + 2) * kstep; const bool gnx = last && has_next;
            if (last && has_next) S.a_ready(nxt);
            if constexpr (SP2) {
            PG8_LDB(B0, 0, 0); PG8_LDB(B1, 0, 1); PG8_SCHED; PG8_LDA(At, 0, 0); PG8_STAGE_A(PG8_SA(1, 1), 1, a1 + hstep, (size_t)(t + 1) * kstep, false);
            PG8_WAIT_V(8); PG8_WAIT_L(0); PG8_BAR; PG8_MMA(0, 0, At, B0); PG8_MMA(0, 1, At, B1); PG8_BAR; PG8_SCHED;
            PG8_LDA(At, 0, 1); PG8_STAGE(PG8_SB(0, 0), b2, voffB); PG8_STAGE(PG8_SB(0, 1), b2 + hstep, voffB); PG8_STAGE_A(PG8_SA(0, 0), 0, a2, gk2, gnx);
            PG8_WAIT_V(8); PG8_WAIT_L(0); PG8_BAR; PG8_MMA(1, 0, At, B0); PG8_MMA(1, 1, At, B1); PG8_BAR; PG8_SCHED;
            PG8_LDB(B0, 1, 0); PG8_LDB(B1, 1, 1); PG8_SCHED; PG8_LDA(At, 1, 0); PG8_STAGE_A(PG8_SA(0, 1), 1, a2 + hstep, gk2, gnx);
            PG8_WAIT_V(8); PG8_WAIT_L(0); PG8_BAR; PG8_MMA(0, 0, At, B0); PG8_MMA(0, 1, At, B1); PG8_BAR; PG8_SCHED;
            PG8_LDA(At, 1, 1); PG8_STAGE(PG8_SB(1, 0), b3, voffB); PG8_STAGE(PG8_SB(1, 1), b3 + hstep, voffB); PG8_STAGE_A(PG8_SA(1, 0), 0, a3, gk2 + kstep, gnx);
            PG8_WAIT_V(8); PG8_WAIT_L(0); PG8_BAR; PG8_MMA(1, 0, At, B0); PG8_MMA(1, 1, At, B1); PG8_BAR; PG8_SCHED;
            } else {
            PG8_LDB(B0, 0, 0); PG8_SCHED; PG8_LDA(At, 0, 0); PG8_STAGE(PG8_SA(1, 1), a1 + hstep, voffA);
            PG8_WAIT_L(8); PG8_BAR; PG8_WAIT_L(0); PG8_MMA(0, 0, At, B0); PG8_BAR; PG8_SCHED;
            PG8_LDB(B1, 0, 1); PG8_STAGE(PG8_SB(0, 0), b2, voffB);
            PG8_BAR; PG8_WAIT_L(0); PG8_MMA(0, 1, At, B1); PG8_BAR;
            PG8_LDA(At, 0, 1); PG8_STAGE(PG8_SA(0, 0), a2, voffA);
            PG8_BAR; PG8_WAIT_L(0); PG8_MMA(1, 0, At, B0); PG8_BAR; PG8_SCHED;
            PG8_STAGE(PG8_SB(0, 1), b2 + hstep, voffB);
            PG8_WAIT_V(6); PG8_BAR; PG8_MMA(1, 1, At, B1); PG8_BAR;
            PG8_LDB(B0, 1, 0); PG8_SCHED; PG8_LDA(At, 1, 0); PG8_STAGE(PG8_SA(0, 1), a2 + hstep, voffA);
            PG8_WAIT_L(8); PG8_BAR; PG8_WAIT_L(0); PG8_MMA(0, 0, At, B0); PG8_BAR; PG8_SCHED;
            PG8_LDB(B1, 1, 1); PG8_STAGE(PG8_SB(1, 0), b3, voffB);
            PG8_BAR; PG8_WAIT_L(0); PG8_MMA(0, 1, At, B1); PG8_BAR;
            PG8_LDA(At, 1, 1); PG8_STAGE(PG8_SA(1, 0), a3, voffA);
            PG8_BAR; PG8_WAIT_L(0); PG8_MMA(1, 0, At, B0); PG8_BAR; PG8_SCHED;
            PG8_STAGE(PG8_SB(1, 1), b3 + hstep, voffB);
            PG8_WAIT_V(6); PG8_BAR; PG8_MMA(1, 1, At, B1); PG8_BAR;
            }
        }
        if constexpr (ALIGN_EPI) { if (wr == 0) PG8_BAR; }
        if constexpr (!Epi::AFTER_DRAIN) { E(acc, cur, wr, wc, fr, fq); S.done(cur); }
        if (!has_next) break;
#pragma unroll
        for (int a = 0; a < 2; ++a)
#pragma unroll
            for (int b = 0; b < 2; ++b)
#pragma unroll
                for (int m = 0; m < 4; ++m)
#pragma unroll
                    for (int n = 0; n < 2; ++n) acc[a][b][m][n] = (f32x4){0.f, 0.f, 0.f, 0.f};
        cur = nxt; cA = nA; cB = nB; ++ui;
        if constexpr (ALIGN_EPI) { if (wr == 1) PG8_BAR; }
    }
    PG8_WAIT_V(0);
    if constexpr (!ALIGN_EPI) { if (wr == 0) PG8_BAR; }
    PG8_BAR;
    if constexpr (Epi::AFTER_DRAIN) { E.fused(acc, cur, wr, wc, fr, fq, lds, wid, lane); S.done(cur); }
#undef PG8_SA
#undef PG8_SB
#undef PG8_STAGE
#undef PG8_STAGE2
#undef PG8_STAGEC
#undef PG8_STAGE_A
#undef PG8_LDA
#undef PG8_LDB
#undef PG8_MMA
#undef PG8_WAIT_V
#undef PG8_WAIT_L
#undef PG8_BAR
#undef PG8_SCHED
}
}

#define LAS __attribute__((address_space(3)))
typedef unsigned short bf16_t;
typedef short bf16x8 __attribute__((ext_vector_type(8)));
typedef float f32x4 __attribute__((ext_vector_type(4)));
typedef float f32x16 __attribute__((ext_vector_type(16)));
typedef unsigned u32x4 __attribute__((ext_vector_type(4)));
typedef unsigned u32x2 __attribute__((ext_vector_type(2)));
typedef short s16x4 __attribute__((ext_vector_type(4)));
typedef LAS const char* lds_cptr;
using pg8::Unit;

constexpr int T = 16384, SEQ = 8192, DM = 2048, INC = 4096, NEXP = 32, DFF = 512, NASSIGN = 2 * T, NLAYER = 2;
constexpr float LOG2E = 1.4426950408889634f;
constexpr float C2 = 0.125f * LOG2E;
constexpr int C_QA = 0, C_KA = 768, C_VA = 1024, C_UB = 1280, C_QC = 1792, C_KC = 2560, C_VC = 3328;

constexpr size_t MiB = 1u << 20;
constexpr size_t WS_CTL = 0, CTL_ZERO_BYTES = 1 * MiB;
constexpr size_t WS_COS = 2 * MiB, WS_SIN = 4 * MiB;
constexpr size_t WS_TOKE = 6 * MiB, WS_TOKG = 6 * MiB + 256 * 1024, WS_TOKP = 6 * MiB + 512 * 1024, WS_SGATE = 6 * MiB + 768 * 1024;
constexpr size_t WS_ROWTOK = 8 * MiB, WS_ROWGATE = 10 * MiB, WS_ROWRS = 14 * MiB;
constexpr size_t WS_LAM = 6 * MiB + 1000 * 1024;
constexpr size_t WS_RS = 6 * MiB + 768 * 1024;
constexpr size_t WS_WR = 12 * MiB;
constexpr size_t WS_WIN = 16 * MiB, WS_WOUT = 48 * MiB, WS_WGU = 64 * MiB, WS_WDN = 320 * MiB;
constexpr size_t WS_HN = 448 * MiB, WS_PROJ = 512 * MiB, WS_CAT = 642 * MiB, WS_XSS = 706 * MiB, WS_ACT = 835 * MiB  , WS_END = 876 * MiB;
constexpr int CW_QCTR = 0;
constexpr int CW_CUR = 1024;
constexpr int CW_BAR = 8192;
constexpr int CW_RDY = 16384;
constexpr int CW_DQ = 32768;

constexpr int LDS_WSF = 135168, LDS_MISC = 137216, LDS_BYTES = 147456;
constexpr int MI_ST = 16, MI_TP = 64, MI_LCNT = 128, MI_LBASE = 160, MI_SSQ = 256;
constexpr int LDS_GAINS = LDS_MISC + 1024;

#define LDS_WAIT() asm volatile("s_waitcnt lgkmcnt(0)" ::: "memory")
__device__ __forceinline__ unsigned f2bf(float f) { unsigned u = __builtin_bit_cast(unsigned, f); return (u + 0x7fffu + ((u >> 16) & 1u)) >> 16; }
__device__ __forceinline__ unsigned pk2(float lo, float hi) { return f2bf(lo) | (f2bf(hi) << 16); }
__device__ __forceinline__ float bf2f(unsigned b) { return __builtin_bit_cast(float, b << 16); }
typedef float f32x2_t __attribute__((ext_vector_type(2))); typedef __bf16 bf16x2_t __attribute__((ext_vector_type(2)));
__device__ __forceinline__ unsigned cvtpk(float lo, float hi) { f32x2_t v = {lo, hi}; bf16x2_t b = __builtin_convertvector(v, bf16x2_t); return __builtin_bit_cast(unsigned, b); }
__device__ __forceinline__ float wave_sum(float v) {
#pragma unroll
    for (int o = 1; o < 64; o <<= 1) v += __shfl_xor(v, o);
    return v;
}

struct Ctx {
    const float* in[23]; float* out; unsigned char* ws;
    LAS unsigned char* lds; volatile LAS int* misc;
    int tid, lane, wave, G, bid;
#if PROBE >= 320 && PROBE < 330
    unsigned long long pts[6];
#endif
};
#if PROBE >= 320 && PROBE < 330
#define PT_STAMP(k) C.pts[k] = __builtin_amdgcn_s_memrealtime()
#else
#define PT_STAMP(k) do {} while (0)
#endif
#define IN_X 0
#define IN_POS 1
#define IN_ANORM 2
#define IN_WIN 3
#define IN_SINKS 4
#define IN_BNA 5
#define IN_WPOOL 6
#define IN_PSCALE 7
#define IN_LQ1 8
#define IN_LK1 9
#define IN_LQ2 10
#define IN_LK2 11
#define IN_SUBLN 12
#define IN_WOUT 13
#define IN_FNORM 14
#define IN_WRG 15
#define IN_BRG 16
#define IN_WRE 17
#define IN_BRE 18
#define IN_WG 19
#define IN_WU 20
#define IN_WD 21
#define IN_FINAL 22

struct EpiProj {
    static constexpr bool PERM = true, AFTER_DRAIN = false;
    bf16_t* O; const float* cosT; const float* sinT; const float* RS;
    __device__ __forceinline__ void operator()(const f32x4 (&acc)[2][2][4][2], const Unit& u, int wr, int wc, int fr, int fq) const {
        const int pn = u.pn;
        const bool rope = (0x1F8Fu >> pn) & 1u;
        const float sc = ((0x0387u >> pn) & 1u) ? C2 : 1.f;
        const int row0 = u.pm * 256 + wr * 64 + fr, col0 = pn * 256 + wc * 32 + 8 * fq, fi = 16 * (wc & 1) + 4 * fq;
#pragma unroll
        for (int ai = 0; ai < 2; ++ai)
#pragma unroll
            for (int m = 0; m < 4; ++m) {
                const int row = row0 + ai * 128 + m * 16;
                const float scr = sc * RS[row];
                f32x4 cs = {1.f, 1.f, 1.f, 1.f}, sn = {0.f, 0.f, 0.f, 0.f};
                if (rope) { cs = *(const f32x4*)(cosT + (size_t)row * 32 + fi); sn = *(const f32x4*)(sinT + (size_t)row * 32 + fi); }
                bf16_t* rowp = O + (size_t)row * INC + col0;
#pragma unroll
                for (int bj = 0; bj < 2; ++bj) {
                    const f32x4 v0 = acc[ai][bj][m][0], v1 = acc[ai][bj][m][1];
                    const f32x4 o0 = (v0 * cs - v1 * sn) * scr, o1 = (v1 * cs + v0 * sn) * scr;
                    u32x4 w; w.x = cvtpk(o0[0], o0[1]); w.y = cvtpk(o0[2], o0[3]); w.z = cvtpk(o1[0], o1[1]); w.w = cvtpk(o1[2], o1[3]);
                    *(u32x4*)(rowp + bj * 128) = w;
                }
            }
    }
};
struct EpiResid {
    static constexpr bool PERM = false, AFTER_DRAIN = false;
    const float* src; float* dst;
    __device__ __forceinline__ void operator()(const f32x4 (&acc)[2][2][4][2], const Unit& u, int wr, int wc, int fr, int fq) const {
        const int row0 = u.pm * 256 + wr * 64 + fr, col0 = u.pn * 256 + wc * 32 + 4 * fq;
#pragma unroll
        for (int ai = 0; ai < 2; ++ai)
#pragma unroll
            for (int m = 0; m < 4; ++m) {
                const size_t off = (size_t)(row0 + ai * 128 + m * 16) * DM + col0;
#pragma unroll
                for (int bj = 0; bj < 2; ++bj)
#pragma unroll
                    for (int n = 0; n < 2; ++n) { const f32x4 s = *(const f32x4*)(src + off + bj * 128 + n * 16); *(f32x4*)(dst + off + bj * 128 + n * 16) = s + acc[ai][bj][m][n]; }
            }
    }
};
__device__ __forceinline__ float bflo(unsigned w) { return __builtin_bit_cast(float, w << 16); }
__device__ __forceinline__ float bfhi(unsigned w) { return __builtin_bit_cast(float, w & 0xffff0000u); }
struct EpiResidB {
    static constexpr bool PERM = true, AFTER_DRAIN = false;
    const float* srcf; bf16_t* hb;
    __device__ __forceinline__ void operator()(const f32x4 (&acc)[2][2][4][2], const Unit& u, int wr, int wc, int fr, int fq) const {
        const int row0 = u.pm * 256 + wr * 64 + fr, col0 = u.pn * 256 + wc * 32 + 8 * fq;
        if (srcf) {
#pragma unroll
            for (int ai = 0; ai < 2; ++ai)
#pragma unroll
                for (int m = 0; m < 4; ++m) {
                    const size_t off = (size_t)(row0 + ai * 128 + m * 16) * DM + col0;
#pragma unroll
                    for (int bj = 0; bj < 2; ++bj) {
                        const f32x4 o0 = *(const f32x4*)(srcf + off + bj * 128) + acc[ai][bj][m][0], o1 = *(const f32x4*)(srcf + off + bj * 128 + 4) + acc[ai][bj][m][1];
                        u32x4 w; w.x = cvtpk(o0[0], o0[1]); w.y = cvtpk(o0[2], o0[3]); w.z = cvtpk(o1[0], o1[1]); w.w = cvtpk(o1[2], o1[3]);
                        *(u32x4*)(hb + off + bj * 128) = w;
                    }
                }
        } else {
#pragma unroll
            for (int ai = 0; ai < 2; ++ai)
#pragma unroll
                for (int m = 0; m < 4; ++m) {
                    const size_t off = (size_t)(row0 + ai * 128 + m * 16) * DM + col0;
#pragma unroll
                    for (int bj = 0; bj < 2; ++bj) {
                        const u32x4 r = *(const u32x4*)(hb + off + bj * 128);
                        const f32x4 a0 = acc[ai][bj][m][0], a1 = acc[ai][bj][m][1];
                        u32x4 w; w.x = cvtpk(bflo(r.x) + a0[0], bfhi(r.x) + a0[1]); w.y = cvtpk(bflo(r.y) + a0[2], bfhi(r.y) + a0[3]);
                        w.z = cvtpk(bflo(r.z) + a1[0], bfhi(r.z) + a1[1]); w.w = cvtpk(bflo(r.w) + a1[2], bfhi(r.w) + a1[3]);
                        *(u32x4*)(hb + off + bj * 128) = w;
                    }
                }
        }
    }
};
struct EpiGU {
    static constexpr bool PERM = true, AFTER_DRAIN = false;
    bf16_t* ACT; const float* rowrs;
    __device__ __forceinline__ void operator()(const f32x4 (&acc)[2][2][4][2], const Unit& u, int wr, int wc, int fr, int fq) const {
        const int col0 = u.pn * 128 + wc * 32 + 8 * fq;
#pragma unroll
        for (int ai = 0; ai < 2; ++ai)
#pragma unroll
            for (int m = 0; m < 4; ++m) {
                const int r = ai * 128 + wr * 64 + m * 16 + fr;
                if (r < u.valid) {
                    const float rsv = rowrs[u.e * T + u.pm * 256 + r];
                    float a[8];
#pragma unroll
                    for (int n = 0; n < 2; ++n)
#pragma unroll
                        for (int j = 0; j < 4; ++j) { const float g = acc[ai][0][m][n][j] * rsv, up = acc[ai][1][m][n][j] * rsv; a[n * 4 + j] = g * __builtin_amdgcn_rcpf(1.f + __builtin_amdgcn_exp2f(-g * LOG2E)) * up; }
                    u32x4 w; w.x = cvtpk(a[0], a[1]); w.y = cvtpk(a[2], a[3]); w.z = cvtpk(a[4], a[5]); w.w = cvtpk(a[6], a[7]);
                    *(u32x4*)(ACT + (size_t)(u.am + r) * DFF + col0) = w;
                }
            }
    }
};
struct EpiDown {
    static constexpr bool PERM = true, AFTER_DRAIN = false;
    bf16_t* YB; const float* sgate; const LAS int* ST;
    __device__ __forceinline__ void operator()(const f32x4 (&acc)[2][2][4][2], const Unit& u, int wr, int wc, int fr, int fq) const {
        const int col0 = u.pn * 256 + wc * 32 + 8 * fq, yrow0 = __builtin_amdgcn_readfirstlane(ST[u.e]) + u.pm * 256;
#pragma unroll
        for (int ai = 0; ai < 2; ++ai)
#pragma unroll
            for (int m = 0; m < 4; ++m) {
                const int r = ai * 128 + wr * 64 + m * 16 + fr;
                if (r < u.valid) {
                    const float gt = sgate[u.e * T + u.pm * 256 + r];
                    bf16_t* rowp = YB + (size_t)(yrow0 + r) * DM + col0;
#pragma unroll
                    for (int bj = 0; bj < 2; ++bj) {
                        const f32x4 v0 = acc[ai][bj][m][0] * gt, v1 = acc[ai][bj][m][1] * gt;
                        u32x4 w; w.x = cvtpk(v0[0], v0[1]); w.y = cvtpk(v0[2], v0[3]); w.z = cvtpk(v1[0], v1[1]); w.w = cvtpk(v1[2], v1[3]);
                        *(u32x4*)(rowp + bj * 128) = w;
                    }
                }
            }
    }
};

template <class F> __device__ __forceinline__ void tr_item(const F& f, int K, bf16_t* WT, LAS float* scr, int kb, int nb, int lane) {
    const int k0 = 64 * kb, n0 = 32 * nb;
#pragma unroll 8
    for (int i = 0; i < 32; ++i) { const int kk = 2 * i + (lane >> 5); scr[kk * 33 + (lane & 31)] = f(k0 + kk, n0 + (lane & 31)); }
    LDS_WAIT(); asm volatile("" ::: "memory");
    const int c = lane & 7;
#pragma unroll
    for (int j = 0; j < 4; ++j) { const int n = (lane >> 3) + 8 * j; const LAS float* s = scr + (8 * c) * 33 + n;
        u32x4 o; o.x = pk2(s[0 * 33], s[1 * 33]); o.y = pk2(s[2 * 33], s[3 * 33]); o.z = pk2(s[4 * 33], s[5 * 33]); o.w = pk2(s[6 * 33], s[7 * 33]);
        *(u32x4*)(WT + (size_t)(n0 + n) * K + k0 + 8 * c) = o; }
    LDS_WAIT(); asm volatile("" ::: "memory");
}
__device__ __forceinline__ float lam_init_of(int l) { return l == 0 ? 0.2f : (0.8f - 0.6f * 0.74081822068171788f); }

struct FWin { const float* w;
    __device__ __forceinline__ float operator()(int k, int n) const {
        const int pn = n >> 8; int col = n;
        if ((pn <= 3) || (pn >= 7 && pn <= 12)) { const int cw = n & 63; col = (n & ~63) + 32 * ((cw >> 2) & 1) + 4 * (cw >> 3) + (cw & 3); }
        return w[(size_t)k * INC + col]; } };
struct FWgu { const float* w;
    __device__ __forceinline__ float operator()(int k, int n) const {
        const int col = 128 * (n >> 8) + (n & 127);
        return w[(size_t)k * DFF + col]; } };
struct FWdn { const float* w;
    __device__ __forceinline__ float operator()(int k, int n) const { return w[(size_t)k * DM + n]; } };
struct FWr { const float* wrg; const float* wre;
    __device__ __forceinline__ float operator()(int k, int n) const {
        const int hl = n >= 48, j = hl ? n - 48 : n;
        const bool isg = j < 4, ise = j >= 4 && j < 36;
        const float* base = isg ? wrg + j : wre + (ise ? j - 4 : 0); const int stride = isg ? 4 : 32;
        const float v = (isg || ise) ? base[(size_t)k * stride] : 0.f * base[(size_t)k * stride];
        const float hi = bf2f(f2bf(v)); return hl ? v - hi : v; } };

__device__ __forceinline__ void fold_item(const float* wout, const float* wpool, const float* pscale, bf16_t* WT, LAS float*, int g, int kbh, int nb, int lane) {
    const int l32 = lane & 31, hi = lane >> 5;
    const float* ua = wout + (size_t)(768 + g * 128) * DM + 64 * nb;
    const float* ub = wpool + ((size_t)g * 128 + 64 * kbh) * 128;
    const float* ps = pscale + g * 128;
    const unsigned oa = (unsigned)(hi * DM + l32), ob = (unsigned)(l32 * 128 + hi), op = (unsigned)hi;
    f32x16 acc[2][2];
#pragma unroll
    for (int kt = 0; kt < 2; ++kt)
#pragma unroll
        for (int nt = 0; nt < 2; ++nt) acc[kt][nt] = f32x16{};
    float av[2][8], bv[2][8];
#define FOLD_LOAD(A_, B_, c_) do { _Pragma("unroll") for (int ks = 0; ks < 8; ++ks) { const int j0 = 16 * (c_) + 2 * ks; const float pv = (ps + j0)[op]; \
        _Pragma("unroll") for (int t = 0; t < 2; ++t) { A_[t][ks] = (ua + (size_t)j0 * DM + 32 * t)[oa]; B_[t][ks] = (ub + (size_t)(32 * t) * 128 + j0)[ob] * pv; } } } while (0)
    FOLD_LOAD(av, bv, 0);
#pragma unroll 1
    for (int c = 0; c < 8; ++c) {
        float an[2][8], bn[2][8];
        const int cn = c < 7 ? c + 1 : 7;
        FOLD_LOAD(an, bn, cn);
#pragma unroll
        for (int ks = 0; ks < 8; ++ks)
#pragma unroll
            for (int kt = 0; kt < 2; ++kt)
#pragma unroll
                for (int nt = 0; nt < 2; ++nt) acc[kt][nt] = __builtin_amdgcn_mfma_f32_32x32x2f32(av[nt][ks], bv[kt][ks], acc[kt][nt], 0, 0, 0);
#pragma unroll
        for (int ks = 0; ks < 8; ++ks)
#pragma unroll
            for (int t = 0; t < 2; ++t) { av[t][ks] = an[t][ks]; bv[t][ks] = bn[t][ks]; }
    }
#undef FOLD_LOAD
    bf16_t* wt = WT + (size_t)(64 * nb) * DM + 768 + g * 128 + 64 * kbh;
#pragma unroll
    for (int kt = 0; kt < 2; ++kt)
#pragma unroll
        for (int nt = 0; nt < 2; ++nt)
#pragma unroll
            for (int r = 0; r < 16; ++r) (wt + (size_t)(32 * nt + (r & 3) + 8 * (r >> 2)) * DM + 32 * kt)[(unsigned)(4 * hi * DM + l32)] = (bf16_t)f2bf(acc[kt][nt][r]);
}
constexpr int I_FOLD = 4 * 2 * 32, I_WR = 32 * 3, I_SLOW = I_FOLD + I_WR;
constexpr int I_WIN = 32 * 128, I_WOUT = 24 * 64, I_WGU1 = 32 * 32, I_WDN1 = 8 * 64;
constexpr int I_FAST = I_WIN + I_WOUT + NEXP * I_WGU1 + NEXP * I_WDN1;
struct TrDesc { const float* src; const float* sptr; bf16_t* dst; float smul; int N, K; unsigned coloff; int gk; };
constexpr int I_PRO = I_WOUT + I_WIN;
constexpr int I_EXP = NEXP * I_WGU1 + NEXP * I_WDN1;
#define BLK2D(q, NBLK, kq_, nb_) do { const int g_ = (q) >> 3, r8_ = (q) & 7; nb_ = (g_ % ((NBLK) / 2)) * 2 + (r8_ & 1); kq_ = (g_ / ((NBLK) / 2)) * 4 + (r8_ >> 1); } while (0)
__device__ __forceinline__ TrDesc tr_mk(Ctx& C, int l, int r, int lane) {
    const int rr = lane >> 3, cc = lane & 7, nl = lane & 31, kh = lane >> 5;
    TrDesc d; d.sptr = nullptr; d.smul = 1.f; d.gk = 2048;
    int kb, nb, n;
    if (r < I_WOUT) { int kq; BLK2D(r, 64, kq, nb); kb = kq < 12 ? kq : kq + 8; n = 32 * nb + nl;
        d.src = C.in[IN_WOUT] + (size_t)l * DM * DM; d.N = DM; d.K = DM; d.coloff = (unsigned)n * 4u; d.dst = (bf16_t*)(C.ws + WS_WOUT) + (size_t)l * DM * DM;
        if (kb < 12) d.sptr = C.in[IN_BNA] + l * 768 + 64 * kb + 32 * kh; else { d.sptr = C.in[IN_SUBLN] + l * 128 + ((64 * kb - 1280) & 127) + 32 * kh; d.smul = 1.f - lam_init_of(l); } }
    else if ((r -= I_WOUT) < I_WIN) { BLK2D(r, 128, kb, nb); n = 32 * nb + nl; const int pn = n >> 8; int col = n;
        if ((pn <= 3) || (pn >= 7 && pn <= 12)) { const int cw = n & 63; col = (n & ~63) + 32 * ((cw >> 2) & 1) + 4 * (cw >> 3) + (cw & 3); }
        d.src = C.in[IN_WIN] + (size_t)l * DM * INC; d.N = INC; d.K = DM; d.coloff = (unsigned)col * 4u; d.dst = (bf16_t*)(C.ws + WS_WIN) + (size_t)l * INC * DM;
        d.sptr = C.in[IN_ANORM] + l * DM + 64 * kb + 32 * kh; }
    else if ((r -= I_WIN) < NEXP * I_WGU1) { const int e = r / I_WGU1, q = r % I_WGU1; BLK2D(q, 32, kb, nb); n = 32 * nb + nl; const size_t eo = ((size_t)l * NEXP + e) * DM * DFF;
        d.src = ((nb & 4) ? C.in[IN_WU] : C.in[IN_WG]) + eo; d.N = DFF; d.K = DM; d.coloff = (unsigned)(128 * (n >> 8) + (n & 127)) * 4u; d.dst = (bf16_t*)(C.ws + WS_WGU) + ((size_t)l * NEXP + e) * 1024 * DM; d.gk = 64 * kb + 32 * kh; }
    else { r -= NEXP * I_WGU1; const int e = r / I_WDN1, q = r % I_WDN1; BLK2D(q, 64, kb, nb); n = 32 * nb + nl;
        d.src = C.in[IN_WD] + ((size_t)l * NEXP + e) * DFF * DM; d.N = DM; d.K = DFF; d.coloff = (unsigned)n * 4u; d.dst = (bf16_t*)(C.ws + WS_WDN) + ((size_t)l * NEXP + e) * DM * DFF; d.gk = 2048; }
    d.src += (size_t)(64 * kb + 32 * kh) * d.N;
    d.dst += (size_t)(32 * nb + rr) * d.K + 64 * kb + 8 * cc;
    return d;
}
#undef BLK2D
#define TR_LOAD(v, d) do { const char* rp_ = (const char*)(d).src + (d).coloff; const size_t rs_ = (size_t)(d).N * 4; _Pragma("unroll") for (int j = 0; j < 32; ++j) v[j] = __builtin_nontemporal_load((const float*)(rp_ + j * rs_)); } while (0)
#define TR_STORE(v, d) do { if (!EXPERT) if ((d).sptr) { const f32x4* sp_ = (const f32x4*)(d).sptr; _Pragma("unroll") for (int j4 = 0; j4 < 8; ++j4) { const f32x4 gg_ = sp_[j4] * (d).smul; v[4 * j4] *= gg_[0]; v[4 * j4 + 1] *= gg_[1]; v[4 * j4 + 2] *= gg_[2]; v[4 * j4 + 3] *= gg_[3]; } }     \
        if (EXPERT) { const LAS f32x4* gp_ = (const LAS f32x4*)((const LAS float*)(C.lds + LDS_GAINS) + (d).gk);     \
            _Pragma("unroll") for (int j4 = 0; j4 < 8; ++j4) { const f32x4 gg_ = gp_[j4]; v[4 * j4] *= gg_[0]; v[4 * j4 + 1] *= gg_[1]; v[4 * j4 + 2] *= gg_[2]; v[4 * j4 + 3] *= gg_[3]; } } \
        _Pragma("unroll") for (int c = 0; c < 4; ++c) { u32x4 o; o.x = cvtpk(v[8 * c], v[8 * c + 1]); o.y = cvtpk(v[8 * c + 2], v[8 * c + 3]); o.z = cvtpk(v[8 * c + 4], v[8 * c + 5]); o.w = cvtpk(v[8 * c + 6], v[8 * c + 7]); \
            *(LAS u32x4*)(sc_ + nl * 144 + kh * 64 + c * 16) = o; } \
        LDS_WAIT(); asm volatile("" ::: "memory"); \
        _Pragma("unroll") for (int g = 0; g < 4; ++g) { const u32x4 o = *(const LAS u32x4*)(sc_ + (8 * g + rr) * 144 + cc * 16); *(u32x4*)((d).dst + (size_t)(8 * g) * (d).K) = o; } \
        LDS_WAIT(); asm volatile("" ::: "memory"); } while (0)
template <bool EXPERT> __device__ __forceinline__ void conv_run(Ctx& C, int lfix, int i0, int i1, int stride) {
    const int lane = C.lane, rr = lane >> 3, cc = lane & 7, nl = lane & 31, kh = lane >> 5;
    LAS unsigned char* sc_ = C.lds + C.wave * 16384;
#define TR_MK(i) (EXPERT ? tr_mk(C, lfix, I_PRO + (i), lane) : tr_mk(C, (i) / I_PRO, (i) % I_PRO, lane))
    float vA[32], vB[32]; TrDesc dA, dB;
    int it = i0;
    if (it >= i1) return;
    dA = TR_MK(it); TR_LOAD(vA, dA);
    for (;;) {
        const int itB = it + stride; const bool hB = itB < i1;
        dB = TR_MK(hB ? itB : it); TR_LOAD(vB, dB);
        TR_STORE(vA, dA);
        if (!hB) break;
        it = itB + stride; const bool hA = it < i1;
        dA = TR_MK(hA ? it : itB); TR_LOAD(vA, dA);
        TR_STORE(vB, dB);
        if (!hA) break;
    }
#undef TR_MK
}
#undef TR_LOAD
#undef TR_STORE
__device__ __forceinline__ void phase_prologue(Ctx& C) {
    const int gw = C.bid * 8 + C.wave, NGW = C.G * 8;
    PT_STAMP(0);
    PT_STAMP(1);
    conv_run<false>(C, 0, gw, NLAYER * I_PRO, NGW);
    PT_STAMP(2);
    if (C.bid == 0 && C.wave == 0) {
        for (int l = 0; l < NLAYER; ++l) { const int i = C.lane;
            const float s1 = wave_sum(C.in[IN_LQ1][l * 64 + i] * C.in[IN_LK1][l * 64 + i]), s2 = wave_sum(C.in[IN_LQ2][l * 64 + i] * C.in[IN_LK2][l * 64 + i]);
            if (i == 0) ((float*)(C.ws + WS_LAM))[l] = __expf(s1) - __expf(s2) + lam_init_of(l); } }
    float* cosT = (float*)(C.ws + WS_COS); float* sinT = (float*)(C.ws + WS_SIN); const int* pos = (const int*)C.in[IN_POS];
    for (int i = C.bid * 512 + C.tid; i < T * 32; i += C.G * 512) {
        const int tok = i >> 5, fi = i & 31;
        double inv = 1.0; for (int q = 0; q < fi; ++q) inv *= 0.74989420933245582;
        const double rev = (double)pos[tok] * inv * 0.15915494309189535;
        const float fr = (float)(rev - __builtin_floor(rev));
        cosT[i] = __builtin_amdgcn_cosf(fr); sinT[i] = __builtin_amdgcn_sinf(fr);
    }
    PT_STAMP(3);
}

__device__ __forceinline__ void load_starts(Ctx& C, int l) {
    const unsigned* cur = (const unsigned*)(C.ws + WS_CTL) + CW_CUR + l * 32 * 64;
    if (C.tid < NEXP) C.misc[MI_LCNT + C.tid] = (int)__hip_atomic_load(cur + C.tid * 64, __ATOMIC_RELAXED, __HIP_MEMORY_SCOPE_AGENT);
    __syncthreads();
    if (C.tid == 0) { int s = 0, tp = 0;
        for (int e = 0; e < NEXP; ++e) { C.misc[MI_ST + e] = s; C.misc[MI_TP + e] = tp; const int c = C.misc[MI_LCNT + e]; s += c; tp += (c + 255) >> 8; }
        C.misc[MI_ST + NEXP] = s; C.misc[MI_TP + NEXP] = tp; }
    __syncthreads();
}
template <int MODE> __device__ __forceinline__ void phase_norm(Ctx& C, const float* src, float* dsth, const float* g, bf16_t* hn, float* outf) {
    const int gw = C.bid * 8 + C.wave, NGW = C.G * 8, lane = C.lane;
    const bf16_t* YB = (const bf16_t*)(C.ws + WS_PROJ);
    const int* toke = (const int*)(C.ws + WS_TOKE); const int* tokp = (const int*)(C.ws + WS_TOKP);
    int en0 = 0, en1 = 0, pn0 = 0, pn1 = 0;
    if (MODE >= 1 && gw < T) { en0 = toke[2 * gw]; en1 = toke[2 * gw + 1]; pn0 = tokp[2 * gw]; pn1 = tokp[2 * gw + 1]; }
    for (int m = gw; m < T; m += NGW) {
        const f32x4* xr = (const f32x4*)(src + (size_t)m * DM) + lane;
        f32x4 v[8];
#pragma unroll
        for (int j = 0; j < 8; ++j) v[j] = xr[64 * j];
        if (MODE >= 1) {
            const int r0 = C.misc[MI_ST + en0] + pn0, r1 = C.misc[MI_ST + en1] + pn1;
            { const int mn = (m + NGW < T) ? m + NGW : m; en0 = toke[2 * mn]; en1 = toke[2 * mn + 1]; pn0 = tokp[2 * mn]; pn1 = tokp[2 * mn + 1]; }
            const u32x2* y0 = (const u32x2*)(YB + (size_t)r0 * DM) + lane; const u32x2* y1 = (const u32x2*)(YB + (size_t)r1 * DM) + lane;
#pragma unroll
            for (int j = 0; j < 8; ++j) { const u32x2 a = y0[64 * j], b = y1[64 * j];
                v[j][0] += bf2f(a.x & 0xffffu) + bf2f(b.x & 0xffffu); v[j][1] += bf2f(a.x >> 16) + bf2f(b.x >> 16);
                v[j][2] += bf2f(a.y & 0xffffu) + bf2f(b.y & 0xffffu); v[j][3] += bf2f(a.y >> 16) + bf2f(b.y >> 16); }
        }
        if (MODE == 1) { f32x4* hr = (f32x4*)(dsth + (size_t)m * DM) + lane;
#pragma unroll
            for (int j = 0; j < 8; ++j) hr[64 * j] = v[j]; }
        float s = 0.f;
#pragma unroll
        for (int j = 0; j < 8; ++j) s += (v[j][0] * v[j][0] + v[j][1] * v[j][1]) + (v[j][2] * v[j][2] + v[j][3] * v[j][3]);
        const float rs = 1.0f / sqrtf(wave_sum(s) * (1.f / DM) + 1e-6f);
        const f32x4* gr = (const f32x4*)g + lane;
        if (MODE == 2) { f32x4* o = (f32x4*)(outf + (size_t)m * DM) + lane;
#pragma unroll
            for (int j = 0; j < 8; ++j) o[64 * j] = v[j] * rs * gr[64 * j]; }
        else if (MODE == 0) { u32x2* o = (u32x2*)(hn + (size_t)m * DM) + lane;
#pragma unroll
            for (int j = 0; j < 8; ++j) { u32x2 p; p.x = cvtpk(v[j][0], v[j][1]); p.y = cvtpk(v[j][2], v[j][3]); o[64 * j] = p; }
            if (lane == 0) ((float*)(C.ws + WS_RS))[m] = rs; }
        else { u32x2* o = (u32x2*)(hn + (size_t)m * DM) + lane;
#pragma unroll
            for (int j = 0; j < 8; ++j) { const f32x4 w = v[j] * rs * gr[64 * j]; u32x2 p; p.x = cvtpk(w[0], w[1]); p.y = cvtpk(w[2], w[3]); o[64 * j] = p; } }
    }
}

__device__ __forceinline__ void phase_stream0(Ctx& C, const float* src, bf16_t* hb) {
    const int gw = C.bid * 8 + C.wave, NGW = C.G * 8, lane = C.lane;
    float* RS = (float*)(C.ws + WS_RS);
    for (int m0 = gw; m0 < T; m0 += 4 * NGW) {
        f32x4 v[4][8];
#pragma unroll
        for (int q = 0; q < 4; ++q) { const int m = (m0 + q * NGW < T) ? m0 + q * NGW : m0; const f32x4* xr = (const f32x4*)(src + (size_t)m * DM) + lane;
#pragma unroll
            for (int j = 0; j < 8; ++j) v[q][j] = __builtin_nontemporal_load(xr + 64 * j); }
#pragma unroll
        for (int q = 0; q < 4; ++q) { const int m = m0 + q * NGW; if (m >= T) break;
            float sq = 0.f;
#pragma unroll
            for (int j = 0; j < 8; ++j) sq += (v[q][j][0] * v[q][j][0] + v[q][j][1] * v[q][j][1]) + (v[q][j][2] * v[q][j][2] + v[q][j][3] * v[q][j][3]);
            const float rs = 1.0f / sqrtf(wave_sum(sq) * (1.f / DM) + 1e-6f);
            u32x2* o = (u32x2*)(hb + (size_t)m * DM) + lane;
#pragma unroll
            for (int j = 0; j < 8; ++j) { u32x2 p; p.x = cvtpk(v[q][j][0], v[q][j][1]); p.y = cvtpk(v[q][j][2], v[q][j][3]); o[64 * j] = p; }
            if (lane == 0) RS[m] = rs; }
    }
}

template <int MODE> __device__ __forceinline__ void phase_combine(Ctx& C, bf16_t* hb, const float* g, bf16_t* hn, float* outf) {
    const int gw = C.bid * 8 + C.wave, NGW = C.G * 8, lane = C.lane;
    const bf16_t* YB = (const bf16_t*)(C.ws + WS_PROJ);
    const int* toke = (const int*)(C.ws + WS_TOKE); const int* tokp = (const int*)(C.ws + WS_TOKP);
    int en[2][2], pn[2][2];
#pragma unroll
    for (int q = 0; q < 2; ++q) { const int mq = (gw + q * NGW < T) ? gw + q * NGW : 0; en[q][0] = toke[2 * mq]; en[q][1] = toke[2 * mq + 1]; pn[q][0] = tokp[2 * mq]; pn[q][1] = tokp[2 * mq + 1]; }
    for (int m0 = gw; m0 < T; m0 += 2 * NGW) {
        const bool two = m0 + NGW < T;
        u32x4 hv[2][4], ya[2][4], yb[2][4];
#pragma unroll
        for (int q = 0; q < 2; ++q) { const int m = (q == 0 || two) ? m0 + q * NGW : m0;
            const u32x4* xr = (const u32x4*)(hb + (size_t)m * DM) + lane;
#pragma unroll
            for (int j = 0; j < 4; ++j) hv[q][j] = xr[64 * j];
            const int r0 = C.misc[MI_ST + en[q][0]] + pn[q][0], r1 = C.misc[MI_ST + en[q][1]] + pn[q][1];
            const u32x4* y0 = (const u32x4*)(YB + (size_t)r0 * DM) + lane; const u32x4* y1 = (const u32x4*)(YB + (size_t)r1 * DM) + lane;
#pragma unroll
            for (int j = 0; j < 4; ++j) { ya[q][j] = y0[64 * j]; yb[q][j] = y1[64 * j]; } }
#pragma unroll
        for (int q = 0; q < 2; ++q) { const int mn0 = m0 + (2 + q) * NGW, mn = mn0 < T ? mn0 : m0; en[q][0] = toke[2 * mn]; en[q][1] = toke[2 * mn + 1]; pn[q][0] = tokp[2 * mn]; pn[q][1] = tokp[2 * mn + 1]; }
#pragma unroll
        for (int q = 0; q < 2; ++q) {
            if (q == 1 && !two) break;
            const int m = m0 + q * NGW;
            float v[4][8];
#pragma unroll
            for (int j = 0; j < 4; ++j)
#pragma unroll
                for (int e = 0; e < 4; ++e) { v[j][2 * e] = bflo(hv[q][j][e]) + (bflo(ya[q][j][e]) + bflo(yb[q][j][e])); v[j][2 * e + 1] = bfhi(hv[q][j][e]) + (bfhi(ya[q][j][e]) + bfhi(yb[q][j][e])); }
            if (MODE == 1) { u32x4* hr = (u32x4*)(hb + (size_t)m * DM) + lane;
#pragma unroll
                for (int j = 0; j < 4; ++j) { u32x4 p; p.x = cvtpk(v[j][0], v[j][1]); p.y = cvtpk(v[j][2], v[j][3]); p.z = cvtpk(v[j][4], v[j][5]); p.w = cvtpk(v[j][6], v[j][7]); hr[64 * j] = p; } }
            float s = 0.f;
#pragma unroll
            for (int j = 0; j < 4; ++j)
#pragma unroll
                for (int e = 0; e < 8; e += 2) s += v[j][e] * v[j][e] + v[j][e + 1] * v[j][e + 1];
            const float rs = 1.0f / sqrtf(wave_sum(s) * (1.f / DM) + 1e-6f);
            const f32x4* gr = (const f32x4*)g + 2 * lane;
            if (MODE == 2) { f32x4* o = (f32x4*)(outf + (size_t)m * DM) + 2 * lane;
#pragma unroll
                for (int j = 0; j < 4; ++j) { const f32x4 g0 = gr[128 * j], g1 = gr[128 * j + 1];
                    f32x4 w0 = {v[j][0], v[j][1], v[j][2], v[j][3]}, w1 = {v[j][4], v[j][5], v[j][6], v[j][7]};
                    o[128 * j] = w0 * rs * g0; o[128 * j + 1] = w1 * rs * g1; } }
            else { if (lane == 0) ((float*)(C.ws + WS_RS))[m] = rs; }
        }
    }
}

__device__ __forceinline__ int crow(int r, int hi) { return (r & 3) + 8 * (r >> 2) + 4 * hi; }
typedef short v4i16_t __attribute__((ext_vector_type(4)));
__device__ __forceinline__ s16x4 vtr(lds_cptr p) { return __builtin_bit_cast(s16x4, __builtin_amdgcn_ds_read_tr16_b64_v4i16((LAS v4i16_t*)p)); }
__device__ __forceinline__ float max3f(float a, float b, float c) { float r; asm("v_max3_f32 %0, %1, %2, %3" : "=v"(r) : "v"(a), "v"(b), "v"(c)); return r; }
__device__ __forceinline__ float swapmax(float v) { auto rr = __builtin_amdgcn_permlane32_swap(__float_as_uint(v), __float_as_uint(v), false, false); return fmaxf(__uint_as_float(rr[0]), __uint_as_float(rr[1])); }
__device__ __forceinline__ float swapsum(float v) { auto rr = __builtin_amdgcn_permlane32_swap(__float_as_uint(v), __float_as_uint(v), false, false); return __uint_as_float(rr[0]) + __uint_as_float(rr[1]); }

template <int NDH, int MASK>
__device__ __forceinline__ void attn_tile(f32x16 (&o)[NDH], float& m, float& l, const bf16x8 (&qr)[4], lds_cptr Kslot, lds_cptr Vslot, LAS float* wsf, int kbase, int qrow, int lane) {
    const int r32 = lane & 31, hi = lane >> 5;
    const lds_cptr kp = Kslot + hi * 1024 + r32 * 16;
    f32x16 p0 = {}, p1 = {};
#pragma unroll
    for (int d0 = 0; d0 < 4; ++d0) {
        const bf16x8 b0 = *(const LAS bf16x8*)(kp + d0 * 2048), b1 = *(const LAS bf16x8*)(kp + d0 * 2048 + 512);
        p0 = __builtin_amdgcn_mfma_f32_32x32x16_bf16(b0, qr[d0], p0, 0, 0, 0);
        p1 = __builtin_amdgcn_mfma_f32_32x32x16_bf16(b1, qr[d0], p1, 0, 0, 0);
    }
    __builtin_amdgcn_sched_barrier(0);
    if (MASK) {
#pragma unroll
        for (int r = 0; r < 16; ++r) {
            const int k0 = kbase + crow(r, hi), k1 = k0 + 32;
            bool v0 = k0 <= qrow, v1 = k1 <= qrow;
            if (MASK == 2) { v0 = v0 && (qrow - k0 < 128); v1 = v1 && (qrow - k1 < 128); }
            p0[r] = v0 ? p0[r] : -__builtin_inff(); p1[r] = v1 ? p1[r] : -__builtin_inff();
        }
    }
    float mx = fmaxf(p0[0], p1[0]);
#pragma unroll
    for (int r = 1; r < 16; ++r) mx = fmaxf(mx, fmaxf(p0[r], p1[r]));
    mx = swapmax(mx);
    const float mn = fmaxf(m, mx);
    const float alpha = __builtin_amdgcn_exp2f(m - mn);
    m = mn;
    float s = 0.f;
#pragma unroll
    for (int r = 0; r < 16; ++r) { p0[r] = __builtin_amdgcn_exp2f(p0[r] - mn); p1[r] = __builtin_amdgcn_exp2f(p1[r] - mn); s += p0[r] + p1[r]; }
    l = l * alpha + s;
    if (__any(alpha != 1.0f)) {
        if (hi == 0) wsf[r32] = alpha;
#pragma unroll
        for (int r = 0; r < 16; ++r) { const float a = wsf[crow(r, hi)];
#pragma unroll
            for (int dh = 0; dh < NDH; ++dh) o[dh][r] *= a; }
    }
    __builtin_amdgcn_sched_barrier(0);
    u32x4 pw[4];
    pw[0] = (u32x4){cvtpk(p0[0], p0[1]), cvtpk(p0[2], p0[3]), cvtpk(p0[4], p0[5]), cvtpk(p0[6], p0[7])};
    pw[1] = (u32x4){cvtpk(p0[8], p0[9]), cvtpk(p0[10], p0[11]), cvtpk(p0[12], p0[13]), cvtpk(p0[14], p0[15])};
    pw[2] = (u32x4){cvtpk(p1[0], p1[1]), cvtpk(p1[2], p1[3]), cvtpk(p1[4], p1[5]), cvtpk(p1[6], p1[7])};
    pw[3] = (u32x4){cvtpk(p1[8], p1[9]), cvtpk(p1[10], p1[11]), cvtpk(p1[12], p1[13]), cvtpk(p1[14], p1[15])};
    __builtin_amdgcn_sched_barrier(0);
    const lds_cptr vp = Vslot + ((lane >> 4) & 1) * 32 + (lane & 3) * 8 + (4 * hi + ((lane & 15) >> 2)) * 64;
#pragma unroll
    for (int dh = 0; dh < NDH; ++dh)
#pragma unroll
        for (int ks = 0; ks < 4; ++ks) {
            const s16x4 lo = vtr(vp + dh * 4096 + ks * 1024), hh = vtr(vp + dh * 4096 + ks * 1024 + 512);
            const bf16x8 vb = (bf16x8){lo[0], lo[1], lo[2], lo[3], hh[0], hh[1], hh[2], hh[3]};
            o[dh] = __builtin_amdgcn_mfma_f32_32x32x16_bf16(__builtin_bit_cast(bf16x8, pw[ks]), vb, o[dh], 0, 0, 0);
            if (ks == 3) __builtin_amdgcn_sched_barrier(0);
        }
}

template <int NDH, int MASK>
__device__ __forceinline__ void attn_qk(f32x16 (&o)[NDH], float& m, float& l, const bf16x8 (&qr)[4], lds_cptr Kslot, LAS float* wsf, int kbase, int qrow, int lane, u32x4 (&pw)[4]) {
    const int r32 = lane & 31, hi = lane >> 5;
    const lds_cptr kp = Kslot + hi * 1024 + r32 * 16;
    f32x16 p0 = {}, p1 = {};
#pragma unroll
    for (int d0 = 0; d0 < 4; ++d0) {
        const bf16x8 b0 = *(const LAS bf16x8*)(kp + d0 * 2048), b1 = *(const LAS bf16x8*)(kp + d0 * 2048 + 512);
        p0 = __builtin_amdgcn_mfma_f32_32x32x16_bf16(b0, qr[d0], p0, 0, 0, 0);
        p1 = __builtin_amdgcn_mfma_f32_32x32x16_bf16(b1, qr[d0], p1, 0, 0, 0);
    }
    __builtin_amdgcn_sched_barrier(0);
    if (MASK) {
#pragma unroll
        for (int r = 0; r < 16; ++r) {
            const int k0 = kbase + crow(r, hi), k1 = k0 + 32;
            bool v0 = k0 <= qrow, v1 = k1 <= qrow;
            if (MASK == 2) { v0 = v0 && (qrow - k0 < 128); v1 = v1 && (qrow - k1 < 128); }
            p0[r] = v0 ? p0[r] : -__builtin_inff(); p1[r] = v1 ? p1[r] : -__builtin_inff();
        }
    }
    float mx = fmaxf(p0[0], p1[0]);
#pragma unroll
    for (int r = 1; r < 16; ++r) mx = fmaxf(mx, fmaxf(p0[r], p1[r]));
    mx = swapmax(mx);
    const float mn = fmaxf(m, mx);
    const float alpha = __builtin_amdgcn_exp2f(m - mn);
    m = mn;
    float s = 0.f;
#pragma unroll
    for (int r = 0; r < 16; ++r) { p0[r] = __builtin_amdgcn_exp2f(p0[r] - mn); p1[r] = __builtin_amdgcn_exp2f(p1[r] - mn); s += p0[r] + p1[r]; }
    l = l * alpha + s;
    if (__any(alpha != 1.0f)) {
        if (hi == 0) wsf[r32] = alpha;
#pragma unroll
        for (int r = 0; r < 16; ++r) { const float a = wsf[crow(r, hi)];
#pragma unroll
            for (int dh = 0; dh < NDH; ++dh) o[dh][r] *= a; }
    }
    __builtin_amdgcn_sched_barrier(0);
    pw[0] = (u32x4){cvtpk(p0[0], p0[1]), cvtpk(p0[2], p0[3]), cvtpk(p0[4], p0[5]), cvtpk(p0[6], p0[7])};
    pw[1] = (u32x4){cvtpk(p0[8], p0[9]), cvtpk(p0[10], p0[11]), cvtpk(p0[12], p0[13]), cvtpk(p0[14], p0[15])};
    pw[2] = (u32x4){cvtpk(p1[0], p1[1]), cvtpk(p1[2], p1[3]), cvtpk(p1[4], p1[5]), cvtpk(p1[6], p1[7])};
    pw[3] = (u32x4){cvtpk(p1[8], p1[9]), cvtpk(p1[10], p1[11]), cvtpk(p1[12], p1[13]), cvtpk(p1[14], p1[15])};
    __builtin_amdgcn_sched_barrier(0);
}
template <int NDH>
__device__ __forceinline__ void attn_pv(f32x16 (&o)[NDH], const u32x4 (&pw)[4], lds_cptr Vslot, int lane) {
    const int hi = lane >> 5;
    const lds_cptr vp = Vslot + ((lane >> 4) & 1) * 32 + (lane & 3) * 8 + (4 * hi + ((lane & 15) >> 2)) * 64;
#pragma unroll
    for (int dh = 0; dh < NDH; ++dh)
#pragma unroll
        for (int ks = 0; ks < 4; ++ks) {
            const s16x4 lo = vtr(vp + dh * 4096 + ks * 1024), hh = vtr(vp + dh * 4096 + ks * 1024 + 512);
            const bf16x8 vb = (bf16x8){lo[0], lo[1], lo[2], lo[3], hh[0], hh[1], hh[2], hh[3]};
            o[dh] = __builtin_amdgcn_mfma_f32_32x32x16_bf16(__builtin_bit_cast(bf16x8, pw[ks]), vb, o[dh], 0, 0, 0);
            if (ks == 3) __builtin_amdgcn_sched_barrier(0);
        }
}

#define DBAR() asm volatile("s_waitcnt lgkmcnt(0)\n\ts_barrier" ::: "memory")
#define VMWAIT0() asm volatile("s_waitcnt vmcnt(0)" ::: "memory")
__device__ __forceinline__ void glds16(const void* gsrc, unsigned lds_dst) { unsigned keep;
    asm volatile("s_mov_b32 %0, m0\n\ts_mov_b32 m0, %2\n\ts_nop 0\n\tglobal_load_lds_dwordx4 %1, off\n\ts_mov_b32 m0, %0" : "=&s"(keep) : "v"(gsrc), "s"(lds_dst) : "memory"); }
template <int ABL = 0> __device__ __forceinline__ void diff_unit(Ctx& C, int b, int h, int qb, float lam) {
    const int lane = C.lane, wid = C.wave, r32 = lane & 31, hi = lane >> 5, c = wid >> 2, wq = wid & 3;
    const int q0w = qb * 128 + wq * 32, qrow = q0w + r32;
    const char* Pb = (const char*)(C.ws + WS_PROJ) + (size_t)b * SEQ * INC * 2;
    bf16x8 qr[4];
    { const unsigned qo = (unsigned)(((q0w + r32) * INC + C_QC + (2 * h + c) * 64 + hi * 8) * 2);
#pragma unroll
      for (int d0 = 0; d0 < 4; ++d0) qr[d0] = *(const bf16x8*)(Pb + (qo + d0 * 32)); }
    const int NT = 2 * (qb + 1);
    LAS unsigned char* L = C.lds; LAS float* wsf = (LAS float*)(L + LDS_WSF + wid * 256);
    const unsigned kofs = (unsigned)((lane * INC + C_KC + (2 * h) * 64 + wid * 8) * 2);
    const unsigned vofs0 = (unsigned)(((16 * (wid & 3) + (lane >> 2)) * INC + C_VC + h * 128 + (wid >> 2) * 32 + (lane & 3) * 8) * 2);
    const unsigned vofs1 = vofs0 + 64 * 2;
    const int kfo = c * 8192 + hi * 1024 + r32 * 16;
    const int vfo = 16384 + ((lane >> 4) & 1) * 32 + (lane & 3) * 8 + (4 * hi + ((lane & 15) >> 2)) * 64;
    const unsigned ldsw = (unsigned)(uintptr_t)(unsigned char*)L + (unsigned)wid * 1024u;
#define DIFF_DMA(t, bo) do { const char* Pt_ = Pb + (size_t)(t) * (64 * INC * 2); const unsigned d_ = (unsigned)__builtin_amdgcn_readfirstlane(ldsw + (bo)); \
        glds16(Pt_ + kofs, d_); glds16(Pt_ + (kofs + 128), d_ + 8192u); glds16(Pt_ + vofs0, d_ + 16384u); glds16(Pt_ + vofs1, d_ + 24576u); } while (0)
#define DIFF_KF(bo) do { _Pragma("unroll") for (int d0 = 0; d0 < 4; ++d0) { kf[2 * d0] = *(const LAS bf16x8*)(L + (bo) + kfo + d0 * 2048); kf[2 * d0 + 1] = *(const LAS bf16x8*)(L + (bo) + kfo + d0 * 2048 + 512); } } while (0)
#define DIFF_VF(lo_, hi_, bo, dh) do { if ((ABL & 32) && t > 0) break; _Pragma("unroll") for (int ks = 0; ks < 4; ++ks) { lo_[ks] = vtr((lds_cptr)(L + (bo) + vfo + (dh) * 4096 + ks * 1024)); hi_[ks] = vtr((lds_cptr)(L + (bo) + vfo + (dh) * 4096 + ks * 1024 + 512)); } } while (0)
#define DIFF_PV(dh, lo_, hi_) do { _Pragma("unroll") for (int ks = 0; ks < 4; ++ks) { if (ABL & 8) { o[dh][ks] += __builtin_bit_cast(float, (int)lo_[ks][0] | ((int)hi_[ks][1] << 16)) + __builtin_bit_cast(float, pw[ks].x); continue; }  const bf16x8 vb_ = (bf16x8){lo_[ks][0], lo_[ks][1], lo_[ks][2], lo_[ks][3], hi_[ks][0], hi_[ks][1], hi_[ks][2], hi_[ks][3]}; \
        o[dh] = __builtin_amdgcn_mfma_f32_32x32x16_bf16(__builtin_bit_cast(bf16x8, pw[ks]), vb_, o[dh], 0, 0, 0); } } while (0)
    DIFF_DMA(0, 0); DIFF_DMA(1, 32768); if (NT > 2) DIFF_DMA(2, 65536); VMWAIT0();
    DBAR();
    bf16x8 kf[8]; DIFF_KF(0);
    f32x16 o[4]; o[0] = f32x16{}; o[1] = f32x16{}; o[2] = f32x16{}; o[3] = f32x16{};
    float m = 0.f, lsum = 0.f;
    u32x4 pw[4]; s16x4 va_lo[4], va_hi[4], vb_lo[4], vb_hi[4];
    f32x16 negm = f32x16{};
    pw[0] = pw[1] = pw[2] = pw[3] = (u32x4){0u, 0u, 0u, 0u};
    if (c == 1) DBAR();
    int s0 = 0, s1 = 32768, s2 = 65536, s3 = 98304;
#if PROBE >= 201 && PROBE <= 219
    unsigned long long tacc_ = 0, tcnt_ = 0, ts0_, ts1_, ts2_, ts3_, ts4_, tsa_ = 0, tsb_ = 0, tsc_ = 0;
#define STAMP(v) do { v = __builtin_amdgcn_s_memtime(); asm volatile("s_waitcnt lgkmcnt(0)" ::: "memory"); } while (0)
#else
#define STAMP(v) do {} while (0)
#endif
#pragma unroll 1
    for (int t = 0; t < NT; ++t) {
        STAMP(ts0_);
        const int kbase = 64 * t; const bool act = kbase <= q0w + 31;
        if (act) {
            f32x16 p0, p1;
            __builtin_amdgcn_s_setprio(2);
#pragma unroll
            for (int d0 = 0; d0 < 4; ++d0) { if (ABL & 2) { p0[d0] += __builtin_bit_cast(float, (int)kf[2 * d0][0]); p1[d0] += __builtin_bit_cast(float, (int)kf[2 * d0 + 1][1]); }
                else { p0 = __builtin_amdgcn_mfma_f32_32x32x16_bf16(kf[2 * d0], qr[d0], d0 == 0 ? negm : p0, 0, 0, 0); p1 = __builtin_amdgcn_mfma_f32_32x32x16_bf16(kf[2 * d0 + 1], qr[d0], d0 == 0 ? negm : p1, 0, 0, 0); } }
            __builtin_amdgcn_s_setprio(1);
            DIFF_VF(va_lo, va_hi, s0, 0); DIFF_VF(vb_lo, vb_hi, s0, 1);
            asm volatile("s_nop 15\n\ts_nop 7" : "+v"(p0), "+v"(p1));
            if (kbase + 63 > q0w) {
                const int dq = qrow - kbase - 4 * hi;
#pragma unroll
                for (int r = 0; r < 16; ++r) { const int cr = (r & 3) + 8 * (r >> 2); p0[r] = (cr <= dq) ? p0[r] : -__builtin_inff(); p1[r] = (cr + 32 <= dq) ? p1[r] : -__builtin_inff(); }
            }
            if (!(ABL & 4)) {
            float mxa = max3f(p0[0], p0[1], p0[2]), mxb = max3f(p0[3], p0[4], p0[5]), mxc = max3f(p1[0], p1[1], p1[2]), mxd = max3f(p1[3], p1[4], p1[5]);
            mxa = max3f(mxa, p0[6], p0[7]); mxb = max3f(mxb, p0[8], p0[9]); mxc = max3f(mxc, p1[6], p1[7]); mxd = max3f(mxd, p1[8], p1[9]);
            mxa = max3f(mxa, p0[10], p0[11]); mxb = max3f(mxb, p0[12], p0[13]); mxc = max3f(mxc, p1[10], p1[11]); mxd = max3f(mxd, p1[12], p1[13]);
            mxa = max3f(mxa, p0[14], p0[15]); mxc = max3f(mxc, p1[14], p1[15]);
            float mx = max3f(mxa, mxb, fmaxf(mxc, mxd));
            mx = swapmax(mx);
            const bool any_grow = __any(mx > 8.0f) || (t == 0);
            if (any_grow) {
                const float dl = (t == 0) ? mx : fmaxf(mx, 0.f);
                m += dl;
#pragma unroll
                for (int r = 0; r < 16; ++r) { p0[r] -= dl; p1[r] -= dl; negm[r] = -m; }
                const float alpha = __builtin_amdgcn_exp2f(-dl);
                lsum *= alpha;
                if (hi == 0) wsf[r32] = alpha;
#pragma unroll
                for (int r = 0; r < 16; ++r) { const float a = wsf[crow(r, hi)];
#pragma unroll
                    for (int dh = 0; dh < 4; ++dh) o[dh][r] *= a; }
            }
            float sa = 0.f, sb = 0.f, sc = 0.f, sd = 0.f;
#pragma unroll
            for (int r = 0; r < 16; r += 2) { p0[r] = __builtin_amdgcn_exp2f(p0[r]); p0[r + 1] = __builtin_amdgcn_exp2f(p0[r + 1]); p1[r] = __builtin_amdgcn_exp2f(p1[r]); p1[r + 1] = __builtin_amdgcn_exp2f(p1[r + 1]);
                sa += p0[r]; sb += p0[r + 1]; sc += p1[r]; sd += p1[r + 1]; }
            lsum += (sa + sb) + (sc + sd);
            }
            pw[0] = (u32x4){cvtpk(p0[0], p0[1]), cvtpk(p0[2], p0[3]), cvtpk(p0[4], p0[5]), cvtpk(p0[6], p0[7])};
            pw[1] = (u32x4){cvtpk(p0[8], p0[9]), cvtpk(p0[10], p0[11]), cvtpk(p0[12], p0[13]), cvtpk(p0[14], p0[15])};
            pw[2] = (u32x4){cvtpk(p1[0], p1[1]), cvtpk(p1[2], p1[3]), cvtpk(p1[4], p1[5]), cvtpk(p1[6], p1[7])};
            pw[3] = (u32x4){cvtpk(p1[8], p1[9]), cvtpk(p1[10], p1[11]), cvtpk(p1[12], p1[13]), cvtpk(p1[14], p1[15])};
        }
        __builtin_amdgcn_s_setprio(0);
        STAMP(ts1_);
        if (c == 0) { if (t + 2 < NT) asm volatile("s_waitcnt vmcnt(4)" ::: "memory"); else VMWAIT0(); }
        DBAR();
        STAMP(ts2_);
        if (!(ABL & 1)) if (t + 3 < NT) DIFF_DMA(t + 3, s3);
        if (act) {
            DIFF_PV(0, va_lo, va_hi);
            DIFF_VF(va_lo, va_hi, s0, 2);
            DIFF_PV(1, vb_lo, vb_hi);
            DIFF_VF(vb_lo, vb_hi, s0, 3);
            DIFF_PV(2, va_lo, va_hi);
            DIFF_PV(3, vb_lo, vb_hi);
        }
        if (!(ABL & 16) || t == 0) if (t + 1 < NT && kbase + 64 <= q0w + 31) DIFF_KF(s1);
        STAMP(ts3_);
        if (c == 1) { if (t + 3 < NT) asm volatile("s_waitcnt vmcnt(4)" ::: "memory"); else VMWAIT0(); }
        DBAR();
        { const int tmp = s0; s0 = s1; s1 = s2; s2 = s3; s3 = tmp; }
#if PROBE >= 201 && PROBE <= 219
        STAMP(ts4_);
        if (t + 4 < NT) { tcnt_ += 1;
            tacc_ += (PROBE == 201) ? (ts1_ - ts0_) : (PROBE == 202) ? (ts2_ - ts1_) : (PROBE == 203) ? (ts3_ - ts2_) : (PROBE == 204) ? (ts4_ - ts3_) : (ts4_ - ts0_); }
#endif
    }
#if PROBE >= 201 && PROBE <= 219
    if (wid == 0 && lane == 0 && qb == 63 && b == 0 && h == 0 && tcnt_ > 0) *(float*)(C.ws + WS_SGATE + 140 * 1024) = (float)tacc_ / (float)tcnt_;
#endif
    if (c == 0) DBAR();
#undef DIFF_DMA
#undef DIFF_KF
#undef DIFF_VF
#undef DIFF_PV
    lsum = swapsum(lsum);
    if (hi == 0) wsf[r32] = lsum;
    LAS float* X = (LAS float*)L + wq * 4096 + lane;
    if (c == 1) {
#pragma unroll
        for (int r = 0; r < 16; ++r) { const float rl = 1.0f / wsf[crow(r, hi)];
#pragma unroll
            for (int dh = 0; dh < 4; ++dh) X[(dh * 16 + r) * 64] = o[dh][r] * rl; }
    }
    __syncthreads();
    if (c == 0) {
        LAS unsigned char* sb = (LAS unsigned char*)L + 65536 + wq * 8704;
        const int odd = lane & 1; const unsigned cb = (unsigned)(((odd ? 32 : 0) + (r32 & ~1)) * 2);
#pragma unroll
        for (int r = 0; r < 16; ++r) {
            const float rl = 1.0f / wsf[crow(r, hi)];
            float s = 0.f;
#pragma unroll
            for (int dh = 0; dh < 4; ++dh) { const float d = o[dh][r] * rl - lam * X[(dh * 16 + r) * 64]; o[dh][r] = d; s += d * d; }
#pragma unroll
            for (int off = 1; off < 32; off <<= 1) s += __shfl_xor(s, off);
            const float rn = 1.0f / sqrtf(s * (1.f / 128.f) + 1e-5f);
            const float v0 = o[0][r] * rn, v1 = o[1][r] * rn, v2 = o[2][r] * rn, v3 = o[3][r] * rn;
            const float ra = __shfl_xor(odd ? v0 : v1, 1), rb = __shfl_xor(odd ? v2 : v3, 1);
            const unsigned w0 = odd ? cvtpk(ra, v1) : cvtpk(v0, ra), w1 = odd ? cvtpk(rb, v3) : cvtpk(v2, rb);
            LAS unsigned char* rp = sb + crow(r, hi) * 272 + cb;
            *(LAS unsigned*)rp = w0; *(LAS unsigned*)(rp + 128) = w1;
        }
        asm volatile("s_waitcnt lgkmcnt(0)" ::: "memory");
        char* Cb = (char*)(C.ws + (ABL ? WS_XSS + 64 * MiB : WS_CAT)) + (size_t)b * SEQ * DM * 2 + (size_t)q0w * (DM * 2) + (1280 + h * 128) * 2;
        const unsigned lo = (unsigned)((lane >> 4) * (DM * 2) + (lane & 15) * 16);
#pragma unroll
        for (int g = 0; g < 8; ++g) { const u32x4 v = *(const LAS u32x4*)(sb + (4 * g + (lane >> 4)) * 272 + (lane & 15) * 16); *(u32x4*)(Cb + (lo + (unsigned)(4 * g * DM * 2))) = v; }
    }
    __syncthreads();
}

__device__ __forceinline__ void swa_task(Ctx& C, int l, int b, int q0, int head, f32x16 (&o)[2], float (&ssq)[16]) {
    const int lane = C.lane, wid = C.wave, r32 = lane & 31, hi = lane >> 5;
    const char* Pb = (const char*)(C.ws + WS_PROJ) + (size_t)b * SEQ * INC * 2;
    LAS unsigned char* Lw = C.lds + wid * 16384; LAS float* wsf = (LAS float*)(C.lds + LDS_WSF + wid * 256);
    const int kvh = head / 3;
    bf16x8 qr[4];
    { const unsigned qo = (unsigned)(((q0 + r32) * INC + C_QA + head * 64 + hi * 8) * 2);
#pragma unroll
      for (int d0 = 0; d0 < 4; ++d0) qr[d0] = *(const bf16x8*)(Pb + (qo + d0 * 32)); }
    o[0] = f32x16{}; o[1] = f32x16{};
    float m = C.in[IN_SINKS][l * 12 + head] * LOG2E, lsum = (hi == 0) ? 1.f : 0.f;
    const int tlo = (q0 >= 127 ? q0 - 127 : 0) >> 6, thi = (q0 + 31) >> 6;
    const unsigned kofs = (unsigned)((lane * INC + C_KA + kvh * 64) * 2);
    const unsigned vofs = (unsigned)(((lane >> 2) * INC + C_VA + kvh * 64 + (lane & 3) * 8) * 2);
    const unsigned ldsw = (unsigned)(uintptr_t)(unsigned char*)Lw;
#define SWA_DMA_K(t_) do { const char* Pt_ = Pb + (size_t)(t_) * (64 * INC * 2); _Pragma("unroll") for (int c8 = 0; c8 < 8; ++c8) glds16(Pt_ + (kofs + c8 * 16), (unsigned)__builtin_amdgcn_readfirstlane(ldsw + c8 * 1024)); } while (0)
#define SWA_DMA_V(t_) do { const char* Pt_ = Pb + (size_t)(t_) * (64 * INC * 2); _Pragma("unroll") for (int i = 0; i < 8; ++i) glds16(Pt_ + (vofs + (16 * (i & 3) * INC + (i >> 2) * 32) * 2), (unsigned)__builtin_amdgcn_readfirstlane(ldsw + 8192 + i * 1024)); } while (0)
    asm volatile("s_waitcnt lgkmcnt(0)" ::: "memory");
    SWA_DMA_K(tlo); SWA_DMA_V(tlo);
#pragma unroll 1
    for (int t = tlo; t <= thi; ++t) {
        asm volatile("s_waitcnt vmcnt(8)" ::: "memory");
        u32x4 pw[4];
        attn_qk<2, 2>(o, m, lsum, qr, (lds_cptr)Lw, wsf, 64 * t, q0 + r32, lane, pw);
        if (t < thi) { asm volatile("s_waitcnt lgkmcnt(0)" ::: "memory"); SWA_DMA_K(t + 1); asm volatile("s_waitcnt vmcnt(8)" ::: "memory"); }
        else VMWAIT0();
        attn_pv<2>(o, pw, (lds_cptr)(Lw + 8192), lane);
        if (t < thi) { asm volatile("s_waitcnt lgkmcnt(0)" ::: "memory"); SWA_DMA_V(t + 1); }
    }
#undef SWA_DMA_K
#undef SWA_DMA_V
    lsum = swapsum(lsum);
    if (hi == 0) wsf[r32] = lsum;
#pragma unroll
    for (int r = 0; r < 16; ++r) { const float rl = 1.0f / wsf[crow(r, hi)]; o[0][r] *= rl; o[1][r] *= rl; float s = o[0][r] * o[0][r] + o[1][r] * o[1][r];
#pragma unroll
        for (int off = 1; off < 32; off <<= 1) s += __shfl_xor(s, off);
        ssq[r] = s; }
}
__device__ __forceinline__ void swa_store(Ctx& C, int b, int q0, int head, const f32x16 (&o)[2]) {
    const int lane = C.lane, r32 = lane & 31, hi = lane >> 5, odd = lane & 1;
    const LAS float* tot = (const LAS float*)(C.misc + MI_SSQ) + 12 * 32;
    LAS unsigned char* sb = C.lds + C.wave * 16384;
    const unsigned cb = (unsigned)(((odd ? 32 : 0) + (r32 & ~1)) * 2);
    asm volatile("s_waitcnt lgkmcnt(0)" ::: "memory");
#pragma unroll
    for (int r = 0; r < 16; ++r) { const int qq = crow(r, hi); const float rn = tot[qq];
        const float v0 = o[0][r] * rn, v1 = o[1][r] * rn;
        const float ra = __shfl_xor(odd ? v0 : v1, 1);
        *(LAS unsigned*)(sb + qq * 144 + cb) = odd ? cvtpk(ra, v1) : cvtpk(v0, ra); }
    asm volatile("s_waitcnt lgkmcnt(0)" ::: "memory");
    char* Cb = (char*)(C.ws + WS_CAT) + (size_t)b * SEQ * DM * 2 + (size_t)q0 * (DM * 2) + head * 128;
    const unsigned lo = (unsigned)((lane >> 3) * (DM * 2) + (lane & 7) * 16);
#pragma unroll
    for (int g = 0; g < 4; ++g) { const u32x4 v = *(const LAS u32x4*)(sb + (8 * g + (lane >> 3)) * 144 + (lane & 7) * 16); *(u32x4*)(Cb + (lo + (unsigned)(8 * g * DM * 2))) = v; }
    asm volatile("s_waitcnt lgkmcnt(0)" ::: "memory");
}
__device__ __forceinline__ void swa_unit(Ctx& C, int l, int b, int jb) {
    const int lane = C.lane, wid = C.wave, r32 = lane & 31, hi = lane >> 5;
    const int q0 = jb * 32;
    LAS float* ssqL = (LAS float*)(C.misc + MI_SSQ);
    f32x16 oa[2], ob[2]; float sa[16], sb[16];
    swa_task(C, l, b, q0, wid, oa, sa);
    if (r32 == 0) {
#pragma unroll
        for (int r = 0; r < 16; ++r) ssqL[wid * 32 + crow(r, hi)] = sa[r]; }
    if (wid < 4) {
        swa_task(C, l, b, q0, 8 + wid, ob, sb);
        if (r32 == 0) {
#pragma unroll
            for (int r = 0; r < 16; ++r) ssqL[(8 + wid) * 32 + crow(r, hi)] = sb[r]; }
    }
    __syncthreads();
    if (C.tid < 32) { float s = 0.f;
#pragma unroll
        for (int hh = 0; hh < 12; ++hh) s += ssqL[hh * 32 + C.tid];
        ssqL[12 * 32 + C.tid] = 1.0f / sqrtf(s * (1.f / 768.f) + 1e-6f); }
    __syncthreads();
    swa_store(C, b, q0, wid, oa);
    if (wid < 4) swa_store(C, b, q0, 8 + wid, ob);
    __syncthreads();
}

__device__ __forceinline__ void pool_unit(Ctx& C, int b, int blk) {
    const int tid = C.tid, s0 = blk * 32;
    const char* Pb = (const char*)(C.ws + WS_PROJ) + (size_t)b * SEQ * INC * 2 + C_UB * 2;
    LAS unsigned char* L = C.lds;
    const int r0 = s0 >= 15 ? s0 - 15 : 0, nrows = s0 + 32 - r0;
    for (int i = tid; i < nrows * 64; i += 512) { const int rr = i >> 6, ch = i & 63;
        *(LAS u32x4*)(L + rr * 1040 + ch * 16) = *(const u32x4*)(Pb + (size_t)(r0 + rr) * (INC * 2) + ch * 16); }
    __syncthreads();
    const int cg8 = tid & 63, ts = tid >> 6, w = 2 << (cg8 >> 4);
    char* Cb = (char*)(C.ws + WS_CAT) + (size_t)b * SEQ * DM * 2 + (768 + 8 * cg8) * 2;
#pragma unroll 1
    for (int i = 0; i < 4; ++i) {
        const int s = s0 + ts * 4 + i, lo = (s - w + 1) > 0 ? (s - w + 1) : 0;
        float acc[8];
#pragma unroll
        for (int j = 0; j < 8; ++j) acc[j] = 0.f;
        u32x4 self = {0, 0, 0, 0};
        for (int sp = lo; sp <= s; ++sp) { const u32x4 v = *(const LAS u32x4*)(L + (sp - r0) * 1040 + cg8 * 16); self = v;
            acc[0] += bf2f(v.x & 0xffffu); acc[1] += bf2f(v.x >> 16); acc[2] += bf2f(v.y & 0xffffu); acc[3] += bf2f(v.y >> 16);
            acc[4] += bf2f(v.z & 0xffffu); acc[5] += bf2f(v.z >> 16); acc[6] += bf2f(v.w & 0xffffu); acc[7] += bf2f(v.w >> 16); }
        const float rc = 1.0f / (float)(s - lo + 1);
        u32x4 ov;
        ov.x = pk2(acc[0] * rc - bf2f(self.x & 0xffffu), acc[1] * rc - bf2f(self.x >> 16)); ov.y = pk2(acc[2] * rc - bf2f(self.y & 0xffffu), acc[3] * rc - bf2f(self.y >> 16));
        ov.z = pk2(acc[4] * rc - bf2f(self.z & 0xffffu), acc[5] * rc - bf2f(self.z >> 16)); ov.w = pk2(acc[6] * rc - bf2f(self.w & 0xffffu), acc[7] * rc - bf2f(self.w >> 16));
        *(u32x4*)(Cb + (size_t)s * (DM * 2)) = ov;
    }
    __syncthreads();
}

#ifndef MIXSELDEF
#define MIXSELDEF 15
#endif
#ifndef MIXSEL
#define MIXSEL 7
#endif
constexpr int NU_DIFF = 2 * 6 * 64, NU_SWA = 2 * 256, NU_POOL = 2 * 256, NU_CONV = 512, CONV_PER = I_EXP / NU_CONV;
constexpr int NU_MIX = NU_DIFF + NU_CONV + NU_SWA + NU_POOL;
static_assert(I_EXP % NU_CONV == 0 && NU_DIFF * 2 == NU_CONV * 3, "queue interleave: 3 attention units : 2 conversion units");
__device__ __forceinline__ void conv_unit(Ctx& C, int l, int j) {
    { LAS float* gl = (LAS float*)(C.lds + LDS_GAINS);
      *(LAS f32x4*)(gl + 4 * C.tid) = *(const f32x4*)(C.in[IN_FNORM] + l * DM + 4 * C.tid);
      if (C.tid < 32) gl[2048 + C.tid] = 1.f;
      __syncthreads(); }
    conv_run<true>(C, l, j * CONV_PER + C.wave, (j + 1) * CONV_PER, 8);
    asm volatile("s_waitcnt vmcnt(0) lgkmcnt(0)" ::: "memory");
    __syncthreads();
}
constexpr int NU_PRE_SLOW = (NLAYER * I_SLOW + 7) / 8, NU_PRE_WO = 0, NU_PRE_L1 = 0, NU_PRE = NU_PRE_SLOW + NU_PRE_WO + NU_PRE_L1;
static_assert(I_WOUT % 96 == 0, "W_out items in whole units");
__device__ __forceinline__ void pre_unit(Ctx& C, int j) {
    if (j < NU_PRE_SLOW) {
        const int it = j * 8 + C.wave;
        if (it < NLAYER * I_SLOW) { const int l = it / I_SLOW, r = it % I_SLOW, lane = C.lane; LAS float* scr = (LAS float*)(C.lds + C.wave * 16384);
            if (r < I_FOLD) fold_item(C.in[IN_WOUT] + (size_t)l * DM * DM, C.in[IN_WPOOL] + (size_t)l * 4 * 128 * 128, C.in[IN_PSCALE] + l * 512, (bf16_t*)(C.ws + WS_WOUT) + (size_t)l * DM * DM, scr, r / 64, (r / 32) & 1, r % 32, lane);
            else { const int q = r - I_FOLD; FWr f{C.in[IN_WRG] + (size_t)l * DM * 4, C.in[IN_WRE] + (size_t)l * DM * 32}; tr_item(f, DM, (bf16_t*)(C.ws + WS_WR) + (size_t)l * 96 * DM, scr, q / 3, q % 3, lane); } }
    } else if (j < NU_PRE_SLOW + NU_PRE_WO) { const int k = j - NU_PRE_SLOW; conv_run<false>(C, 0, k * 96 + C.wave, (k + 1) * 96, 8); }
    else { const int k = j - NU_PRE_SLOW - NU_PRE_WO, e1 = I_PRO + (k + 1) * 96; conv_run<false>(C, 0, I_PRO + k * 96 + C.wave, e1 < 2 * I_PRO ? e1 : 2 * I_PRO, 8); }
    asm volatile("s_waitcnt vmcnt(0) lgkmcnt(0)" ::: "memory");
    __syncthreads();
}
__device__ __forceinline__ void conv_drain(Ctx& C, int l, unsigned* cq) {
    for (;;) {
        if (C.tid == 0) C.misc[0] = (int)__hip_atomic_fetch_add(cq, 1u, __ATOMIC_RELAXED, __HIP_MEMORY_SCOPE_AGENT);
        __syncthreads();
        const int j = C.misc[0];
        __syncthreads();
        if (j >= NU_CONV) break;
        { int l_ = C.lane; asm volatile("" : "+v"(l_)); C.lane = l_; C.tid = C.wave * 64 + l_; }
        conv_unit(C, l, j);
    }
}
template <int ABL = 0> __device__ __forceinline__ void phase_mixers(Ctx& C, int l, int qslot = -1, int sel = MIXSELDEF) {
    const float lam = ((const float*)(C.ws + WS_LAM))[l];
    unsigned* qctr = (unsigned*)(C.ws + WS_CTL) + CW_QCTR + 64 * (qslot < 0 ? l : qslot);
    unsigned* cq = (unsigned*)(C.ws + WS_CTL) + CW_QCTR + 64 * (4 + (qslot < 0 ? l : qslot));
    const int npre = (l == 0 && qslot < 0) ? NU_PRE : 0;
    if ((sel & 8) && (C.bid % 7) == 0) conv_drain(C, l, cq);
    int unext = 0;
    if (C.tid == 0) unext = (int)__hip_atomic_fetch_add(qctr, 1u, __ATOMIC_RELAXED, __HIP_MEMORY_SCOPE_AGENT);
    for (;;) {
        if (C.tid == 0) { C.misc[0] = unext; unext = (int)__hip_atomic_fetch_add(qctr, 1u, __ATOMIC_RELAXED, __HIP_MEMORY_SCOPE_AGENT); }
        __syncthreads();
        int u = C.misc[0];
        __syncthreads();
        { int l_ = C.lane; asm volatile("" : "+v"(l_)); C.lane = l_; C.tid = C.wave * 64 + l_; }
        if (npre) { if (u < npre) { pre_unit(C, u); continue; } u -= npre; }
        if (u >= NU_DIFF + NU_SWA + NU_POOL) break;
        if (u < NU_DIFF) { if (sel & 1) { const int qb = 63 - u / 12, bh = u % 12; diff_unit<ABL>(C, bh / 6, bh % 6, qb, lam); } }
        else if (u < NU_DIFF + NU_SWA) { if (sel & 2) { const int v = u - NU_DIFF; swa_unit(C, l, v >> 8, v & 255); } }
        else { if (sel & 4) { const int v = u - NU_DIFF - NU_SWA; pool_unit(C, v >> 8, v & 255); } }
    }
    if (sel & 8) conv_drain(C, l, cq);
}

__device__ __forceinline__ void phase_router(Ctx& C, int l) {
    const int lane = C.lane, wid = C.wave, tid = C.tid;
    const bf16_t* h = (const bf16_t*)(C.ws + WS_XSS); const float* g = C.in[IN_FNORM] + l * DM;
    bf16_t* XS = (bf16_t*)(C.ws + WS_HN); const bf16_t* WR = (const bf16_t*)(C.ws + WS_WR) + (size_t)l * 96 * DM;
    unsigned* cur = (unsigned*)(C.ws + WS_CTL) + CW_CUR + l * 32 * 64;
    int* toke = (int*)(C.ws + WS_TOKE); float* tokg = (float*)(C.ws + WS_TOKG); int* tokp = (int*)(C.ws + WS_TOKP);
    int* rowtok = (int*)(C.ws + WS_ROWTOK); float* rowgate = (float*)(C.ws + WS_ROWGATE);
    LAS unsigned char* L = C.lds;
    LAS float* RED = (LAS float*)L;
    LAS float* LG = RED + 8 * 64 * 48;
    LAS float* PS = LG + 64 * 48;
    LAS float* RSL = PS + 8 * 64;
    float* rowrs = (float*)(C.ws + WS_ROWRS);
#pragma unroll 1
    for (int unit = C.bid; unit < T / 64; unit += C.G) {
        const int tok0 = unit * 64;
        int l_ = lane; asm volatile("" : "+v"(l_));
        const int r16 = l_ & 15, kq = l_ >> 4, kc = 256 * wid + 8 * kq;
        const unsigned loff = (unsigned)(r16 * DM + kc) * 2u, goff = (unsigned)kc * 4u;
        const char* hb_ = (const char*)h + (size_t)tok0 * DM * 2; char* xb_ = (char*)XS + (size_t)tok0 * DM * 2;
        u32x4 a[4][8];
#pragma unroll
        for (int rt = 0; rt < 4; ++rt)
#pragma unroll
            for (int ks = 0; ks < 8; ++ks) a[rt][ks] = *(const u32x4*)(hb_ + (size_t)rt * 16 * DM * 2 + (loff + 64u * ks));
#pragma unroll
        for (int rt = 0; rt < 4; ++rt) { float sq = 0.f;
#pragma unroll
            for (int ks = 0; ks < 8; ++ks)
#pragma unroll
                for (int q = 0; q < 4; ++q) { const float x0 = bflo(a[rt][ks][q]), x1 = bfhi(a[rt][ks][q]); sq += x0 * x0 + x1 * x1; }
            sq += __shfl_xor(sq, 16); sq += __shfl_xor(sq, 32);
            if (kq == 0) PS[wid * 64 + 16 * rt + r16] = sq;
#pragma unroll
            for (int ks = 0; ks < 8; ++ks) asm volatile("" : "+v"(a[rt][ks]));
        }
        if (tid < 32) C.misc[MI_LCNT + tid] = 0;
        __syncthreads();
        float rs[4];
#pragma unroll
        for (int rt = 0; rt < 4; ++rt) { float sq = 0.f;
#pragma unroll
            for (int w8 = 0; w8 < 8; ++w8) sq += PS[w8 * 64 + 16 * rt + r16];
            rs[rt] = 1.0f / sqrtf(sq * (1.f / DM) + 1e-6f);
            if (wid == 0 && kq == 0) RSL[16 * rt + r16] = rs[rt]; }
#pragma unroll
        for (int ks = 0; ks < 8; ++ks) { const f32x4 g0 = *(const f32x4*)((const char*)g + (goff + 128u * ks)), g1 = *(const f32x4*)((const char*)g + (goff + 128u * ks + 16u));
#pragma unroll
            for (int rt = 0; rt < 4; ++rt) { const u32x4 hh = a[rt][ks]; const float r = rs[rt]; u32x4 p;
                p.x = cvtpk(bflo(hh.x) * r * g0[0], bfhi(hh.x) * r * g0[1]); p.y = cvtpk(bflo(hh.y) * r * g0[2], bfhi(hh.y) * r * g0[3]);
                p.z = cvtpk(bflo(hh.z) * r * g1[0], bfhi(hh.z) * r * g1[1]); p.w = cvtpk(bflo(hh.w) * r * g1[2], bfhi(hh.w) * r * g1[3]);
                a[rt][ks] = p; }
            __builtin_amdgcn_sched_barrier(0); }
        f32x4 acc[4][3];
#pragma unroll
        for (int rt = 0; rt < 4; ++rt)
#pragma unroll
            for (int ct = 0; ct < 3; ++ct) acc[rt][ct] = (f32x4){0.f, 0.f, 0.f, 0.f};
        const char* wp = (const char*)WR;
        bf16x8 bb[6];
#pragma unroll
        for (int i = 0; i < 6; ++i) bb[i] = *(const bf16x8*)(wp + (size_t)((i & 1) * 48 + 16 * (i >> 1)) * DM * 2 + loff);
#pragma unroll
        for (int ks = 0; ks < 8; ++ks) {
            bf16x8 bn[6];
#pragma unroll
            for (int i = 0; i < 6; ++i) bn[i] = *(const bf16x8*)(wp + (size_t)((i & 1) * 48 + 16 * (i >> 1)) * DM * 2 + (loff + 64u * (ks < 7 ? ks + 1 : ks)));
#pragma unroll
            for (int i = 0; i < 6; ++i)
#pragma unroll
                for (int rt = 0; rt < 4; ++rt) acc[rt][i >> 1] = __builtin_amdgcn_mfma_f32_16x16x32_bf16(__builtin_bit_cast(bf16x8, a[rt][ks]), bb[i], acc[rt][i >> 1], 0, 0, 0);
#pragma unroll
            for (int i = 0; i < 6; ++i) bb[i] = bn[i];
            __builtin_amdgcn_sched_barrier(0);
        }
#pragma unroll
        for (int rt = 0; rt < 4; ++rt)
#pragma unroll
            for (int ct = 0; ct < 3; ++ct)
#pragma unroll
                for (int q = 0; q < 4; ++q) RED[(wid * 64 + 16 * rt + 4 * kq + q) * 48 + 16 * ct + r16] = acc[rt][ct][q];
        __syncthreads();
        for (int i = tid; i < 64 * 48; i += 512) { float sacc = 0.f;
#pragma unroll
            for (int w8 = 0; w8 < 8; ++w8) sacc += RED[w8 * 64 * 48 + i];
            LG[i] = sacc; }
        __syncthreads();
        int e0 = 0, e1 = 0, rk0 = 0, rk1 = 0; float g0 = 0.f, g1 = 0.f;
        if (tid < 64) {
            const LAS float* lg = LG + tid * 48;
            const float* brg = C.in[IN_BRG] + l * 4; const float* bre = C.in[IN_BRE] + l * 32;
            float gl[4]; int gsel = 0; float gm = -__builtin_inff();
#pragma unroll
            for (int j = 0; j < 4; ++j) { gl[j] = lg[j] + brg[j]; if (gl[j] > gm) { gm = gl[j]; gsel = j; } }
            float gs = 0.f;
#pragma unroll
            for (int j = 0; j < 4; ++j) gs += __expf(gl[j] - gm);
            const float pgsel = 1.0f / gs;
            float le[8];
#pragma unroll
            for (int j = 0; j < 8; ++j) le[j] = lg[4 + gsel * 8 + j] + bre[gsel * 8 + j];
            int i0 = 0; float m0 = le[0];
#pragma unroll
            for (int j = 1; j < 8; ++j) if (le[j] > m0) { m0 = le[j]; i0 = j; }
            int i1 = -1; float m1 = -__builtin_inff();
#pragma unroll
            for (int j = 0; j < 8; ++j) if (j != i0 && le[j] > m1) { m1 = le[j]; i1 = j; }
            const float p1 = __expf(m1 - m0), den = 1.0f / (1.0f + p1);
            g0 = pgsel * den; g1 = pgsel * p1 * den;
            e0 = gsel * 8 + i0; e1 = gsel * 8 + i1;
            rk0 = __hip_atomic_fetch_add((LAS int*)(C.misc + MI_LCNT) + e0, 1, __ATOMIC_RELAXED, __HIP_MEMORY_SCOPE_WORKGROUP);
            rk1 = __hip_atomic_fetch_add((LAS int*)(C.misc + MI_LCNT) + e1, 1, __ATOMIC_RELAXED, __HIP_MEMORY_SCOPE_WORKGROUP);
        }
        __syncthreads();
        if (tid < 32) { const int c = C.misc[MI_LCNT + tid]; C.misc[MI_LBASE + tid] = c ? (int)__hip_atomic_fetch_add(cur + tid * 64, (unsigned)c, __ATOMIC_RELAXED, __HIP_MEMORY_SCOPE_AGENT) : 0; }
        __syncthreads();
        if (tid < 64) {
            const int t = tok0 + tid; const int p0 = C.misc[MI_LBASE + e0] + rk0, p1 = C.misc[MI_LBASE + e1] + rk1;
            toke[2 * t] = e0; toke[2 * t + 1] = e1; tokg[2 * t] = g0; tokg[2 * t + 1] = g1; tokp[2 * t] = p0; tokp[2 * t + 1] = p1;
            rowtok[e0 * T + p0] = t; rowtok[e1 * T + p1] = t; rowgate[e0 * T + p0] = g0; rowgate[e1 * T + p1] = g1;
            const float rst = RSL[tid]; rowrs[e0 * T + p0] = rst; rowrs[e1 * T + p1] = rst;
        }
        __syncthreads();
    }
}

__device__ __forceinline__ void phase_gather(Ctx& C, int l) {
    load_starts(C, l);
    const int gw = C.bid * 8 + C.wave, NGW = C.G * 8, lane = C.lane;
    const bf16_t* XS = (const bf16_t*)(C.ws + WS_HN); bf16_t* XSS = (bf16_t*)(C.ws + WS_XSS);
    const int* rowtok = (const int*)(C.ws + WS_ROWTOK); const float* rowgate = (const float*)(C.ws + WS_ROWGATE); float* sgate = (float*)(C.ws + WS_SGATE);
    for (int ci = gw; ci < NASSIGN; ci += NGW) {
        int e = 0;
        while (e < 31 && C.misc[MI_ST + e + 1] <= ci) ++e;
        const int pos = ci - C.misc[MI_ST + e]; const int tok = rowtok[e * T + pos];
        const u32x4* s = (const u32x4*)(XS + (size_t)tok * DM) + lane; u32x4* d = (u32x4*)(XSS + (size_t)ci * DM) + lane;
        const u32x4 a0 = s[0], a1 = s[64], a2 = s[128], a3 = s[192];
        d[0] = a0; d[64] = a1; d[128] = a2; d[192] = a3;
        if (lane == 0) sgate[ci] = rowgate[e * T + pos];
    }
}

#define XB_TMO      128
#define XB_XCNT(j)  (256  + 64 * (j))
#define XB_XSUB(j)  (1280 + 64 * (j))
#define XB_XGEN(j)  (2304 + 64 * (j))
#define XB_TOP      3328
#define XB_TOPGEN   3392
#define XCD_BAR_WORDS 3456
#define XB_SPIN_CAP (1u << 18)

__device__ __forceinline__ unsigned xb_ld(unsigned* p)              { return __hip_atomic_load(p, __ATOMIC_RELAXED, __HIP_MEMORY_SCOPE_AGENT); }
__device__ __forceinline__ unsigned xb_add(unsigned* p, unsigned v) { return __hip_atomic_fetch_add(p, v, __ATOMIC_RELAXED, __HIP_MEMORY_SCOPE_AGENT); }
__device__ __forceinline__ unsigned xb_xcc_id() { return (unsigned)__builtin_amdgcn_s_getreg((3 << 11) | 20) & 0xFu; }
#define XB_SPIN(cond, bar) do { unsigned _sp = 0; while (cond) { __builtin_amdgcn_s_sleep(1); \
    if ((++_sp & 255u) == 0u) { if (xb_ld(&(bar)[XB_TMO])) break; if (_sp > XB_SPIN_CAP) { atomicAdd(&(bar)[XB_TMO], 1u); break; } } } } while (0)

__device__ __forceinline__ int lane_id_v() { int l; asm volatile("v_mbcnt_lo_u32_b32 %0, -1, 0\n\tv_mbcnt_hi_u32_b32 %0, -1, %0" : "=v"(l)); return l; }
struct XcdBarrier {
    int wv;
    unsigned* bar; unsigned x;
    volatile LAS unsigned* st;
};

__device__ __forceinline__ XcdBarrier xcd_barrier_post(unsigned* bar, volatile LAS unsigned* st) {
    XcdBarrier b; b.bar = bar; b.x = xb_xcc_id(); b.st = st;
    if (threadIdx.x == 0) (void)xb_add(&bar[XB_XCNT(b.x)], 1u);
    return b;
}
__device__ __forceinline__ void xcd_barrier_complete(unsigned* bar, unsigned x, unsigned& nloc, unsigned& nx) {
    const unsigned G = gridDim.x * gridDim.y * gridDim.z;
    unsigned sum, cnt, mine, sp = 0u;
    for (;;) {
        sum = 0u; cnt = 0u; mine = 0u;
#pragma unroll 1
        for (unsigned j = 0; j < 16; ++j) { const unsigned c = xb_ld(&bar[XB_XCNT(j)]); sum += c; cnt += (c > 0u) ? 1u : 0u; mine = (j == x) ? c : mine; }
        if (sum == G) break;
        __builtin_amdgcn_s_sleep(1);
        if ((++sp & 255u) == 0u) { if (xb_ld(&bar[XB_TMO])) break; if (sp > XB_SPIN_CAP) { atomicAdd(&bar[XB_TMO], 1u); break; } }
    }
    nloc = mine > 0u ? mine : 1u; nx = cnt > 0u ? cnt : 1u;
}

__device__ __forceinline__ void xcd_barrier(const XcdBarrier& b) {
    asm volatile("s_waitcnt vmcnt(0)" ::: "memory");
    __syncthreads();
    if (b.wv == 0 && lane_id_v() == 0) {
        unsigned* bar = b.bar; unsigned bx = b.x;
        asm volatile("" : "+s"(bar), "+s"(bx));
        __builtin_amdgcn_s_waitcnt(0);
        unsigned nloc = b.st[0], nx = b.st[1];
        if (nloc == 0u) { xcd_barrier_complete(bar, bx, nloc, nx); b.st[0] = nloc; b.st[1] = nx; }
        const unsigned old = xb_add(&bar[XB_XSUB(bx)], 1u);
        const unsigned gen = old / nloc;
        if (old + 1u == (gen + 1u) * nloc) {
            __builtin_amdgcn_fence(__ATOMIC_RELEASE, "agent");
            asm volatile("s_waitcnt vmcnt(0)" ::: "memory");
            const unsigned og = xb_add(&bar[XB_TOP], 1u);
            const unsigned tg = og / nx;
            if (og + 1u == (tg + 1u) * nx) xb_add(&bar[XB_TOPGEN], 1u);
            else XB_SPIN(xb_ld(&bar[XB_TOPGEN]) == tg, bar);
            __builtin_amdgcn_fence(__ATOMIC_ACQUIRE, "agent");
            xb_add(&bar[XB_XGEN(bx)], 1u);
            asm volatile("s_waitcnt vmcnt(0)" ::: "memory");
        } else {
            XB_SPIN(xb_ld(&bar[XB_XGEN(bx)]) == gen, bar);
            __builtin_amdgcn_fence(__ATOMIC_ACQUIRE, "agent");
            asm volatile("s_waitcnt vmcnt(0)" ::: "memory");
        }
    }
    __syncthreads();
}


#ifndef PHASE_MASK
#define PHASE_MASK 0x3ff
#endif
#define HAS(k) (((PHASE_MASK) >> (k)) & 1)
struct Args { const float* in[23]; float* out; unsigned char* ws; int ph_lo, ph_hi; };
constexpr int N_PHASES = 18;

__global__ void __launch_bounds__(512, 2) mega_fwd(Args args) {
    extern __shared__ __attribute__((aligned(16))) unsigned char lds_raw[];
    cg::grid_group grid = cg::this_grid();
    Ctx C;
    C.lds = (LAS unsigned char*)lds_raw; C.misc = (volatile LAS int*)(C.lds + LDS_MISC);
    const int wv0 = __builtin_amdgcn_readfirstlane((int)threadIdx.x >> 6);
    C.tid = threadIdx.x; C.lane = C.tid & 63; C.wave = wv0; C.G = gridDim.x; C.bid = blockIdx.x;
    const int lo = args.ph_lo, hi = args.ph_hi;
    if (threadIdx.x < 64) ((volatile LAS int*)(C.lds + LDS_MISC))[threadIdx.x] = 0;
    __syncthreads();
    XcdBarrier xbar = xcd_barrier_post((unsigned*)(args.ws + WS_CTL) + CW_BAR, (volatile LAS unsigned*)(C.lds + LDS_MISC) + 8);
    xbar.wv = wv0;
    typedef const Args __attribute__((address_space(4)))* KArgP;
#define CTX_REFRESH() do { KArgP ka_ = (KArgP)__builtin_amdgcn_kernarg_segment_ptr(); asm volatile("" : "+s"(ka_)); \
        _Pragma("unroll") for (int i_ = 0; i_ < 23; ++i_) C.in[i_] = ka_->in[i_]; C.out = ka_->out; C.ws = ka_->ws; \
        int w_ = wv0; asm volatile("" : "+s"(w_)); int l_ = lane_id_v(); asm volatile("" : "+v"(l_)); C.wave = w_; C.lane = l_; C.tid = w_ * 64 + l_; } while (0)
#if MK_PER_PHASE
#define IN(k) (lo <= (k) && (k) < hi)
#else
#define IN(k) true
#endif
#define XBAR() do { xbar.bar = (unsigned*)(C.ws + WS_CTL) + CW_BAR; xcd_barrier(xbar); } while (0)
#define SEAM(k) do { if (IN(k) && IN((k) + 1)) XBAR(); } while (0)
#define HN ((bf16_t*)(C.ws + WS_HN))
#define PROJ ((bf16_t*)(C.ws + WS_PROJ))
#define CAT ((bf16_t*)(C.ws + WS_CAT))
#define XSS ((bf16_t*)(C.ws + WS_XSS))
#define HB ((bf16_t*)(C.ws + WS_XSS))
#define ACT ((bf16_t*)(C.ws + WS_ACT))
#define YB ((bf16_t*)(C.ws + WS_PROJ))

#if PROBE >= 300 && PROBE < 400
    unsigned long long ptacc_ = 0, pt0_ = __builtin_amdgcn_s_memrealtime();
#define PH_END(id) do { const unsigned long long n_ = __builtin_amdgcn_s_memrealtime(); if ((PROBE - 300) == (id)) ptacc_ += n_ - pt0_; pt0_ = n_; } while (0)
#else
#define PH_END(id) do {} while (0)
#endif
    if (lo == 0x7fffffff) grid.sync();
    if (HAS(0) && IN(0)) { CTX_REFRESH(); phase_prologue(C); phase_stream0(C, C.in[IN_X], HB); PT_STAMP(4); } SEAM(0); PH_END(0);
    if (PROBE == 1) { CTX_REFRESH(); phase_prologue(C); XBAR(); }
    for (int l = 0; l < NLAYER; ++l) {
        const int p0 = 1 + 8 * l;
        if (HAS(1) && IN(p0 + 0)) { CTX_REFRESH();
            if (l > 0) { load_starts(C, l - 1); phase_combine<1>(C, HB, C.in[IN_ANORM] + l * DM, HN, nullptr); }
        } if (l > 0) SEAM(p0 + 0); PH_END(p0 + 0);

        if (HAS(2) && IN(p0 + 1)) { CTX_REFRESH();
            pg8::Gemm g{HB, (const bf16_t*)(C.ws + WS_WIN) + (size_t)l * INC * DM, T, INC, DM}; pg8::StaticOrder S; S.init(T, INC, C.G, C.bid);
            EpiProj E{PROJ, (const float*)(C.ws + WS_COS), (const float*)(C.ws + WS_SIN), (const float*)(C.ws + WS_RS)};
            pg8::gemm_phase<EpiProj, pg8::StaticOrder, true, true>(C.lds, g, S, E, C.tid);
        } SEAM(p0 + 1); PH_END(p0 + 1);
        if (PROBE == 2 && l == 0) { CTX_REFRESH();
            pg8::Gemm g{HB, (const bf16_t*)(C.ws + WS_WIN) + (size_t)l * INC * DM, T, INC, DM}; pg8::StaticOrder S; S.init(T, INC, C.G, C.bid);
            EpiProj E{PROJ, (const float*)(C.ws + WS_COS), (const float*)(C.ws + WS_SIN), (const float*)(C.ws + WS_RS)};
            pg8::gemm_phase<EpiProj, pg8::StaticOrder, true, true>(C.lds, g, S, E, C.tid); XBAR(); }
        if (HAS(3) && IN(p0 + 2)) { CTX_REFRESH(); phase_mixers(C, l); } SEAM(p0 + 2); PH_END(p0 + 2);
        if (PROBE >= 30 && PROBE <= 37 && l == 0) { CTX_REFRESH(); phase_mixers(C, l, 2, PROBE - 30); XBAR(); }
#if PROBE >= 100 && PROBE < 200
        if (l == 0) { CTX_REFRESH(); phase_mixers<128 | (PROBE - 100)>(C, l, 2, 1); XBAR(); }
#endif
        if (HAS(4) && IN(p0 + 3)) { CTX_REFRESH();
            pg8::Gemm g{CAT, (const bf16_t*)(C.ws + WS_WOUT) + (size_t)l * DM * DM, T, DM, DM}; pg8::StaticOrder S; S.init(T, DM, C.G, C.bid);
            EpiResidB E{nullptr, HB};
            pg8::gemm_phase<EpiResidB, pg8::StaticOrder, true, true>(C.lds, g, S, E, C.tid);
        } SEAM(p0 + 3); PH_END(p0 + 3);
        if (PROBE == 4 && l == 0) { CTX_REFRESH();
            pg8::Gemm g{CAT, (const bf16_t*)(C.ws + WS_WOUT) + (size_t)l * DM * DM, T, DM, DM}; pg8::StaticOrder S; S.init(T, DM, C.G, C.bid);
            EpiResidB E{nullptr, HB};
            pg8::gemm_phase<EpiResidB, pg8::StaticOrder, true, true>(C.lds, g, S, E, C.tid); XBAR(); }
        if (HAS(5) && IN(p0 + 4)) { CTX_REFRESH(); phase_router(C, l); } SEAM(p0 + 4); PH_END(p0 + 4);
        if (HAS(7) && IN(p0 + 6)) { CTX_REFRESH();
            load_starts(C, l);
            pg8::Gemm g{HB, (const bf16_t*)(C.ws + WS_WGU) + (size_t)l * NEXP * 1024 * DM, T, 1024, DM};
            unsigned* rdy = (unsigned*)(C.ws + WS_CTL) + CW_RDY + l * 4096;
            pg8::MoeOrder S{(const LAS int*)(C.lds + LDS_MISC) + MI_ST, (const LAS int*)(C.lds + LDS_MISC) + MI_TP, 4, 1024, C.G, C.bid, rdy, C.lane, C.wave};
            LAS int* tk = (LAS int*)(C.lds + LDS_MISC + 4096);
            { const int* rowtok = (const int*)(C.ws + WS_ROWTOK);
#pragma unroll 1
              for (int i = 0; i < 6; ++i) { Unit u; if (!S.next(i, u)) break; if (C.tid < 256) tk[i * 256 + C.tid] = (C.tid < u.valid) ? rowtok[u.e * T + u.pm * 256 + C.tid] : 0; }
              __syncthreads(); }
            EpiGU E{ACT, (const float*)(C.ws + WS_ROWRS)};
            pg8::gemm_phase<EpiGU, pg8::MoeOrder, true, true, true>(C.lds, g, S, E, C.tid, (const LAS int*)tk);
            __syncthreads();
            { pg8::Gemm g2{ACT, (const bf16_t*)(C.ws + WS_WDN) + (size_t)l * NEXP * DM * DFF, NASSIGN + NEXP * 256, DM, DFF};
              pg8::MoeQueue Q{(const LAS int*)(C.lds + LDS_MISC) + MI_ST, (const LAS int*)(C.lds + LDS_MISC) + MI_TP, 8, DM, (unsigned*)(C.ws + WS_CTL) + CW_DQ + l * 8 * 64, rdy, 4,
                              (volatile LAS int*)(C.lds + LDS_MISC) + 2, C.tid, C.bid & 7};
              EpiDown E2{YB, (const float*)(C.ws + WS_ROWGATE), (const LAS int*)(C.lds + LDS_MISC) + MI_ST};
              pg8::gemm_phase<EpiDown, pg8::MoeQueue, true, true, false, true>(C.lds, g2, Q, E2, C.tid); }
        } SEAM(p0 + 7); PH_END(p0 + 7);
    }
    if (HAS(9) && IN(17)) { CTX_REFRESH(); load_starts(C, NLAYER - 1); phase_combine<2>(C, HB, C.in[IN_FINAL], nullptr, C.out); }
#if PROBE >= 300 && PROBE < 400
    PH_END(17);
    if (C.wave == 0 && C.lane == 0) { const unsigned long long t0_ = __builtin_amdgcn_s_memrealtime(); while (__builtin_amdgcn_s_memrealtime() - t0_ < ptacc_) __builtin_amdgcn_s_sleep(8); }
#endif
#if PROBE >= 320 && PROBE < 330
    { const int sec_ = (PROBE - 320) >> 1, pw_ = (PROBE & 1) ? 7 : 0;
      if (C.wave == pw_ && C.lane == 0) { const unsigned long long d_ = C.pts[sec_ + 1] - C.pts[sec_], t0_ = __builtin_amdgcn_s_memrealtime(); while (__builtin_amdgcn_s_memrealtime() - t0_ < d_) __builtin_amdgcn_s_sleep(8); } }
#endif
#if PROBE >= 201 && PROBE <= 219
    if (C.bid == 0 && C.tid == 0) { const float v_ = *(volatile float*)(C.ws + WS_SGATE + 140 * 1024); const unsigned long long t0_ = __builtin_amdgcn_s_memrealtime(), dt_ = (unsigned long long)(v_ * 10.f);
        while (__builtin_amdgcn_s_memrealtime() - t0_ < dt_) __builtin_amdgcn_s_sleep(8); }
#endif
#undef IN
#undef SEAM
#undef HN
#undef PROJ
#undef CAT
#undef XSS
#undef HB
#undef ACT
#undef YB
}

extern "C" void kernel_launch(void* const* d_in, const int* in_sizes, int n_in, void* d_out, int out_size, void* d_ws, size_t ws_size, hipStream_t stream) {
    static int grid = 0;
    if (grid == 0) {
        if (n_in != 23 || in_sizes[0] != T * DM || out_size != T * DM || ws_size < WS_END) { fprintf(stderr, "kernel_launch: unexpected shapes (n_in %d, in0 %d, out %d, ws %zu < %zu)\n", n_in, n_in > 0 ? in_sizes[0] : -1, out_size, ws_size, (size_t)WS_END); grid = -1; return; }
        int dev = 0, cus = 0, per_cu = 0;
        hipGetDevice(&dev); hipDeviceGetAttribute(&cus, hipDeviceAttributeMultiprocessorCount, dev);
        if (hipFuncSetAttribute((const void*)mega_fwd, hipFuncAttributeMaxDynamicSharedMemorySize, LDS_BYTES) != hipSuccess) { fprintf(stderr, "kernel_launch: hipFuncSetAttribute failed\n"); grid = -1; return; }
        if (hipOccupancyMaxActiveBlocksPerMultiprocessor(&per_cu, (const void*)mega_fwd, 512, LDS_BYTES) != hipSuccess || per_cu < 1) { fprintf(stderr, "kernel_launch: occupancy query says %d blocks per CU\n", per_cu); per_cu = 1; }
        (void)hipGetLastError();
        grid = cus * 1;
        fprintf(stderr, "kernel_launch: %d CUs, occupancy %d/CU, grid %d\n", cus, per_cu, grid);
    }
    if (grid < 0) return;
    hipMemsetAsync((char*)d_ws + WS_CTL, 0, CTL_ZERO_BYTES, stream);
    Args a{};
    for (int i = 0; i < 23; ++i) a.in[i] = (const float*)d_in[i];
    a.out = (float*)d_out; a.ws = (unsigned char*)d_ws;
#if MK_PER_PHASE
    for (int p = 0; p < N_PHASES; ++p) {
        a.ph_lo = p; a.ph_hi = p + 1; void* kargs[] = {&a};
        hipError_t e = hipLaunchCooperativeKernel((const void*)mega_fwd, dim3(grid), dim3(512), kargs, LDS_BYTES, stream);
        if (e != hipSuccess) { fprintf(stderr, "launch of phase %d failed: %s\n", p, hipGetErrorString(e)); break; }
    }
#else
    a.ph_lo = 0; a.ph_hi = N_PHASES; void* kargs[] = {&a};
    hipError_t e = hipLaunchCooperativeKernel((const void*)mega_fwd, dim3(grid), dim3(512), kargs, LDS_BYTES, stream);
    if (e != hipSuccess) fprintf(stderr, "cooperative launch failed: %s (grid %d)\n", hipGetErrorString(e), grid);
#endif
}
```
